# Optimizing an MI355X kernel written in HIP

```python
import jax, jax.numpy as jnp
from jax import lax
import numpy as np

D_MODEL = 1024
BATCH = 32
SEQ = 2048
DEPTH = 2

N_MIXERS = 2
EPS = 1e-6
Q_BLOCK = 128
NEG_INF = -1e30
MEM_LEN = 256
XATTN_HEADS = 4
XATTN_WIDTH = D_MODEL // 4
XATTN_HEAD_DIM = XATTN_WIDTH // XATTN_HEADS
TOKEN_MIX_WIDTH = D_MODEL - XATTN_WIDTH
QK_NOPE_DIM = 64
QK_ROPE_DIM = 32
QK_HEAD_DIM = QK_NOPE_DIM + QK_ROPE_DIM
V_HEAD_DIM = 64
MLA_HEADS = TOKEN_MIX_WIDTH // V_HEAD_DIM
Q_LORA_RANK = D_MODEL // 4
KV_LORA_RANK = D_MODEL // 8
MLA_IN = Q_LORA_RANK + KV_LORA_RANK + QK_ROPE_DIM
ROPE_THETA = 10000.0
POOL_WINDOWS = (2, 4, 8, 16)
POOL_GROUPS = len(POOL_WINDOWS)
POOL_GROUP_WIDTH = TOKEN_MIX_WIDTH // POOL_GROUPS
N_EXPERT_GROUPS = 4
EXPERTS_PER_GROUP = 8
N_EXPERTS = N_EXPERT_GROUPS * EXPERTS_PER_GROUP
TOP_K = 2
D_EXPERT = D_MODEL // 4

kernel_name = 'hybrid_mla_pool_memxattn_hmoe'


def rmsnorm(x, g):
    x32 = x.astype(jnp.float32)
    y = x32 * lax.rsqrt(jnp.mean(x32 * x32, axis=-1, keepdims=True) + EPS)
    return (y * g.astype(jnp.float32)).astype(x.dtype)


def apply_rope(x, cos, sin):
    x1, x2 = jnp.split(x, 2, axis=-1)
    return jnp.concatenate([x1 * cos - x2 * sin, x2 * cos + x1 * sin], axis=-1)


def causal_mla_attention(q_nope, q_rope, k_nope, k_rope, v):
    S = q_nope.shape[1]
    scale = QK_HEAD_DIM ** -0.5
    outs = []
    for blk in range(S // Q_BLOCK):
        lo, hi = blk * Q_BLOCK, (blk + 1) * Q_BLOCK
        s = (jnp.einsum('bqhd,bkhd->bhqk', q_nope[:, lo:hi], k_nope[:, :hi])
             + jnp.einsum('bqhr,bkr->bhqk', q_rope[:, lo:hi], k_rope[:, :hi]))
        s = s.astype(jnp.float32) * scale
        q_idx = lo + jnp.arange(Q_BLOCK)[:, None]
        k_idx = jnp.arange(hi)[None, :]
        s = jnp.where(k_idx <= q_idx, s, NEG_INF)
        p = jax.nn.softmax(s, axis=-1).astype(v.dtype)
        outs.append(jnp.einsum('bhqk,bkhd->bqhd', p, v[:, :hi]))
    return jnp.concatenate(outs, axis=1)


def mla_mixer(z, g_q_lat, w_uq, g_kv_lat, w_ukv, cos, sin):
    B, S, _ = z.shape
    q_lat = z[..., :Q_LORA_RANK]
    kv_lat = z[..., Q_LORA_RANK:Q_LORA_RANK + KV_LORA_RANK]
    k_r = z[..., Q_LORA_RANK + KV_LORA_RANK:]
    q = (rmsnorm(q_lat, g_q_lat) @ w_uq).reshape(B, S, MLA_HEADS, QK_HEAD_DIM)
    q_nope = q[..., :QK_NOPE_DIM]
    q_rope = apply_rope(q[..., QK_NOPE_DIM:], cos[:, :, None, :], sin[:, :, None, :])
    kv = (rmsnorm(kv_lat, g_kv_lat) @ w_ukv).reshape(B, S, MLA_HEADS, QK_NOPE_DIM + V_HEAD_DIM)
    k_nope = kv[..., :QK_NOPE_DIM]
    v = kv[..., QK_NOPE_DIM:]
    k_rope = apply_rope(k_r, cos, sin)
    o = causal_mla_attention(q_nope, q_rope, k_nope, k_rope, v)
    return o.reshape(B, S, MLA_HEADS * V_HEAD_DIM)


def multiscale_pool(u, w_group, scale):
    B, S, C = u.shape
    ug = u.reshape(B, S, POOL_GROUPS, POOL_GROUP_WIDTH).astype(jnp.float32)
    csum = jnp.cumsum(ug, axis=1)
    steps = jnp.arange(1, S + 1)
    outs = []
    for g, win in enumerate(POOL_WINDOWS):
        cg = csum[:, :, g]
        shifted = jnp.pad(cg, ((0, 0), (win, 0), (0, 0)))[:, :S]
        count = jnp.minimum(steps, win).astype(jnp.float32)[None, :, None]
        outs.append((cg - shifted) / count - ug[:, :, g])
    d = jnp.stack(outs, axis=2).astype(u.dtype)
    y = jnp.einsum('bsgc,gcd->bsgd', d, w_group).reshape(B, S, C)
    return y * scale


def memory_cross_attention(qc, mem_k, mem_v):
    B, S, _ = qc.shape
    q = qc.reshape(B, S, XATTN_HEADS, XATTN_HEAD_DIM)
    s = jnp.einsum('bshd,bmhd->bhsm', q, mem_k).astype(jnp.float32) * (XATTN_HEAD_DIM ** -0.5)
    p = jax.nn.softmax(s, axis=-1).astype(qc.dtype)
    return jnp.einsum('bhsm,bmhd->bshd', p, mem_v).reshape(B, S, XATTN_WIDTH)


def hierarchical_moe(h, w_rg, b_rg, w_re, b_re, w_gate, w_up, w_down):
    B, S, D = h.shape
    t = h.reshape(-1, D)
    t32 = t.astype(jnp.float32)
    lg = t32 @ w_rg.astype(jnp.float32) + b_rg.astype(jnp.float32)
    pg = jax.nn.softmax(lg, axis=-1)
    g_sel = jnp.argmax(lg, axis=-1)
    gate_g = jnp.take_along_axis(pg, g_sel[:, None], axis=1)
    le = (t32 @ w_re.astype(jnp.float32) + b_re.astype(jnp.float32)).reshape(-1, N_EXPERT_GROUPS, EXPERTS_PER_GROUP)
    le_sel = jnp.take_along_axis(le, g_sel[:, None, None], axis=1)[:, 0]
    pe = jax.nn.softmax(le_sel, axis=-1)
    top_p, top_i = lax.top_k(pe, TOP_K)
    wts = gate_g * top_p / jnp.sum(top_p, axis=-1, keepdims=True)
    eid = g_sel[:, None] * EXPERTS_PER_GROUP + top_i
    comb = jnp.sum(jax.nn.one_hot(eid, N_EXPERTS, dtype=jnp.float32) * wts[..., None], axis=1).astype(t.dtype)
    y = jnp.zeros_like(t)
    for e in range(N_EXPERTS):
        a = jax.nn.silu(t @ w_gate[e]) * (t @ w_up[e])
        y = y + comb[:, e:e + 1] * (a @ w_down[e])
    return y.reshape(B, S, D)


def setup_inputs(seed: int = 0) -> dict:
    key = jax.random.key(seed)
    ks = iter(jax.random.split(key, 32))
    f32 = jnp.float32
    n_mla = (DEPTH + 1) // 2
    n_pool = DEPTH // 2

    def w(shape, fan_in):
        return jax.random.normal(next(ks), shape, f32) * (fan_in ** -0.5)

    def gain(shape, s=0.05):
        return 1.0 + s * jax.random.normal(next(ks), shape, f32)

    x = jax.random.normal(next(ks), (BATCH, SEQ, D_MODEL), f32)
    mem = jax.random.normal(next(ks), (BATCH, MEM_LEN, D_MODEL), f32)
    offset = jax.random.randint(next(ks), (BATCH, 1), 0, 4096, dtype=jnp.int32)
    positions = (offset + jnp.arange(SEQ, dtype=jnp.int32)[None, :]).astype(jnp.int32)
    return {
        'x': x,
        'mem': mem,
        'positions': positions,
        'g_mix': gain((DEPTH, D_MODEL)),
        'w_in_mla': w((n_mla, D_MODEL, MLA_IN + XATTN_WIDTH), D_MODEL),
        'g_q_lat': gain((n_mla, Q_LORA_RANK)),
        'w_uq': w((n_mla, Q_LORA_RANK, MLA_HEADS * QK_HEAD_DIM), Q_LORA_RANK),
        'g_kv_lat': gain((n_mla, KV_LORA_RANK)),
        'w_ukv': w((n_mla, KV_LORA_RANK, MLA_HEADS * (QK_NOPE_DIM + V_HEAD_DIM)), KV_LORA_RANK),
        'w_in_pool': w((n_pool, D_MODEL, TOKEN_MIX_WIDTH + XATTN_WIDTH), D_MODEL),
        'w_pool_mix': w((n_pool, POOL_GROUPS, POOL_GROUP_WIDTH, POOL_GROUP_WIDTH), POOL_GROUP_WIDTH),
        'pool_scale': gain((n_pool, TOKEN_MIX_WIDTH), 0.1),
        'g_mem': gain((D_MODEL,)),
        'w_mem_kv': w((D_MODEL, 2 * XATTN_WIDTH), D_MODEL),
        'w_o': w((DEPTH, D_MODEL, D_MODEL), D_MODEL),
        'g_ffn': gain((DEPTH, D_MODEL)),
        'w_router_group': w((DEPTH, D_MODEL, N_EXPERT_GROUPS), D_MODEL),
        'b_router_group': 0.01 * jax.random.normal(next(ks), (DEPTH, N_EXPERT_GROUPS), f32),
        'w_router_expert': w((DEPTH, D_MODEL, N_EXPERTS), D_MODEL),
        'b_router_expert': 0.01 * jax.random.normal(next(ks), (DEPTH, N_EXPERTS), f32),
        'w_expert_gate': w((DEPTH, N_EXPERTS, D_MODEL, D_EXPERT), D_MODEL),
        'w_expert_up': w((DEPTH, N_EXPERTS, D_MODEL, D_EXPERT), D_MODEL),
        'w_expert_down': w((DEPTH, N_EXPERTS, D_EXPERT, D_MODEL), D_EXPERT),
        'g_final': gain((D_MODEL,)),
    }


def reference(x, mem, positions, g_mix, w_in_mla, g_q_lat, w_uq, g_kv_lat, w_ukv, w_in_pool, w_pool_mix, pool_scale, g_mem, w_mem_kv, w_o, g_ffn, w_router_group, b_router_group, w_router_expert, b_router_expert, w_expert_gate, w_expert_up, w_expert_down, g_final):
    B = x.shape[0]
    M = mem.shape[1]
    mem_kv = rmsnorm(mem, g_mem) @ w_mem_kv
    mem_k = mem_kv[..., :XATTN_WIDTH].reshape(B, M, XATTN_HEADS, XATTN_HEAD_DIM)
    mem_v = mem_kv[..., XATTN_WIDTH:].reshape(B, M, XATTN_HEADS, XATTN_HEAD_DIM)
    inv_freq = ROPE_THETA ** (-jnp.arange(0, QK_ROPE_DIM, 2, dtype=jnp.float32) / QK_ROPE_DIM)
    ang = positions.astype(jnp.float32)[..., None] * inv_freq
    cos = jnp.cos(ang).astype(x.dtype)
    sin = jnp.sin(ang).astype(x.dtype)
    for i in range(DEPTH):
        h = rmsnorm(x, g_mix[i])
        j = i // N_MIXERS
        if i % N_MIXERS == 0:
            z = h @ w_in_mla[j]
            mix = mla_mixer(z[..., :MLA_IN], g_q_lat[j], w_uq[j], g_kv_lat[j], w_ukv[j], cos, sin)
            qc = z[..., MLA_IN:]
        else:
            z = h @ w_in_pool[j]
            mix = multiscale_pool(z[..., :TOKEN_MIX_WIDTH], w_pool_mix[j], pool_scale[j])
            qc = z[..., TOKEN_MIX_WIDTH:]
        xa = memory_cross_attention(qc, mem_k, mem_v)
        x = x + jnp.concatenate([mix, xa], axis=-1) @ w_o[i]
        x = x + hierarchical_moe(rmsnorm(x, g_ffn[i]), w_router_group[i], b_router_group[i], w_router_expert[i], b_router_expert[i], w_expert_gate[i], w_expert_up[i], w_expert_down[i])
    return rmsnorm(x, g_final)
```

```cpp
#include <hip/hip_runtime.h>
#include <cstdio>
#include <cstdint>

#define LAS __attribute__((address_space(3)))
#define GAS __attribute__((address_space(1)))
typedef unsigned short bf16_t;
typedef short bf16x8 __attribute__((ext_vector_type(8)));
typedef short s16x4 __attribute__((ext_vector_type(4)));
typedef float f32x2 __attribute__((ext_vector_type(2)));
typedef float f32x4 __attribute__((ext_vector_type(4)));
typedef float f32x16 __attribute__((ext_vector_type(16)));
typedef unsigned u32x2 __attribute__((ext_vector_type(2)));
typedef unsigned u32x4 __attribute__((ext_vector_type(4)));
typedef __bf16 bf16x2_t __attribute__((ext_vector_type(2)));

constexpr int T = 65536, DM = 1024, SEQ = 2048, NB = 32, MEML = 256, TMEM = NB * MEML;
constexpr int NHEAD = 12, DQK = 96, DV = 64, QW = NHEAD * DQK  , KVW = NHEAD * DV  ;
constexpr float EPS = 1e-6f;
constexpr int NBUCKET = 112, CAP = 65536;
constexpr float LOG2E = 1.4426950408889634f;

constexpr size_t MiB = 1u << 20;
constexpr size_t WS_CTL = 0, CTL_ZERO_BYTES = 1 * MiB;
constexpr size_t WS_WINA = 1 * MiB;
constexpr size_t WS_WQKV = 3 * MiB;
constexpr size_t WS_WINP = 5 * MiB;
constexpr size_t WS_WPOOL = 7 * MiB;
constexpr size_t WS_WMEM = 8 * MiB;
constexpr size_t WS_WO = 9 * MiB;
constexpr size_t WS_WR = 13 * MiB;
constexpr size_t WS_WGU = 14 * MiB;
constexpr size_t WS_WD = 78 * MiB;
constexpr size_t WS_XS = 110 * MiB;
constexpr size_t WS_RSTD0 = 238 * MiB;
constexpr size_t WS_RSTDM = 238 * MiB + 512 * 1024;
constexpr size_t WS_CS = 239 * MiB, WS_SN = 243 * MiB;
constexpr size_t WS_MEMB = 247 * MiB;
constexpr size_t WS_MEMKV = 263 * MiB;
constexpr size_t WS_SSQQ = 271 * MiB, WS_SSQKV = 272 * MiB, WS_SSQX = 273 * MiB;
constexpr size_t WS_TOKW = 277 * MiB;
constexpr size_t WS_TOKR = 278 * MiB;
constexpr size_t WS_KROPE = 279 * MiB;
constexpr size_t WS_LIST = 283 * MiB;
constexpr size_t WS_QLAT = 311 * MiB, WS_QC = 343 * MiB, WS_KVLAT = 375 * MiB;
constexpr size_t WS_ACT = 311 * MiB;
constexpr size_t WS_Q = 407 * MiB, WS_KN = 551 * MiB, WS_V = 647 * MiB;
constexpr size_t WS_Z = 407 * MiB, WS_DG = 535 * MiB;
constexpr size_t WS_CONCAT = 743 * MiB;
constexpr size_t WS_END = 871 * MiB;
constexpr int CW_BAR = 4096, CW_CNT = 8192;

constexpr int RING_BYTES = 131072;
constexpr int L_MISC = RING_BYTES, L_LIST = RING_BYTES + 256, L_TAB = RING_BYTES + 256 + 2048, LDS_BYTES = RING_BYTES + 4096;

__device__ __forceinline__ unsigned pk2(float lo, float hi) { f32x2 v = {lo, hi}; bf16x2_t b = __builtin_convertvector(v, bf16x2_t); return __builtin_bit_cast(unsigned, b); }
__device__ __forceinline__ float bflo(unsigned w) { return __uint_as_float(w << 16); }
__device__ __forceinline__ float bfhi(unsigned w) { return __uint_as_float(w & 0xffff0000u); }
__device__ __forceinline__ u32x4 pack8(f32x4 a, f32x4 b) { u32x4 w; w.x = pk2(a[0], a[1]); w.y = pk2(a[2], a[3]); w.z = pk2(b[0], b[1]); w.w = pk2(b[2], b[3]); return w; }
__device__ __forceinline__ float wave_sum(float v) {
#pragma unroll
    for (int o = 1; o < 64; o <<= 1) v += __shfl_xor(v, o);
    return v;
}
#define LDS_WAIT() asm volatile("s_waitcnt lgkmcnt(0)" ::: "memory")
#define VM_WAIT() asm volatile("s_waitcnt vmcnt(0)" ::: "memory")

#define XB_TMO      128
#define XB_XCNT(j)  (256  + 64 * (j))
#define XB_XSUB(j)  (1280 + 64 * (j))
#define XB_XGEN(j)  (2304 + 64 * (j))
#define XB_TOP      3328
#define XB_TOPGEN   3392
#define XCD_BAR_WORDS 3456
#define XB_SPIN_CAP (1u << 18)
__device__ __forceinline__ unsigned xb_ld(unsigned* p)              { return __hip_atomic_load(p, __ATOMIC_RELAXED, __HIP_MEMORY_SCOPE_AGENT); }
__device__ __forceinline__ unsigned xb_add(unsigned* p, unsigned v) { return __hip_atomic_fetch_add(p, v, __ATOMIC_RELAXED, __HIP_MEMORY_SCOPE_AGENT); }
__device__ __forceinline__ unsigned xb_xcc_id() { return (unsigned)__builtin_amdgcn_s_getreg((3 << 11) | 20) & 0xFu; }
#define XB_SPIN(cond, bar) do { unsigned _sp = 0; while (cond) { __builtin_amdgcn_s_sleep(1); \
    if ((++_sp & 255u) == 0u) { if (xb_ld(&(bar)[XB_TMO])) break; if (_sp > XB_SPIN_CAP) { atomicAdd(&(bar)[XB_TMO], 1u); break; } } } } while (0)
struct XcdBarrier { unsigned* bar; unsigned x; volatile LAS unsigned* st; };
__device__ __forceinline__ XcdBarrier xcd_barrier_post(unsigned* bar, volatile LAS unsigned* st) {
    XcdBarrier b; b.bar = bar; b.x = xb_xcc_id(); b.st = st;
    if (threadIdx.x == 0) (void)xb_add(&bar[XB_XCNT(b.x)], 1u);
    return b;
}
__device__ __forceinline__ void xcd_barrier_complete(unsigned* bar, unsigned x, unsigned& nloc, unsigned& nx) {
    const unsigned G = gridDim.x * gridDim.y * gridDim.z;
    unsigned sum, cnt, mine, sp = 0u;
    for (;;) {
        sum = 0u; cnt = 0u; mine = 0u;
#pragma unroll
        for (unsigned j = 0; j < 16; ++j) { const unsigned c = xb_ld(&bar[XB_XCNT(j)]); sum += c; cnt += (c > 0u) ? 1u : 0u; mine = (j == x) ? c : mine; }
        if (sum == G) break;
        __builtin_amdgcn_s_sleep(1);
        if ((++sp & 255u) == 0u) { if (xb_ld(&bar[XB_TMO])) break; if (sp > XB_SPIN_CAP) { atomicAdd(&bar[XB_TMO], 1u); break; } }
    }
    nloc = mine > 0u ? mine : 1u; nx = cnt > 0u ? cnt : 1u;
}
__device__ __forceinline__ void xcd_barrier(const XcdBarrier& b) {
    asm volatile("s_waitcnt vmcnt(0)" ::: "memory");
    __syncthreads();
    if (threadIdx.x == 0) {
        unsigned zoff = 0u; asm volatile("" : "+s"(zoff));
        unsigned* bar = b.bar + zoff;
        __builtin_amdgcn_s_waitcnt(0);
        const unsigned bx = xb_xcc_id();
        unsigned nloc = b.st[0], nx = b.st[1];
        if (nloc == 0u) { xcd_barrier_complete(bar, bx, nloc, nx); b.st[0] = nloc; b.st[1] = nx; }
        const unsigned old = xb_add(&bar[XB_XSUB(bx)], 1u);
        const unsigned gen = old / nloc;
        if (old + 1u == (gen + 1u) * nloc) {
            __builtin_amdgcn_fence(__ATOMIC_RELEASE, "agent");
            asm volatile("s_waitcnt vmcnt(0)" ::: "memory");
            const unsigned og = xb_add(&bar[XB_TOP], 1u);
            const unsigned tg = og / nx;
            if (og + 1u == (tg + 1u) * nx) xb_add(&bar[XB_TOPGEN], 1u);
            else XB_SPIN(xb_ld(&bar[XB_TOPGEN]) == tg, bar);
            __builtin_amdgcn_fence(__ATOMIC_ACQUIRE, "agent");
            xb_add(&bar[XB_XGEN(bx)], 1u);
            asm volatile("s_waitcnt vmcnt(0)" ::: "memory");
        } else {
            XB_SPIN(xb_ld(&bar[XB_XGEN(bx)]) == gen, bar);
            __builtin_amdgcn_fence(__ATOMIC_ACQUIRE, "agent");
            asm volatile("s_waitcnt vmcnt(0)" ::: "memory");
        }
    }
    __syncthreads();
}

namespace pg8 {
constexpr int BM = 256, BK = 64, HALF = 128, HTB = HALF * BK * 2, NXCD = 8, WGM = 8;
__host__ __device__ __forceinline__ int lds_byte(int r, int c) { const int st = (r >> 4) * 2 + (c >> 5), rr = r & 15, cc = c & 31, ob = rr * 64 + cc * 2; return st * 1024 + (ob ^ (((ob >> 9) & 1) << 5)); }
__host__ __device__ __forceinline__ void stage_rc(int b, int& R, int& C) { const int st = b / 1024, sb = b % 1024, swz = sb ^ (((sb >> 9) & 1) << 5); R = (st >> 1) * 16 + swz / 64; C = (st & 1) * 32 + (swz % 64) / 2; }
__host__ __device__ __forceinline__ int perm32(int rho) { const int n = rho >> 4, i = rho & 15; return 8 * (i >> 2) + 4 * n + (i & 3); }

struct Unit { const char* A; const char* B; int bjump; int nvalid; const int* list; int pm, pn, aux; };

struct TileOrder {
    int nM, nN, nwg, G, c;
    __device__ __forceinline__ void init(int nM_, int nN_, int G_, int c_) { nM = nM_; nN = nN_; nwg = nM * nN; G = G_; c = c_; }
    __device__ __forceinline__ bool get(int i, int& pm, int& pn) const {
        const long L = (long)i * G + c; if (L >= nwg) return false;
        int wgid = (int)L; { const int q = nwg / NXCD, r = nwg % NXCD, xcd = wgid % NXCD, off = wgid / NXCD; wgid = (xcd < r ? xcd * (q + 1) : r * (q + 1) + (xcd - r) * q) + off; }
        const int nig = WGM * nN, gid = wgid / nig, fm = gid * WGM, gsz = (nM - fm) < WGM ? (nM - fm) : WGM;
        pm = fm + ((wgid % nig) % gsz); pn = (wgid % nig) / gsz; return true;
    }
};

template <class Epi, class Sched, bool GATHER>
__device__ __forceinline__ void gemm_run(LAS unsigned char* lds, LAS unsigned char* listbuf, const Sched& S, const Epi& E, const int nt, const int jt, const unsigned lda2, const unsigned ldb2) {
    int tid = threadIdx.x; asm volatile("" : "+v"(tid));
    const int wid = __builtin_amdgcn_readfirstlane(tid >> 6), lane = tid & 63, wr = wid >> 2, wc = wid & 3, fr = lane & 15, fq = lane >> 4;
    int Rr[2]; unsigned Cc[2], voffB[2];
#pragma unroll
    for (int i = 0; i < 2; ++i) { int R, C; stage_rc(tid * 16 + i * 8192, R, C); const int Rb = (R & ~31) + perm32(R & 31); Rr[i] = R; Cc[i] = (unsigned)C * 2u; voffB[i] = (unsigned)Rb * ldb2 + (unsigned)C * 2u; }
    const size_t kstep = (size_t)(BK * 2);
    const size_t hstepB = (size_t)HALF * ldb2;
    const size_t hstepA = GATHER ? (size_t)0 : (size_t)HALF * lda2;
    const unsigned ldsw = (unsigned)wid * 1024u;
    const int aoff = lds_byte(wr * 64 + fr, fq * 8), boff = lds_byte(wc * 32 + fr, fq * 8);
#define PG8_SA(b, h) (((b) * 2 + (h)) * HTB)
#define PG8_SB(b, h) ((4 + (b) * 2 + (h)) * HTB)
#define PG8_STAGE(bufoff, gbase, voff) do { _Pragma("unroll") for (int _i = 0; _i < 2; ++_i) \
        __builtin_amdgcn_global_load_lds((const unsigned*)((const char*)(gbase) + (voff)[_i]), (LAS unsigned*)(lds + (bufoff) + ldsw + _i * 8192), 16, 0, 0); } while (0)
#define PG8_LDA(dst, b, h) do { _Pragma("unroll") for (int m = 0; m < 4; ++m) _Pragma("unroll") for (int k = 0; k < 2; ++k) dst[m][k] = *(const LAS bf16x8*)(lds + PG8_SA(b, h) + aoff + m * 2048 + k * 1024); } while (0)
#define PG8_LDB(dst, b, h) do { _Pragma("unroll") for (int n = 0; n < 2; ++n) _Pragma("unroll") for (int k = 0; k < 2; ++k) dst[n][k] = *(const LAS bf16x8*)(lds + PG8_SB(b, h) + boff + n * 2048 + k * 1024); } while (0)
#define PG8_MMA(ai, bj, At, Bt) do { __builtin_amdgcn_s_setprio(1); _Pragma("unroll") for (int m = 0; m < 4; ++m) _Pragma("unroll") for (int n = 0; n < 2; ++n) _Pragma("unroll") for (int k = 0; k < 2; ++k) \
        acc[ai][bj][m][n] = __builtin_amdgcn_mfma_f32_16x16x32_bf16(Bt[n][k], At[m][k], acc[ai][bj][m][n], 0, 0, 0); __builtin_amdgcn_s_setprio(0); } while (0)
#define PG8_WAIT_V(n) asm volatile("s_waitcnt vmcnt(" #n ")" ::: "memory")
#define PG8_WAIT_L(n) asm volatile("s_waitcnt lgkmcnt(" #n ")" ::: "memory")
#define PG8_BAR __builtin_amdgcn_s_barrier()
#define PG8_SCHED __builtin_amdgcn_sched_barrier(0)
#define PG8_BPTR(X, tt) ((X).B + (size_t)(tt) * kstep + (((tt) >= jt) ? (X).bjump : 0))
    Unit cur, nxt; int ui = 0;
    if (!S.next(0, cur)) return;
    unsigned offA[2][2], offN[2][2];
#pragma unroll
    for (int h = 0; h < 2; ++h)
#pragma unroll
        for (int i = 0; i < 2; ++i) {
            const int row = h * HALF + Rr[i];
            if constexpr (GATHER) { int idx = cur.list[row]; if (row >= cur.nvalid) idx = 0; offA[h][i] = (unsigned)idx * lda2 + Cc[i]; }
            else offA[h][i] = (unsigned)Rr[i] * lda2 + Cc[i];
            offN[h][i] = offA[h][i];
        }
    f32x4 acc[2][2][4][2];
#pragma unroll
    for (int a = 0; a < 2; ++a)
#pragma unroll
        for (int b = 0; b < 2; ++b)
#pragma unroll
            for (int m = 0; m < 4; ++m)
#pragma unroll
                for (int n = 0; n < 2; ++n) acc[a][b][m][n] = (f32x4){0.f, 0.f, 0.f, 0.f};
    bf16x8 At[4][2], B0[2][2], B1[2][2];
    {
        const char* cA = cur.A; const char* cB = cur.B;
        PG8_STAGE(PG8_SB(0, 0), cB, voffB); PG8_STAGE(PG8_SB(0, 1), cB + hstepB, voffB); PG8_STAGE(PG8_SA(0, 0), cA, offA[0]); PG8_STAGE(PG8_SA(0, 1), cA + hstepA, offA[1]);
        if (wr == 1) PG8_BAR;
        PG8_WAIT_V(2); PG8_BAR;
        const char* cB1 = PG8_BPTR(cur, 1);
        PG8_STAGE(PG8_SB(1, 0), cB1, voffB); PG8_STAGE(PG8_SA(1, 0), cA + kstep, offA[0]); PG8_STAGE(PG8_SB(1, 1), cB1 + hstepB, voffB);
        PG8_WAIT_V(6); PG8_BAR;
    }
    for (;;) {
        const bool has_next = S.next(ui + 1, nxt);
        if constexpr (GATHER) {
            if (has_next) __builtin_amdgcn_global_load_lds((const unsigned*)((const char*)nxt.list + lane * 16), (LAS unsigned*)(listbuf + ((ui + 1) & 1) * 1024), 16, 0, 0);
        }
        const char* cA = cur.A;
        const char* nA = has_next ? nxt.A : cur.A;
        const char* nB0 = has_next ? nxt.B : cur.B;
        const char* nB1 = has_next ? PG8_BPTR(nxt, 1) : PG8_BPTR(cur, 1);
#pragma unroll 1
        for (int t = 0; t < nt; t += 2) {
            const bool last = (t == nt - 2);
            if constexpr (GATHER) {
                if (last && has_next) {
                    const LAS int* lb = (const LAS int*)(listbuf + ((ui + 1) & 1) * 1024);
#pragma unroll
                    for (int h = 0; h < 2; ++h)
#pragma unroll
                        for (int i = 0; i < 2; ++i) { const int row = h * HALF + Rr[i]; int idx = lb[row]; if (row >= nxt.nvalid) idx = 0; offN[h][i] = (unsigned)idx * lda2 + Cc[i]; }
                }
            }
            const char* a1 = cA + (size_t)(t + 1) * kstep;
            const char* a2 = last ? nA : cA + (size_t)(t + 2) * kstep; const char* b2 = last ? nB0 : PG8_BPTR(cur, t + 2);
            const char* a3 = a2 + kstep;                              const char* b3 = last ? nB1 : PG8_BPTR(cur, t + 3);
            unsigned o2[2][2];
#pragma unroll
            for (int h = 0; h < 2; ++h)
#pragma unroll
                for (int i = 0; i < 2; ++i) o2[h][i] = (GATHER && last) ? offN[h][i] : offA[h][i];
            PG8_LDB(B0, 0, 0); PG8_LDB(B1, 0, 1); PG8_SCHED; PG8_LDA(At, 0, 0); PG8_STAGE(PG8_SA(1, 1), a1 + hstepA, offA[1]);
            PG8_WAIT_V(8); PG8_WAIT_L(0); PG8_BAR; PG8_MMA(0, 0, At, B0); PG8_MMA(0, 1, At, B1); PG8_BAR; PG8_SCHED;
            PG8_LDA(At, 0, 1); PG8_STAGE(PG8_SB(0, 0), b2, voffB); PG8_STAGE(PG8_SB(0, 1), b2 + hstepB, voffB); PG8_STAGE(PG8_SA(0, 0), a2, o2[0]);
            PG8_WAIT_V(8); PG8_WAIT_L(0); PG8_BAR; PG8_MMA(1, 0, At, B0); PG8_MMA(1, 1, At, B1); PG8_BAR; PG8_SCHED;
            PG8_LDB(B0, 1, 0); PG8_LDB(B1, 1, 1); PG8_SCHED; PG8_LDA(At, 1, 0); PG8_STAGE(PG8_SA(0, 1), a2 + hstepA, o2[1]);
            PG8_WAIT_V(8); PG8_WAIT_L(0); PG8_BAR; PG8_MMA(0, 0, At, B0); PG8_MMA(0, 1, At, B1); PG8_BAR; PG8_SCHED;
            PG8_LDA(At, 1, 1); PG8_STAGE(PG8_SB(1, 0), b3, voffB); PG8_STAGE(PG8_SB(1, 1), b3 + hstepB, voffB); PG8_STAGE(PG8_SA(1, 0), a3, o2[0]);
            PG8_WAIT_V(8); PG8_WAIT_L(0); PG8_BAR; PG8_MMA(1, 0, At, B0); PG8_MMA(1, 1, At, B1); PG8_BAR; PG8_SCHED;
        }
        if (wr == 0) PG8_BAR;
        E(acc, cur, wr, wc, fr, fq);
        if (!has_next) break;
#pragma unroll
        for (int a = 0; a < 2; ++a)
#pragma unroll
            for (int b = 0; b < 2; ++b)
#pragma unroll
                for (int m = 0; m < 4; ++m)
#pragma unroll
                    for (int n = 0; n < 2; ++n) acc[a][b][m][n] = (f32x4){0.f, 0.f, 0.f, 0.f};
        cur = nxt; ++ui;
        if constexpr (GATHER) {
#pragma unroll
            for (int h = 0; h < 2; ++h)
#pragma unroll
                for (int i = 0; i < 2; ++i) offA[h][i] = offN[h][i];
        }
        if (wr == 1) PG8_BAR;
    }
    PG8_WAIT_V(0);
    PG8_BAR;
#undef PG8_SA
#undef PG8_SB
#undef PG8_STAGE
#undef PG8_LDA
#undef PG8_LDB
#undef PG8_MMA
#undef PG8_WAIT_V
#undef PG8_WAIT_L
#undef PG8_BAR
#undef PG8_SCHED
#undef PG8_BPTR
}
}
using pg8::Unit;

struct SchedPlain {
    pg8::TileOrder o; const char* A; const char* B; size_t a_tile, b_tile;
    __device__ __forceinline__ bool next(int i, Unit& u) const { int pm, pn; if (!o.get(i, pm, pn)) return false;
        u.A = A + (size_t)pm * a_tile; u.B = B + (size_t)pn * b_tile; u.bjump = 0; u.nvalid = 256; u.list = nullptr; u.pm = pm; u.pn = pn; u.aux = 0; return true; }
};
struct SchedQKV {
    pg8::TileOrder o; const char* Aq; const char* Akv; const char* B;
    __device__ __forceinline__ bool next(int i, Unit& u) const { int pm, pn; if (!o.get(i, pm, pn)) return false;
        u.A = (pn < 5 ? Aq : Akv) + (size_t)pm * (256 * 512); u.B = B + (size_t)pn * (256 * 512); u.bjump = 0; u.nvalid = 256; u.list = nullptr; u.pm = pm; u.pn = pn; u.aux = 0; return true; }
};
struct SchedPool {
    pg8::TileOrder o; const char* A; const char* B;
    __device__ __forceinline__ bool next(int i, Unit& u) const { int pm, pn; if (!o.get(i, pm, pn)) return false;
        u.A = A + ((size_t)pn * T + (size_t)pm * 256) * 512; u.B = B + (size_t)pn * (256 * 512); u.bjump = 0; u.nvalid = 256; u.list = nullptr; u.pm = pm; u.pn = pn; u.aux = 0; return true; }
};
__device__ __forceinline__ void pair_decode(int p, int& lo, int& hi) { int l = 0, rem = p; while (rem >= 7 - l) { rem -= 7 - l; ++l; } lo = l; hi = l + 1 + rem; }
template <bool DOWN> struct SchedMoe {
    const LAS int* tab; int G, c; const char* A; const char* W; const int* list;
    __device__ __forceinline__ bool next(int i, Unit& u) const {
        const int ntile = tab[NBUCKET]; const long L = (long)i * G + c; if (L >= (long)ntile * 4) return false;
        const int tile = (int)(L >> 2), pn = (int)(L & 3);
        int lo_ = 0, hi_ = NBUCKET - 1;
        while (lo_ < hi_) { const int mid = (lo_ + hi_ + 1) >> 1; if (tab[mid] <= tile) lo_ = mid; else hi_ = mid - 1; }
        const int b = __builtin_amdgcn_readfirstlane(lo_);
        const int tib = tile - __builtin_amdgcn_readfirstlane(tab[b]), cnt = __builtin_amdgcn_readfirstlane(tab[128 + b]);
        int elo, ehi; pair_decode(b % 28, elo, ehi); const int g = b / 28;
        u.nvalid = min(256, cnt - tib * 256); u.list = list + (size_t)b * CAP + tib * 256; u.pm = tile; u.pn = pn; u.aux = tile * 256;
        if (!DOWN) { u.A = A; u.B = W + ((size_t)(g * 8 + (pn < 2 ? elo : ehi)) * 512 + (pn & 1) * 256) * 2048; u.bjump = 0; }
        else { u.A = A + (size_t)tile * (256 * 1024); u.B = W + (size_t)g * (1024 * 4096) + (size_t)pn * (256 * 4096) + elo * 512; u.bjump = (ehi - elo - 1) * 512; }
        return true;
    }
};

#define EPI_ROWS(ai, m) (128 * (ai) + 64 * wr + 16 * (m) + fr)
#define EPI_COL(bj) (128 * (bj) + 32 * wc + 8 * fq)
#define EPI_FENCE asm volatile("" ::: "memory")
typedef f32x4 acc_t[2][2][4][2];

struct EpiRowScale {
    bf16_t* O; int ldc; const float* rs;
    __device__ __forceinline__ void operator()(const acc_t& acc, const Unit& u, int wr, int wc, int fr, int fq) const {
#pragma unroll
        for (int ai = 0; ai < 2; ++ai)
#pragma unroll
            for (int m = 0; m < 4; ++m) { EPI_FENCE; const int r = u.pm * 256 + EPI_ROWS(ai, m); const float s = rs[r];
#pragma unroll
                for (int bj = 0; bj < 2; ++bj) *(u32x4*)(O + (size_t)r * ldc + u.pn * 256 + EPI_COL(bj)) = pack8(acc[ai][bj][m][0] * s, acc[ai][bj][m][1] * s); }
    }
};
__device__ __forceinline__ void rope8(f32x4& v0, f32x4& v1, const float* cs, const float* sn, int r, int fq) {
    const f32x4 c0 = *(const f32x4*)(cs + (size_t)r * 16 + 8 * (fq & 1)), c1 = *(const f32x4*)(cs + (size_t)r * 16 + 8 * (fq & 1) + 4);
    const f32x4 s0 = *(const f32x4*)(sn + (size_t)r * 16 + 8 * (fq & 1)), s1 = *(const f32x4*)(sn + (size_t)r * 16 + 8 * (fq & 1) + 4);
    f32x4 p0, p1;
#pragma unroll
    for (int j = 0; j < 4; ++j) { p0[j] = __shfl_xor(v0[j], 32); p1[j] = __shfl_xor(v1[j], 32); }
    const float sg = (fq < 2) ? -1.f : 1.f;
    v0 = v0 * c0 + (p0 * s0) * sg; v1 = v1 * c1 + (p1 * s1) * sg;
}
struct EpiInA {
    const float* rstd0; bf16_t* qlat; bf16_t* qc; bf16_t* kvlat; bf16_t* krope; float* ssqq; float* ssqkv; const float* cs; const float* sn; float qcscale;
    __device__ __forceinline__ void operator()(const acc_t& acc, const Unit& u, int wr, int wc, int fr, int fq) const {
#pragma unroll
        for (int ai = 0; ai < 2; ++ai)
#pragma unroll
            for (int m = 0; m < 4; ++m) { EPI_FENCE; const int r = u.pm * 256 + EPI_ROWS(ai, m); const float s = rstd0[r];
                f32x4 v[2][2];
#pragma unroll
                for (int bj = 0; bj < 2; ++bj) { v[bj][0] = acc[ai][bj][m][0] * s; v[bj][1] = acc[ai][bj][m][1] * s; }
                if (u.pn == 0) {
                    float ss = 0.f;
#pragma unroll
                    for (int bj = 0; bj < 2; ++bj) { *(u32x4*)(qlat + (size_t)r * 256 + EPI_COL(bj)) = pack8(v[bj][0], v[bj][1]);
#pragma unroll
                        for (int n = 0; n < 2; ++n) ss += (v[bj][n][0] * v[bj][n][0] + v[bj][n][1] * v[bj][n][1]) + (v[bj][n][2] * v[bj][n][2] + v[bj][n][3] * v[bj][n][3]); }
                    ss += __shfl_xor(ss, 16); ss += __shfl_xor(ss, 32);
                    if (fq == 0) ssqq[(size_t)r * 4 + wc] = ss;
                } else if (u.pn == 1) {
#pragma unroll
                    for (int bj = 0; bj < 2; ++bj) *(u32x4*)(qc + (size_t)r * 256 + EPI_COL(bj)) = pack8(v[bj][0] * qcscale, v[bj][1] * qcscale);
                } else {
                    float ss = 0.f;
#pragma unroll
                    for (int n = 0; n < 2; ++n) ss += (v[0][n][0] * v[0][n][0] + v[0][n][1] * v[0][n][1]) + (v[0][n][2] * v[0][n][2] + v[0][n][3] * v[0][n][3]);
                    ss += __shfl_xor(ss, 16); ss += __shfl_xor(ss, 32);
                    if (fq == 0) ssqkv[(size_t)r * 4 + wc] = ss;
                    *(u32x4*)(kvlat + (size_t)r * 256 + EPI_COL(0)) = pack8(v[0][0], v[0][1]);
                    *(u32x4*)(kvlat + (size_t)r * 256 + EPI_COL(1)) = (u32x4){0u, 0u, 0u, 0u};
                    if (wc == 0) { f32x4 a = v[1][0], b = v[1][1]; rope8(a, b, cs, sn, r, fq); *(u32x4*)(krope + (size_t)r * 32 + 8 * fq) = pack8(a, b); }
                }
            }
    }
};
struct EpiQKV {
    const float* ssqq; const float* ssqkv; bf16_t* Q; bf16_t* KN; bf16_t* V; const float* cs; const float* sn; float qscale;
    __device__ __forceinline__ void operator()(const acc_t& acc, const Unit& u, int wr, int wc, int fr, int fq) const {
        const bool isq = u.pn < 5;
#pragma unroll
        for (int ai = 0; ai < 2; ++ai)
#pragma unroll
            for (int m = 0; m < 4; ++m) { EPI_FENCE; const int r = u.pm * 256 + EPI_ROWS(ai, m);
                const f32x4 p4 = *(const f32x4*)((isq ? ssqq : ssqkv) + (size_t)r * 4);
                const float rs = 1.0f / sqrtf(((p4[0] + p4[1]) + (p4[2] + p4[3])) * (isq ? (1.f / 256.f) : (1.f / 128.f)) + EPS);
#pragma unroll
                for (int bj = 0; bj < 2; ++bj) {
                    f32x4 v0 = acc[ai][bj][m][0] * rs, v1 = acc[ai][bj][m][1] * rs;
                    if (isq) { const int g32 = u.pn * 8 + bj * 4 + wc;
                        if (g32 < 36) { if (g32 % 3 == 2) rope8(v0, v1, cs, sn, r, fq);
                            *(u32x4*)(Q + (size_t)r * QW + g32 * 32 + 8 * fq) = pack8(v0 * qscale, v1 * qscale); }
                    } else { const int g32 = (u.pn - 5) * 8 + bj * 4 + wc, h = g32 >> 2, part = g32 & 3;
                        bf16_t* dst = (part < 2 ? KN : V) + (size_t)r * KVW + h * 64 + (part & 1) * 32 + 8 * fq;
                        *(u32x4*)dst = pack8(v0, v1); }
                }
            }
    }
};
struct EpiWo {
    int layer; const float* x; bf16_t* XS;
    __device__ __forceinline__ void operator()(const acc_t& acc, const Unit& u, int wr, int wc, int fr, int fq) const {
#pragma unroll
        for (int ai = 0; ai < 2; ++ai)
#pragma unroll
            for (int m = 0; m < 4; ++m) { EPI_FENCE; const int r = u.pm * 256 + EPI_ROWS(ai, m);
#pragma unroll
                for (int bj = 0; bj < 2; ++bj) { const size_t off = (size_t)r * DM + u.pn * 256 + EPI_COL(bj); f32x4 a, b;
                    if (layer == 0) { a = *(const f32x4*)(x + off); b = *(const f32x4*)(x + off + 4); }
                    else { const u32x4 w = *(const u32x4*)(XS + off); a = (f32x4){bflo(w.x), bfhi(w.x), bflo(w.y), bfhi(w.y)}; b = (f32x4){bflo(w.z), bfhi(w.z), bflo(w.w), bfhi(w.w)}; }
                    *(u32x4*)(XS + off) = pack8(acc[ai][bj][m][0] + a, acc[ai][bj][m][1] + b); }
            }
    }
};
struct EpiMoeUp {
    const float* tokr; const float* tokw; bf16_t* ACT;
    __device__ __forceinline__ void operator()(const acc_t& acc, const Unit& u, int wr, int wc, int fr, int fq) const {
#pragma unroll
        for (int ai = 0; ai < 2; ++ai)
#pragma unroll
            for (int m = 0; m < 4; ++m) { EPI_FENCE; const int lr = EPI_ROWS(ai, m); const int tok = (lr < u.nvalid) ? u.list[lr] : 0;
                const float rs = tokr[tok], w = tokw[(size_t)tok * 2 + (u.pn >> 1)];
#pragma unroll
                for (int bj = 0; bj < 2; ++bj) { const f32x4 g = acc[ai][bj][m][0] * rs, up = acc[ai][bj][m][1] * rs; f32x4 a;
#pragma unroll
                    for (int j = 0; j < 4; ++j) a[j] = g[j] * __builtin_amdgcn_rcpf(1.0f + __builtin_amdgcn_exp2f(-g[j] * LOG2E)) * up[j] * w;
                    u32x2 o; o.x = pk2(a[0], a[1]); o.y = pk2(a[2], a[3]);
                    *(u32x2*)(ACT + (size_t)(u.aux + lr) * 512 + (u.pn >> 1) * 256 + (u.pn & 1) * 128 + bj * 64 + 16 * wc + 4 * fq) = o; }
            }
    }
};
struct EpiMoeDown {
    bf16_t* XS; float* ssq;
    __device__ __forceinline__ void operator()(const acc_t& acc, const Unit& u, int wr, int wc, int fr, int fq) const {
#pragma unroll
        for (int ai = 0; ai < 2; ++ai)
#pragma unroll
            for (int m = 0; m < 4; ++m) { EPI_FENCE; const int lr = EPI_ROWS(ai, m); const bool ok = lr < u.nvalid; const int tok = ok ? u.list[lr] : 0; float ss = 0.f;
#pragma unroll
                for (int bj = 0; bj < 2; ++bj) { const size_t off = (size_t)tok * DM + u.pn * 256 + EPI_COL(bj);
                    const u32x4 w = *(const u32x4*)(XS + off);
                    const f32x4 a = acc[ai][bj][m][0] + (f32x4){bflo(w.x), bfhi(w.x), bflo(w.y), bfhi(w.y)}, b = acc[ai][bj][m][1] + (f32x4){bflo(w.z), bfhi(w.z), bflo(w.w), bfhi(w.w)};
                    ss += (a[0] * a[0] + a[1] * a[1]) + (a[2] * a[2] + a[3] * a[3]) + (b[0] * b[0] + b[1] * b[1]) + (b[2] * b[2] + b[3] * b[3]);
                    if (ok) *(u32x4*)(XS + off) = pack8(a, b); }
                ss += __shfl_xor(ss, 16); ss += __shfl_xor(ss, 32);
                if (ok && fq == 0) ssq[(size_t)tok * 16 + u.pn * 4 + wc] = ss;
            }
    }
};
struct EpiInP {
    const float* ssq; bf16_t* Z; float qcscale;
    __device__ __forceinline__ void operator()(const acc_t& acc, const Unit& u, int wr, int wc, int fr, int fq) const {
        const float cscale = (u.pn == 3) ? qcscale : 1.0f;
#pragma unroll
        for (int ai = 0; ai < 2; ++ai)
#pragma unroll
            for (int m = 0; m < 4; ++m) { EPI_FENCE; const int r = u.pm * 256 + EPI_ROWS(ai, m); const f32x4* p = (const f32x4*)(ssq + (size_t)r * 16);
                const f32x4 s4 = (p[0] + p[1]) + (p[2] + p[3]); const float rs = cscale / sqrtf(((s4[0] + s4[1]) + (s4[2] + s4[3])) * (1.f / 1024.f) + EPS);
#pragma unroll
                for (int bj = 0; bj < 2; ++bj) *(u32x4*)(Z + (size_t)r * DM + u.pn * 256 + EPI_COL(bj)) = pack8(acc[ai][bj][m][0] * rs, acc[ai][bj][m][1] * rs); }
    }
};
struct EpiPool {
    const float* scale; bf16_t* CC;
    __device__ __forceinline__ void operator()(const acc_t& acc, const Unit& u, int wr, int wc, int fr, int fq) const {
#pragma unroll
        for (int bj = 0; bj < 2; ++bj) { const int cl = EPI_COL(bj); if (cl < 192) { const int col = u.pn * 192 + cl;
            const f32x4 s0 = *(const f32x4*)(scale + col), s1 = *(const f32x4*)(scale + col + 4);
#pragma unroll
            for (int ai = 0; ai < 2; ++ai)
#pragma unroll
                for (int m = 0; m < 4; ++m) { EPI_FENCE; const int r = u.pm * 256 + EPI_ROWS(ai, m); *(u32x4*)(CC + (size_t)r * DM + col) = pack8(acc[ai][bj][m][0] * s0, acc[ai][bj][m][1] * s1); } } }
    }
};

namespace att {
__device__ __forceinline__ int crow(int r, int hi) { return (r & 3) + 8 * (r >> 2) + 4 * hi; }
template <int DQ, bool CAUSAL>
__device__ __forceinline__ void attn_unit(LAS unsigned char* L, const bf16_t* Qw, int ldq, const bf16_t* Kn, int ldk, const bf16_t* Kr, int ldkr,
                                          const bf16_t* Vp, int ldv, bf16_t* Ow, int ldo, const int NT, const int wid, const int lane) {
    constexpr int ND = DQ / 16, NCH = DQ / 8, KSL = NCH * 1024, LV = 2 * KSL, LWS = LV + 16384, LOST = LWS + 2048;
    const int r32 = lane & 31, hi = lane >> 5;
    LAS float* wsf = (LAS float*)(L + LWS) + wid * 64;
#define ATT_DMA(t, slot) do { \
        __builtin_amdgcn_global_load_lds((const unsigned*)(Kn + (size_t)((t) * 64 + lane) * ldk + wid * 8), (LAS unsigned*)(L + (slot) * KSL + wid * 1024), 16, 0, 0); \
        if (NCH > 8 && wid < NCH - 8) __builtin_amdgcn_global_load_lds((const unsigned*)(Kr + (size_t)((t) * 64 + lane) * ldkr + wid * 8), (LAS unsigned*)(L + (slot) * KSL + (8 + wid) * 1024), 16, 0, 0); \
        __builtin_amdgcn_global_load_lds((const unsigned*)(Vp + (size_t)((t) * 64 + 16 * (wid & 3) + (lane >> 2)) * ldv + (wid >> 2) * 32 + (lane & 3) * 8), (LAS unsigned*)(L + LV + (slot) * 8192 + wid * 1024), 16, 0, 0); } while (0)
    ATT_DMA(0, 0);
    bf16x8 qr[ND];
#pragma unroll
    for (int d0 = 0; d0 < ND; ++d0) qr[d0] = *(const bf16x8*)(Qw + (size_t)(wid * 32 + r32) * ldq + d0 * 16 + hi * 8);
    f32x16 o0 = {}, o1 = {};
    float mrun = -1e30f, lrun = 0.f;
    const int vb0 = ((lane >> 4) & 1) * 32 + (lane & 3) * 8 + (4 * hi + ((lane & 15) >> 2)) * 64;
    asm volatile("s_waitcnt vmcnt(0) lgkmcnt(0)" ::: "memory"); __builtin_amdgcn_s_barrier(); asm volatile("" ::: "memory");
    for (int t = 0; t < NT; ++t) {
        const int slot = t & 1;
        if (t + 1 < NT) ATT_DMA(t + 1, slot ^ 1);
        const int jb = t - (NT - 4);
        const bool skip = CAUSAL && jb >= 0 && (64 * jb > 32 * wid + 31);
        if (!skip) {
            f32x16 p0 = {}, p1 = {};
            const LAS unsigned char* kb = L + slot * KSL + hi * 1024 + r32 * 16;
#pragma unroll
            for (int d0 = 0; d0 < ND; ++d0) {
                const bf16x8 b0 = *(const LAS bf16x8*)(kb + d0 * 2048), b1 = *(const LAS bf16x8*)(kb + d0 * 2048 + 512);
                p0 = __builtin_amdgcn_mfma_f32_32x32x16_bf16(b0, qr[d0], p0, 0, 0, 0);
                p1 = __builtin_amdgcn_mfma_f32_32x32x16_bf16(b1, qr[d0], p1, 0, 0, 0);
            }
            if (CAUSAL && jb >= 0) { const int qrel = wid * 32 + r32, kbase = 64 * jb + 4 * hi;
#pragma unroll
                for (int r = 0; r < 16; ++r) { const int kv = kbase + (r & 3) + 8 * (r >> 2); if (kv > qrel) p0[r] = -INFINITY; if (kv + 32 > qrel) p1[r] = -INFINITY; } }
            float rm = fmaxf(p0[0], p1[0]);
#pragma unroll
            for (int r = 1; r < 16; ++r) rm = fmaxf(rm, fmaxf(p0[r], p1[r]));
            rm = fmaxf(rm, __shfl_xor(rm, 32));
            const float mnew = fmaxf(mrun, rm), f = __builtin_amdgcn_exp2f(mrun - mnew);
            mrun = mnew;
            float sacc = 0.f;
#pragma unroll
            for (int r = 0; r < 16; ++r) { p0[r] = __builtin_amdgcn_exp2f(p0[r] - mnew); p1[r] = __builtin_amdgcn_exp2f(p1[r] - mnew); sacc += p0[r] + p1[r]; }
            lrun = lrun * f + sacc;
            if (__any(f != 1.0f)) {
                if (hi == 0) wsf[r32] = f;
                LDS_WAIT();
#pragma unroll
                for (int r = 0; r < 16; ++r) { const float ff = wsf[crow(r, hi)]; o0[r] *= ff; o1[r] *= ff; }
            }
            u32x4 pw[4];
#pragma unroll
            for (int k = 0; k < 2; ++k) { pw[k] = (u32x4){pk2(p0[8 * k], p0[8 * k + 1]), pk2(p0[8 * k + 2], p0[8 * k + 3]), pk2(p0[8 * k + 4], p0[8 * k + 5]), pk2(p0[8 * k + 6], p0[8 * k + 7])};
                                          pw[2 + k] = (u32x4){pk2(p1[8 * k], p1[8 * k + 1]), pk2(p1[8 * k + 2], p1[8 * k + 3]), pk2(p1[8 * k + 4], p1[8 * k + 5]), pk2(p1[8 * k + 6], p1[8 * k + 7])}; }
            const LAS unsigned char* vp = L + LV + slot * 8192 + vb0;
#pragma unroll
            for (int d0 = 0; d0 < 2; ++d0) {
#pragma unroll
                for (int ks = 0; ks < 4; ++ks) {
                    const s16x4 lo = __builtin_bit_cast(s16x4, __builtin_amdgcn_ds_read_tr16_b64_v4i16((LAS s16x4*)(vp + d0 * 4096 + ks * 1024)));
                    const s16x4 hh = __builtin_bit_cast(s16x4, __builtin_amdgcn_ds_read_tr16_b64_v4i16((LAS s16x4*)(vp + d0 * 4096 + ks * 1024 + 512)));
                    const bf16x8 vf = (bf16x8){lo[0], lo[1], lo[2], lo[3], hh[0], hh[1], hh[2], hh[3]};
                    if (d0 == 0) o0 = __builtin_amdgcn_mfma_f32_32x32x16_bf16(__builtin_bit_cast(bf16x8, pw[ks]), vf, o0, 0, 0, 0);
                    else         o1 = __builtin_amdgcn_mfma_f32_32x32x16_bf16(__builtin_bit_cast(bf16x8, pw[ks]), vf, o1, 0, 0, 0);
                }
            }
        }
        asm volatile("s_waitcnt vmcnt(0) lgkmcnt(0)" ::: "memory"); __builtin_amdgcn_s_barrier(); asm volatile("" ::: "memory");
    }
    lrun += __shfl_xor(lrun, 32);
    if (hi == 0) wsf[32 + r32] = lrun;
    LDS_WAIT();
    bf16_t LAS* stg = (bf16_t LAS*)(L + LOST) + wid * 2048;
#pragma unroll
    for (int r = 0; r < 16; ++r) { const int orow = crow(r, hi); const float rl = __builtin_amdgcn_rcpf(wsf[32 + orow]);
        stg[orow * 64 + r32] = (bf16_t)(pk2(o0[r] * rl, 0.f) & 0xffffu); stg[orow * 64 + 32 + r32] = (bf16_t)(pk2(o1[r] * rl, 0.f) & 0xffffu); }
    LDS_WAIT();
#pragma unroll
    for (int i = 0; i < 4; ++i) { const int row = i * 8 + (lane >> 3), ch = lane & 7; const u32x4 v = *(const LAS u32x4*)(stg + row * 64 + ch * 8); *(u32x4*)(Ow + (size_t)(wid * 32 + row) * ldo + ch * 8) = v; }
    asm volatile("s_waitcnt lgkmcnt(0)" ::: "memory"); __builtin_amdgcn_s_barrier(); asm volatile("" ::: "memory");
#undef ATT_DMA
}
}

struct Args { const float* in[24]; float* out; unsigned char* ws; };
struct Frame { LAS unsigned char* lds; unsigned* ctl; int tid, lane, wave, vcu, G; };
__device__ __forceinline__ Frame phase_frame(const Frame& F0) { Frame F = F0; int t = threadIdx.x; asm volatile("" : "+v"(t)); F.tid = t; F.lane = t & 63; F.wave = __builtin_amdgcn_readfirstlane(t >> 6); return F; }

template <class RowMap>
__device__ __forceinline__ void tr_item(const float* W, int ldw, const float* gain, bf16_t* WT, size_t ldt, int dcol0, RowMap rm, LAS float* scr, int k0, int n0, int lane) {
#pragma unroll 8
    for (int i = 0; i < 32; ++i) { const int kk = 2 * i + (lane >> 5); float v = W[(size_t)(k0 + kk) * ldw + n0 + (lane & 31)]; if (gain) v *= gain[k0 + kk]; scr[kk * 33 + (lane & 31)] = v; }
    LDS_WAIT(); asm volatile("" ::: "memory");
    const int c = lane & 7;
#pragma unroll
    for (int j = 0; j < 4; ++j) { const int n = (lane >> 3) + 8 * j; const LAS float* s = scr + (8 * c) * 33 + n;
        u32x4 o; o.x = pk2(s[0 * 33], s[1 * 33]); o.y = pk2(s[2 * 33], s[3 * 33]); o.z = pk2(s[4 * 33], s[5 * 33]); o.w = pk2(s[6 * 33], s[7 * 33]);
        *(u32x4*)(WT + (size_t)rm(n0 + n) * ldt + dcol0 + k0 + 8 * c) = o; }
    LDS_WAIT(); asm volatile("" ::: "memory");
}
struct RmId { __device__ __forceinline__ int operator()(int n) const { return n; } };
struct RmOff { int off; __device__ __forceinline__ int operator()(int n) const { return n + off; } };
struct RmInA { __device__ __forceinline__ int operator()(int n) const { return n < 256 ? n : (n < 384 ? n + 256 : (n < 416 ? n + 256 : n - 160)); } };
struct RmGU { int up; __device__ __forceinline__ int operator()(int h) const { return (h >> 2) * 8 + (h & 3) + 4 * up; } };
__device__ __forceinline__ void zero16(bf16_t* p) { *(u32x4*)p = (u32x4){0u, 0u, 0u, 0u}; }

__device__ __forceinline__ void p0_prologue(const Frame& F0, const Args& a) {
    const Frame F = phase_frame(F0);
    unsigned char* ws = a.ws;
    LAS float* scr = (LAS float*)(F.lds + F.wave * 16384);
    const int gw = F.vcu * 8 + F.wave, NGW = F.G * 8, lane = F.lane;
    bf16_t* WinA = (bf16_t*)(ws + WS_WINA); bf16_t* Wqkv = (bf16_t*)(ws + WS_WQKV); bf16_t* WinP = (bf16_t*)(ws + WS_WINP); bf16_t* Wpool = (bf16_t*)(ws + WS_WPOOL);
    bf16_t* Wmem = (bf16_t*)(ws + WS_WMEM); bf16_t* Wo = (bf16_t*)(ws + WS_WO); bf16_t* Wgu = (bf16_t*)(ws + WS_WGU); bf16_t* Wd = (bf16_t*)(ws + WS_WD);
    constexpr int I_INA = 16 * 21, I_UQ = 4 * 36, I_UKV = 2 * 48, I_INP = 16 * 32, I_POOL = 4 * 18, I_MEM = 16 * 16, I_WO = 2 * 512, I_G = 64 * 128, I_U = 64 * 128, I_D = 64 * 128;
    constexpr int NITEMS = I_INA + I_UQ + I_UKV + I_INP + I_POOL + I_MEM + I_WO + I_G + I_U + I_D;
    for (int it = gw; it < NITEMS; it += NGW) {
        int r = it;
        if (r < I_INA) { tr_item(a.in[4], 672, a.in[3], WinA, 1024, 0, RmInA{}, scr, 64 * (r / 21), 32 * (r % 21), lane); continue; } r -= I_INA;
        if (r < I_UQ) { tr_item(a.in[6], 1152, a.in[5], Wqkv, 256, 0, RmId{}, scr, 64 * (r / 36), 32 * (r % 36), lane); continue; } r -= I_UQ;
        if (r < I_UKV) { tr_item(a.in[8], 1536, a.in[7], Wqkv, 256, 0, RmOff{1280}, scr, 64 * (r / 48), 32 * (r % 48), lane); continue; } r -= I_UKV;
        if (r < I_INP) { tr_item(a.in[9], 1024, a.in[3] + 1024, WinP, 1024, 0, RmId{}, scr, 64 * (r / 32), 32 * (r % 32), lane); continue; } r -= I_INP;
        if (r < I_POOL) { const int g = r / 18, q = r % 18; tr_item(a.in[10] + (size_t)g * 192 * 192, 192, nullptr, Wpool + (size_t)g * 65536, 256, 0, RmId{}, scr, 64 * (q / 6), 32 * (q % 6), lane); continue; } r -= I_POOL;
        if (r < I_MEM) { tr_item(a.in[13], 512, a.in[12], Wmem, 1024, 0, RmId{}, scr, 64 * (r / 16), 32 * (r % 16), lane); continue; } r -= I_MEM;
        if (r < I_WO) { const int l = r / 512, q = r % 512; tr_item(a.in[14] + (size_t)l * 1048576, 1024, nullptr, Wo + (size_t)l * 1048576, 1024, 0, RmId{}, scr, 64 * (q / 32), 32 * (q % 32), lane); continue; } r -= I_WO;
        if (r < I_G) { const int le = r / 128, q = r % 128; tr_item(a.in[20] + (size_t)le * 262144, 256, a.in[15] + (le / 32) * 1024, Wgu + (size_t)le * 524288, 1024, 0, RmGU{0}, scr, 64 * (q / 8), 32 * (q % 8), lane); continue; } r -= I_G;
        if (r < I_U) { const int le = r / 128, q = r % 128; tr_item(a.in[21] + (size_t)le * 262144, 256, a.in[15] + (le / 32) * 1024, Wgu + (size_t)le * 524288, 1024, 0, RmGU{1}, scr, 64 * (q / 8), 32 * (q % 8), lane); continue; } r -= I_U;
        { const int le = r / 128, q = r % 128, l = le / 32, e = le % 32;
          tr_item(a.in[22] + (size_t)le * 262144, 1024, nullptr, Wd + ((size_t)l * 4 + (e >> 3)) * (1024 * 2048), 2048, (e & 7) * 256, RmId{}, scr, 64 * (q / 32), 32 * (q % 32), lane); }
    }
    const int gt = (F.vcu * 8 + F.wave) * 64 + lane, NGT = NGW * 64;
    for (int c = gt; c < 96 * 128; c += NGT) zero16(WinA + (size_t)672 * 1024 + (size_t)c * 8);
    for (int c = gt; c < 128 * 32; c += NGT) zero16(Wqkv + (size_t)1152 * 256 + (size_t)c * 8);
    for (int c = gt; c < 1536 * 16; c += NGT) zero16(Wqkv + (size_t)(1280 + c / 16) * 256 + 128 + (c % 16) * 8);
    for (int c = gt; c < 4 * 64 * 32; c += NGT) { const int g = c / 2048, q = c % 2048; zero16(Wpool + (size_t)g * 65536 + (size_t)(192 + q / 32) * 256 + (q % 32) * 8); }
    for (int c = gt; c < 4 * 192 * 8; c += NGT) { const int g = c / 1536, q = c % 1536; zero16(Wpool + (size_t)g * 65536 + (size_t)(q / 8) * 256 + 192 + (q % 8) * 8); }
    { bf16_t* Wr = (bf16_t*)(ws + WS_WR);
      for (int c = gt; c < 2 * 48 * 1024; c += NGT) { const int l = c / 49152, q = c % 49152, j = q / 1024, k = q % 1024; float w = 0.f;
          if (j < 4) w = a.in[16][((size_t)l * 1024 + k) * 4 + j]; else if (j >= 16) w = a.in[18][((size_t)l * 1024 + k) * 32 + (j - 16)];
          w *= a.in[15][l * 1024 + k]; const unsigned hi = pk2(w, 0.f) & 0xffffu; const float rem = w - __uint_as_float(hi << 16);
          Wr[((size_t)l * 96 + j) * 1024 + k] = (bf16_t)hi; Wr[((size_t)l * 96 + 48 + j) * 1024 + k] = (bf16_t)(pk2(rem, 0.f) & 0xffffu); } }
    { float* cs = (float*)(ws + WS_CS); float* sn = (float*)(ws + WS_SN); const int* pos = (const int*)a.in[2];
      for (int c = gt; c < T * 16; c += NGT) { const int t = c >> 4, i = c & 15; const float inv = powf(10000.0f, -(float)(2 * i) / 32.0f); const float ang = (float)pos[t] * inv; cs[c] = cosf(ang); sn[c] = sinf(ang); } }
    { bf16_t* XS = (bf16_t*)(ws + WS_XS); float* rstd0 = (float*)(ws + WS_RSTD0); bf16_t* MB = (bf16_t*)(ws + WS_MEMB); float* rstdm = (float*)(ws + WS_RSTDM);
      for (int m = gw; m < T + TMEM; m += NGW) { const bool ism = m >= T; const int row = ism ? m - T : m;
          const f32x4* xr = (const f32x4*)((ism ? a.in[1] : a.in[0]) + (size_t)row * DM) + lane; f32x4 v[4]; float s2 = 0.f;
#pragma unroll
          for (int j = 0; j < 4; ++j) { v[j] = xr[64 * j]; s2 += (v[j][0] * v[j][0] + v[j][1] * v[j][1]) + (v[j][2] * v[j][2] + v[j][3] * v[j][3]); }
          s2 = wave_sum(s2); const float rs = 1.0f / sqrtf(s2 * (1.f / DM) + EPS);
          u32x2* o8 = (u32x2*)((ism ? MB : XS) + (size_t)row * DM) + lane;
#pragma unroll
          for (int j = 0; j < 4; ++j) o8[64 * j] = (u32x2){pk2(v[j][0], v[j][1]), pk2(v[j][2], v[j][3])};
          if (lane == 0) (ism ? rstdm : rstd0)[row] = rs; } }
}

__device__ __forceinline__ void attn_phase(const Frame& F0, unsigned char* ws, bool mla, const bf16_t* QC, int ldqc) {
    const Frame F = phase_frame(F0);
    const bf16_t* Q = (const bf16_t*)(ws + WS_Q); const bf16_t* KN = (const bf16_t*)(ws + WS_KN); const bf16_t* KR = (const bf16_t*)(ws + WS_KROPE); const bf16_t* V = (const bf16_t*)(ws + WS_V);
    const bf16_t* MKV = (const bf16_t*)(ws + WS_MEMKV); bf16_t* CC = (bf16_t*)(ws + WS_CONCAT);
    if (mla) {
        for (int i = 0; i < 6; ++i) { const int pidx = i * F.G + F.vcu; if (pidx >= NB * NHEAD * 4) break; const int bh = pidx >> 2, pr = pidx & 3, b = bh / NHEAD, h = bh % NHEAD;
#pragma unroll 1
            for (int k = 0; k < 2; ++k) { const int qb = k == 0 ? 7 - pr : pr; const size_t row0 = (size_t)b * SEQ, q0 = row0 + (size_t)qb * 256;
                att::attn_unit<96, true>(F.lds, Q + q0 * QW + h * DQK, QW, KN + row0 * KVW + h * 64, KVW, KR + row0 * 32, 32, V + row0 * KVW + h * 64, KVW, CC + q0 * DM + h * 64, DM, 4 * (qb + 1), F.wave, F.lane); } }
    }
    for (int i = 0; i < 4; ++i) { const int uidx = i * F.G + F.vcu; if (uidx >= NB * 4 * 8) break; const int qb = uidx & 7, h = (uidx >> 3) & 3, b = uidx >> 5; const size_t q0 = (size_t)b * SEQ + (size_t)qb * 256;
        att::attn_unit<64, false>(F.lds, QC + q0 * ldqc + h * 64, ldqc, MKV + (size_t)b * MEML * 512 + h * 64, 512, nullptr, 0, MKV + (size_t)b * MEML * 512 + 256 + h * 64, 512, CC + q0 * DM + 768 + h * 64, DM, 4, F.wave, F.lane); }
}

__device__ __forceinline__ void router_phase(const Frame& F0, const Args& a, int layer) {
    const Frame F = phase_frame(F0);
    unsigned char* ws = a.ws; const bf16_t* XS = (const bf16_t*)(ws + WS_XS); const bf16_t* Wr = (const bf16_t*)(ws + WS_WR) + (size_t)layer * 96 * 1024;
    float* tokw = (float*)(ws + WS_TOKW); float* tokr = (float*)(ws + WS_TOKR); int* list = (int*)(ws + WS_LIST); unsigned* cnt = F.ctl + CW_CNT + layer * 128;
    const float* brg = a.in[17] + layer * 4; const float* bre = a.in[19] + layer * 32;
    const int lane = F.lane, fr = lane & 15, fq = lane >> 4, wid = F.wave;
    constexpr int WP = 520;
    LAS bf16_t* Bs = (LAS bf16_t*)F.lds;
    LAS float* LG = (LAS float*)F.lds;
    for (int blk = F.vcu; blk < T / 256; blk += F.G) {
        const int row0 = blk * 256 + wid * 32;
        f32x4 acc[2][6]; float ssq[2] = {0.f, 0.f};
#pragma unroll
        for (int mt = 0; mt < 2; ++mt)
#pragma unroll
            for (int i = 0; i < 6; ++i) acc[mt][i] = (f32x4){0.f, 0.f, 0.f, 0.f};
        for (int kc = 0; kc < 2; ++kc) {
            __syncthreads();
            for (int c = F.tid; c < 96 * 64; c += 512) { const int n = c >> 6, ch = c & 63; *(LAS u32x4*)(Bs + n * WP + ch * 8) = *(const u32x4*)(Wr + (size_t)n * 1024 + kc * 512 + ch * 8); }
            __syncthreads();
#pragma unroll 4
            for (int ks = 0; ks < 16; ++ks) {
                bf16x8 af[2];
#pragma unroll
                for (int mt = 0; mt < 2; ++mt) { af[mt] = *(const bf16x8*)(XS + (size_t)(row0 + mt * 16 + fr) * DM + kc * 512 + ks * 32 + fq * 8);
#pragma unroll
                    for (int j = 0; j < 8; ++j) { const float x = __uint_as_float(((unsigned)(unsigned short)af[mt][j]) << 16); ssq[mt] += x * x; } }
#pragma unroll
                for (int i = 0; i < 6; ++i) { const bf16x8 bfr = *(const LAS bf16x8*)(Bs + (i * 16 + fr) * WP + ks * 32 + fq * 8);
#pragma unroll
                    for (int mt = 0; mt < 2; ++mt) acc[mt][i] = __builtin_amdgcn_mfma_f32_16x16x32_bf16(bfr, af[mt], acc[mt][i], 0, 0, 0); }
            }
        }
        __syncthreads();
#pragma unroll
        for (int mt = 0; mt < 2; ++mt) { float s = ssq[mt]; s += __shfl_xor(s, 16); s += __shfl_xor(s, 32); const float rs = 1.0f / sqrtf(s * (1.f / DM) + EPS); const int lr = wid * 32 + mt * 16 + fr;
#pragma unroll
            for (int i = 0; i < 3; ++i) { const f32x4 v = (acc[mt][i] + acc[mt][i + 3]) * rs;
#pragma unroll
                for (int j = 0; j < 4; ++j) LG[lr * 49 + 16 * i + 4 * fq + j] = v[j]; }
            if (fq == 0) LG[lr * 49 + 48] = rs; }
        __syncthreads();
        if (F.tid < 256) { const int tok = blk * 256 + F.tid; const LAS float* lg = LG + F.tid * 49;
            float g[4]; int gs = 0; float gm;
#pragma unroll
            for (int j = 0; j < 4; ++j) g[j] = lg[j] + brg[j];
            gm = g[0];
#pragma unroll
            for (int j = 1; j < 4; ++j) if (g[j] > gm) { gm = g[j]; gs = j; }
            float den = 0.f;
#pragma unroll
            for (int j = 0; j < 4; ++j) den += __expf(g[j] - gm);
            const float gate = 1.0f / den;
            float e[8];
#pragma unroll
            for (int j = 0; j < 8; ++j) e[j] = lg[16 + gs * 8 + j] + bre[gs * 8 + j];
            int i1 = 0; float m1 = e[0];
#pragma unroll
            for (int j = 1; j < 8; ++j) if (e[j] > m1) { m1 = e[j]; i1 = j; }
            int i2 = -1; float m2 = -INFINITY;
#pragma unroll
            for (int j = 0; j < 8; ++j) if (j != i1 && e[j] > m2) { m2 = e[j]; i2 = j; }
            const float w1 = gate / (1.0f + __expf(m2 - m1)), w2 = gate - w1;
            const int elo = i1 < i2 ? i1 : i2, ehi = i1 < i2 ? i2 : i1; const float wlo = i1 < i2 ? w1 : w2, whi = i1 < i2 ? w2 : w1;
            const int pidx = elo * 7 - (elo * (elo - 1)) / 2 + (ehi - elo - 1);
            const int b = gs * 28 + pidx;
            tokw[(size_t)tok * 2] = wlo; tokw[(size_t)tok * 2 + 1] = whi; tokr[tok] = lg[48];
            const unsigned pos = atomicAdd(cnt + b, 1u);
            list[(size_t)b * CAP + pos] = tok;
        }
        __syncthreads();
    }
}
__device__ __forceinline__ void moe_table(const Frame& F0, int layer) {
    const Frame F = phase_frame(F0);
    LAS int* tab = (LAS int*)(F.lds + L_TAB); const unsigned* cnt = F.ctl + CW_CNT + layer * 128;
    if (F.tid < NBUCKET) tab[128 + F.tid] = (int)__hip_atomic_load(cnt + F.tid, __ATOMIC_RELAXED, __HIP_MEMORY_SCOPE_AGENT);
    __syncthreads();
    if (F.tid == 0) { int s = 0; for (int b = 0; b < NBUCKET; ++b) { tab[b] = s; s += (tab[128 + b] + 255) >> 8; } tab[NBUCKET] = s; }
    __syncthreads();
}

__device__ __forceinline__ void pool_diff_phase(const Frame& F0, unsigned char* ws) {
    const Frame F = phase_frame(F0);
    const bf16_t* Z = (const bf16_t*)(ws + WS_Z); bf16_t* DG = (bf16_t*)(ws + WS_DG);
    const long gt = (long)(F.vcu * 8 + F.wave) * 64 + F.lane, NGT = (long)F.G * 512;
    for (long c = gt; c < (long)T * 128; c += NGT) { const int t = (int)(c >> 7), q = (int)(c & 127), g = q >> 5, ch = q & 31;
        u32x4 o = (u32x4){0u, 0u, 0u, 0u};
        if (ch < 24) { const int win = 2 << g, s = t & (SEQ - 1), n = min(s + 1, win); float acc[8] = {0.f, 0.f, 0.f, 0.f, 0.f, 0.f, 0.f, 0.f}; float own[8];
            for (int j = 0; j < n; ++j) { const u32x4 w = *(const u32x4*)(Z + (size_t)(t - j) * DM + g * 192 + ch * 8);
                const float x[8] = {bflo(w.x), bfhi(w.x), bflo(w.y), bfhi(w.y), bflo(w.z), bfhi(w.z), bflo(w.w), bfhi(w.w)};
#pragma unroll
                for (int k = 0; k < 8; ++k) { acc[k] += x[k]; if (j == 0) own[k] = x[k]; } }
            const float inv = 1.0f / (float)n;
            o = (u32x4){pk2(acc[0] * inv - own[0], acc[1] * inv - own[1]), pk2(acc[2] * inv - own[2], acc[3] * inv - own[3]), pk2(acc[4] * inv - own[4], acc[5] * inv - own[5]), pk2(acc[6] * inv - own[6], acc[7] * inv - own[7])}; }
        *(u32x4*)(DG + ((size_t)g * T + t) * 256 + ch * 8) = o; }
}
__device__ __forceinline__ void final_phase(const Frame& F0, const Args& a) {
    const Frame F = phase_frame(F0);
    const bf16_t* XS = (const bf16_t*)(a.ws + WS_XS); const float* gf = a.in[23];
    const int gw = F.vcu * 8 + F.wave, NGW = F.G * 8, lane = F.lane;
    f32x4 gv[4];
#pragma unroll
    for (int j = 0; j < 4; ++j) gv[j] = *((const f32x4*)gf + lane + 64 * j);
    for (int m = gw; m < T; m += NGW) { const u32x2* xr = (const u32x2*)(XS + (size_t)m * DM) + lane; f32x4 v[4]; float s2 = 0.f;
#pragma unroll
        for (int j = 0; j < 4; ++j) { const u32x2 w = xr[64 * j]; v[j] = (f32x4){bflo(w.x), bfhi(w.x), bflo(w.y), bfhi(w.y)}; s2 += (v[j][0] * v[j][0] + v[j][1] * v[j][1]) + (v[j][2] * v[j][2] + v[j][3] * v[j][3]); }
        s2 = wave_sum(s2); const float rs = 1.0f / sqrtf(s2 * (1.f / DM) + EPS);
        f32x4* o = (f32x4*)(a.out + (size_t)m * DM) + lane;
#pragma unroll
        for (int j = 0; j < 4; ++j) o[64 * j] = v[j] * rs * gv[j]; }
}

#ifndef PHASE_MASK
#define PHASE_MASK 0xFFFFFFFFu
#endif
#define PH(n) ((PHASE_MASK >> (n)) & 1u)
__global__ void __launch_bounds__(512, 2) fwd_kernel(Args args) {
    extern __shared__ __attribute__((aligned(16))) unsigned char lds_raw[];
    Frame F; F.lds = (LAS unsigned char*)lds_raw; F.tid = threadIdx.x; F.lane = F.tid & 63; F.wave = __builtin_amdgcn_readfirstlane(F.tid >> 6);
    F.G = gridDim.x; { const int bx = blockIdx.x; F.vcu = (F.G % 8 == 0) ? (bx % 8) * (F.G / 8) + bx / 8 : bx; }
    unsigned char* ws = args.ws; F.ctl = (unsigned*)(ws + WS_CTL);
    for (int u = F.tid; u < (LDS_BYTES - RING_BYTES) / 4; u += 512) ((LAS unsigned*)(F.lds + RING_BYTES))[u] = 0u;
    __syncthreads();
    XcdBarrier bar = xcd_barrier_post(F.ctl + CW_BAR, (volatile LAS unsigned*)(F.lds + L_MISC) + 8);
    LAS unsigned char* listbuf = F.lds + L_LIST;
    const float qcscale = 0.125f * LOG2E;
    const float qscale = 0.10206207261596577f * LOG2E;

    if (PH(0)) p0_prologue(F, args);
    xcd_barrier(bar);
    if (PH(1)) {   SchedPlain S; S.o.init(TMEM / 256, 2, F.G, (int)blockIdx.x); S.A = (const char*)(ws + WS_MEMB); S.B = (const char*)(ws + WS_WMEM); S.a_tile = 256 * 2048; S.b_tile = 256 * 2048;
        EpiRowScale E{(bf16_t*)(ws + WS_MEMKV), 512, (const float*)(ws + WS_RSTDM)};
        pg8::gemm_run<EpiRowScale, SchedPlain, false>(F.lds, listbuf, S, E, 16, 1 << 30, 2048u, 2048u); }
    if (PH(2)) {   SchedPlain S; S.o.init(T / 256, 3, F.G, (int)blockIdx.x); S.A = (const char*)(ws + WS_XS); S.B = (const char*)(ws + WS_WINA); S.a_tile = 256 * 2048; S.b_tile = 256 * 2048;
        EpiInA E{(const float*)(ws + WS_RSTD0), (bf16_t*)(ws + WS_QLAT), (bf16_t*)(ws + WS_QC), (bf16_t*)(ws + WS_KVLAT), (bf16_t*)(ws + WS_KROPE), (float*)(ws + WS_SSQQ), (float*)(ws + WS_SSQKV),
                 (const float*)(ws + WS_CS), (const float*)(ws + WS_SN), qcscale};
        pg8::gemm_run<EpiInA, SchedPlain, false>(F.lds, listbuf, S, E, 16, 1 << 30, 2048u, 2048u); }
    xcd_barrier(bar);
    if (PH(3)) {   SchedQKV S; S.o.init(T / 256, 11, F.G, (int)blockIdx.x); S.Aq = (const char*)(ws + WS_QLAT); S.Akv = (const char*)(ws + WS_KVLAT); S.B = (const char*)(ws + WS_WQKV);
        EpiQKV E{(const float*)(ws + WS_SSQQ), (const float*)(ws + WS_SSQKV), (bf16_t*)(ws + WS_Q), (bf16_t*)(ws + WS_KN), (bf16_t*)(ws + WS_V), (const float*)(ws + WS_CS), (const float*)(ws + WS_SN), qscale};
        pg8::gemm_run<EpiQKV, SchedQKV, false>(F.lds, listbuf, S, E, 4, 1 << 30, 512u, 512u); }
    xcd_barrier(bar);
#pragma unroll 1
    for (int layer = 0; layer < 2; ++layer) {
        { size_t zoff = 0; asm volatile("" : "+s"(zoff)); ws = args.ws + zoff; }
        if (layer == 0) {
            if (PH(4)) attn_phase(F, ws, true, (const bf16_t*)(ws + WS_QC), 256);
            xcd_barrier(bar);
        } else {
            if (PH(5)) {   SchedPlain S; S.o.init(T / 256, 4, F.G, (int)blockIdx.x); S.A = (const char*)(ws + WS_XS); S.B = (const char*)(ws + WS_WINP); S.a_tile = 256 * 2048; S.b_tile = 256 * 2048;
                EpiInP E{(const float*)(ws + WS_SSQX), (bf16_t*)(ws + WS_Z), qcscale};
                pg8::gemm_run<EpiInP, SchedPlain, false>(F.lds, listbuf, S, E, 16, 1 << 30, 2048u, 2048u); }
            xcd_barrier(bar);
            if (PH(6)) pool_diff_phase(F, ws);
            if (PH(7)) attn_phase(F, ws, false, (const bf16_t*)(ws + WS_Z) + 768, 1024);
            xcd_barrier(bar);
            if (PH(8)) {   SchedPool S; S.o.init(T / 256, 4, F.G, (int)blockIdx.x); S.A = (const char*)(ws + WS_DG); S.B = (const char*)(ws + WS_WPOOL);
                EpiPool E{args.in[11], (bf16_t*)(ws + WS_CONCAT)};
                pg8::gemm_run<EpiPool, SchedPool, false>(F.lds, listbuf, S, E, 4, 1 << 30, 512u, 512u); }
            xcd_barrier(bar);
        }
        if (PH(9)) {   SchedPlain S; S.o.init(T / 256, 4, F.G, (int)blockIdx.x); S.A = (const char*)(ws + WS_CONCAT); S.B = (const char*)(ws + WS_WO) + (size_t)layer * 2097152; S.a_tile = 256 * 2048; S.b_tile = 256 * 2048;
            EpiWo E{layer, args.in[0], (bf16_t*)(ws + WS_XS)};
            pg8::gemm_run<EpiWo, SchedPlain, false>(F.lds, listbuf, S, E, 16, 1 << 30, 2048u, 2048u); }
        xcd_barrier(bar);
        if (PH(10)) router_phase(F, args, layer);
        xcd_barrier(bar);
        moe_table(F, layer);
        if (PH(11)) {   SchedMoe<false> S{(const LAS int*)(F.lds + L_TAB), F.G, F.vcu, (const char*)(ws + WS_XS), (const char*)(ws + WS_WGU) + (size_t)layer * (32u * 512u * 2048u), (const int*)(ws + WS_LIST)};
            EpiMoeUp E{(const float*)(ws + WS_TOKR), (const float*)(ws + WS_TOKW), (bf16_t*)(ws + WS_ACT)};
            pg8::gemm_run<EpiMoeUp, SchedMoe<false>, true>(F.lds, listbuf, S, E, 16, 1 << 30, 2048u, 2048u); }
        xcd_barrier(bar);
        if (PH(12)) {   SchedMoe<true> S{(const LAS int*)(F.lds + L_TAB), F.G, F.vcu, (const char*)(ws + WS_ACT), (const char*)(ws + WS_WD) + (size_t)layer * (4u * 1024u * 4096u), (const int*)(ws + WS_LIST)};
            EpiMoeDown E{(bf16_t*)(ws + WS_XS), (float*)(ws + WS_SSQX)};
            pg8::gemm_run<EpiMoeDown, SchedMoe<true>, false>(F.lds, listbuf, S, E, 8, 4, 1024u, 4096u); }
        xcd_barrier(bar);
    }
    if (PH(13)) final_phase(F, args);
}

extern "C" void kernel_launch(void* const* d_in, const int* in_sizes, int n_in, void* d_out, int out_size, void* d_ws, size_t ws_size, hipStream_t stream) {
    static int grid = 0;
    if (grid == 0) {
        if (n_in != 24 || in_sizes[0] != T * DM || out_size != T * DM || ws_size < WS_END) { fprintf(stderr, "kernel_launch: unexpected shapes (n_in %d, in0 %d, out %d, ws %zu); nothing launched\n", n_in, n_in > 0 ? in_sizes[0] : -1, out_size, ws_size); grid = -1; return; }
        int dev = 0, cus = 0, per_cu = 0;
        if (hipGetDevice(&dev) != hipSuccess || hipDeviceGetAttribute(&cus, hipDeviceAttributeMultiprocessorCount, dev) != hipSuccess) { grid = -1; return; }
        if (hipFuncSetAttribute((const void*)fwd_kernel, hipFuncAttributeMaxDynamicSharedMemorySize, LDS_BYTES) != hipSuccess) { fprintf(stderr, "kernel_launch: hipFuncSetAttribute failed\n"); grid = -1; return; }
        if (hipOccupancyMaxActiveBlocksPerMultiprocessor(&per_cu, (const void*)fwd_kernel, 512, LDS_BYTES) != hipSuccess || per_cu < 1) fprintf(stderr, "kernel_launch: occupancy query reports %d\n", per_cu);
        (void)hipGetLastError();
        grid = cus;
    }
    if (grid < 0) return;
    if (hipMemsetAsync((char*)d_ws + WS_CTL, 0, CTL_ZERO_BYTES, stream) != hipSuccess) return;
    Args a{};
    for (int i = 0; i < 24; ++i) a.in[i] = (const float*)d_in[i];
    a.out = (float*)d_out; a.ws = (unsigned char*)d_ws;
    hipLaunchKernelGGL(fwd_kernel, dim3(grid), dim3(512), LDS_BYTES, stream, a);
}
```

```cpp
#include <hip/hip_runtime.h>
#include <cstdio>
#include <cstdint>

#define LAS __attribute__((address_space(3)))
#define GAS __attribute__((address_space(1)))
typedef unsigned short bf16_t;
typedef short bf16x8 __attribute__((ext_vector_type(8)));
typedef short s16x4 __attribute__((ext_vector_type(4)));
typedef float f32x2 __attribute__((ext_vector_type(2)));
typedef float f32x4 __attribute__((ext_vector_type(4)));
typedef float f32x16 __attribute__((ext_vector_type(16)));
typedef unsigned u32x2 __attribute__((ext_vector_type(2)));
typedef unsigned u32x4 __attribute__((ext_vector_type(4)));
typedef __bf16 bf16x2_t __attribute__((ext_vector_type(2)));

constexpr int T = 65536, DM = 1024, SEQ = 2048, NB = 32, MEML = 256, TMEM = NB * MEML;
constexpr int NHEAD = 12, DQK = 96, DV = 64, QW = NHEAD * DQK  , KVW = NHEAD * DV  ;
constexpr float EPS = 1e-6f;
constexpr int NBUCKET = 112, CAP = 65536;
constexpr float LOG2E = 1.4426950408889634f;

constexpr size_t MiB = 1u << 20;
constexpr size_t WS_CTL = 0, CTL_ZERO_BYTES = 1 * MiB;
constexpr size_t WS_WINA = 1 * MiB;
constexpr size_t WS_WQKV = 3 * MiB;
constexpr size_t WS_WINP = 5 * MiB;
constexpr size_t WS_WPOOL = 7 * MiB;
constexpr size_t WS_WMEM = 8 * MiB;
constexpr size_t WS_WO = 9 * MiB;
constexpr size_t WS_WR = 13 * MiB;
constexpr size_t WS_WGU = 14 * MiB;
constexpr size_t WS_WD = 78 * MiB;
constexpr size_t WS_XS = 110 * MiB;
constexpr size_t WS_RSTD0 = 238 * MiB;
constexpr size_t WS_RSTDM = 238 * MiB + 512 * 1024;
constexpr size_t WS_CS = 239 * MiB, WS_SN = 243 * MiB;
constexpr size_t WS_MEMB = 247 * MiB;
constexpr size_t WS_MEMKV = 263 * MiB;
constexpr size_t WS_SSQQ = 271 * MiB, WS_SSQKV = 272 * MiB, WS_SSQX = 273 * MiB;
constexpr size_t WS_TOKW = 277 * MiB;
constexpr size_t WS_TOKR = 278 * MiB;
constexpr size_t WS_KROPE = 279 * MiB;
constexpr size_t WS_LIST = 283 * MiB;
constexpr size_t WS_QLAT = 311 * MiB, WS_QC = 343 * MiB, WS_KVLAT = 375 * MiB;
constexpr size_t WS_ACT = 311 * MiB;
constexpr size_t WS_Q = 407 * MiB, WS_KN = 551 * MiB, WS_V = 647 * MiB;
constexpr size_t WS_Z = 407 * MiB, WS_DG = 535 * MiB;
constexpr size_t WS_CONCAT = 743 * MiB;
constexpr size_t WS_END = 871 * MiB;
constexpr int CW_BAR = 4096, CW_CNT = 8192;

constexpr int RING_BYTES = 131072;
constexpr int L_MISC = RING_BYTES, L_LIST = RING_BYTES + 256, L_TAB = RING_BYTES + 256 + 2048, LDS_BYTES = RING_BYTES + 4096;

__device__ __forceinline__ unsigned pk2(float lo, float hi) { f32x2 v = {lo, hi}; bf16x2_t b = __builtin_convertvector(v, bf16x2_t); return __builtin_bit_cast(unsigned, b); }
__device__ __forceinline__ float bflo(unsigned w) { return __uint_as_float(w << 16); }
__device__ __forceinline__ float bfhi(unsigned w) { return __uint_as_float(w & 0xffff0000u); }
__device__ __forceinline__ u32x4 pack8(f32x4 a, f32x4 b) { u32x4 w; w.x = pk2(a[0], a[1]); w.y = pk2(a[2], a[3]); w.z = pk2(b[0], b[1]); w.w = pk2(b[2], b[3]); return w; }
__device__ __forceinline__ float wave_sum(float v) {
#pragma unroll
    for (int o = 1; o < 64; o <<= 1) v += __shfl_xor(v, o);
    return v;
}
#define LDS_WAIT() asm volatile("s_waitcnt lgkmcnt(0)" ::: "memory")
#define VM_WAIT() asm volatile("s_waitcnt vmcnt(0)" ::: "memory")

#define XB_TMO      128
#define XB_XCNT(j)  (256  + 64 * (j))
#define XB_XSUB(j)  (1280 + 64 * (j))
#define XB_XGEN(j)  (2304 + 64 * (j))
#define XB_TOP      3328
#define XB_TOPGEN   3392
#define XCD_BAR_WORDS 3456
#define XB_SPIN_CAP (1u << 18)
__device__ __forceinline__ unsigned xb_ld(unsigned* p)              { return __hip_atomic_load(p, __ATOMIC_RELAXED, __HIP_MEMORY_SCOPE_AGENT); }
__device__ __forceinline__ unsigned xb_add(unsigned* p, unsigned v) { return __hip_atomic_fetch_add(p, v, __ATOMIC_RELAXED, __HIP_MEMORY_SCOPE_AGENT); }
__device__ __forceinline__ unsigned xb_xcc_id() { return (unsigned)__builtin_amdgcn_s_getreg((3 << 11) | 20) & 0xFu; }
#define XB_SPIN(cond, bar) do { unsigned _sp = 0; while (cond) { __builtin_amdgcn_s_sleep(1); \
    if ((++_sp & 255u) == 0u) { if (xb_ld(&(bar)[XB_TMO])) break; if (_sp > XB_SPIN_CAP) { atomicAdd(&(bar)[XB_TMO], 1u); break; } } } } while (0)
struct XcdBarrier { unsigned* bar; unsigned x; volatile LAS unsigned* st; };
__device__ __forceinline__ XcdBarrier xcd_barrier_post(unsigned* bar, volatile LAS unsigned* st) {
    XcdBarrier b; b.bar = bar; b.x = xb_xcc_id(); b.st = st;
    if (threadIdx.x == 0) (void)xb_add(&bar[XB_XCNT(b.x)], 1u);
    return b;
}
__device__ __forceinline__ void xcd_barrier_complete(unsigned* bar, unsigned x, unsigned& nloc, unsigned& nx) {
    const unsigned G = gridDim.x * gridDim.y * gridDim.z;
    unsigned sum, cnt, mine, sp = 0u;
    for (;;) {
        sum = 0u; cnt = 0u; mine = 0u;
#pragma unroll
        for (unsigned j = 0; j < 16; ++j) { const unsigned c = xb_ld(&bar[XB_XCNT(j)]); sum += c; cnt += (c > 0u) ? 1u : 0u; mine = (j == x) ? c : mine; }
        if (sum == G) break;
        __builtin_amdgcn_s_sleep(1);
        if ((++sp & 255u) == 0u) { if (xb_ld(&bar[XB_TMO])) break; if (sp > XB_SPIN_CAP) { atomicAdd(&bar[XB_TMO], 1u); break; } }
    }
    nloc = mine > 0u ? mine : 1u; nx = cnt > 0u ? cnt : 1u;
}
__device__ __forceinline__ void xcd_barrier(const XcdBarrier& b) {
    asm volatile("s_waitcnt vmcnt(0)" ::: "memory");
    __syncthreads();
    if (threadIdx.x == 0) {
        unsigned zoff = 0u; asm volatile("" : "+s"(zoff));
        unsigned* bar = b.bar + zoff;
        __builtin_amdgcn_s_waitcnt(0);
        const unsigned bx = xb_xcc_id();
        unsigned nloc = b.st[0], nx = b.st[1];
        if (nloc == 0u) { xcd_barrier_complete(bar, bx, nloc, nx); b.st[0] = nloc; b.st[1] = nx; }
        const unsigned old = xb_add(&bar[XB_XSUB(bx)], 1u);
        const unsigned gen = old / nloc;
        if (old + 1u == (gen + 1u) * nloc) {
            __builtin_amdgcn_fence(__ATOMIC_RELEASE, "agent");
            asm volatile("s_waitcnt vmcnt(0)" ::: "memory");
            const unsigned og = xb_add(&bar[XB_TOP], 1u);
            const unsigned tg = og / nx;
            if (og + 1u == (tg + 1u) * nx) xb_add(&bar[XB_TOPGEN], 1u);
            else XB_SPIN(xb_ld(&bar[XB_TOPGEN]) == tg, bar);
            __builtin_amdgcn_fence(__ATOMIC_ACQUIRE, "agent");
            xb_add(&bar[XB_XGEN(bx)], 1u);
            asm volatile("s_waitcnt vmcnt(0)" ::: "memory");
        } else {
            XB_SPIN(xb_ld(&bar[XB_XGEN(bx)]) == gen, bar);
            __builtin_amdgcn_fence(__ATOMIC_ACQUIRE, "agent");
            asm volatile("s_waitcnt vmcnt(0)" ::: "memory");
        }
    }
    __syncthreads();
}

namespace pg8 {
constexpr int BM = 256, BK = 64, HALF = 128, HTB = HALF * BK * 2, NXCD = 8, WGM = 8;
__host__ __device__ __forceinline__ int lds_byte(int r, int c) { const int st = (r >> 4) * 2 + (c >> 5), rr = r & 15, cc = c & 31, ob = rr * 64 + cc * 2; return st * 1024 + (ob ^ (((ob >> 9) & 1) << 5)); }
__host__ __device__ __forceinline__ void stage_rc(int b, int& R, int& C) { const int st = b / 1024, sb = b % 1024, swz = sb ^ (((sb >> 9) & 1) << 5); R = (st >> 1) * 16 + swz / 64; C = (st & 1) * 32 + (swz % 64) / 2; }
__host__ __device__ __forceinline__ int perm32(int rho) { const int n = rho >> 4, i = rho & 15; return 8 * (i >> 2) + 4 * n + (i & 3); }

struct Unit { const char* A; const char* B; int bjump; int nvalid; const int* list; int pm, pn, aux; };

struct TileOrder {
    int nM, nN, nwg, G, c;
    __device__ __forceinline__ void init(int nM_, int nN_, int G_, int c_) { nM = nM_; nN = nN_; nwg = nM * nN; G = G_; c = c_; }
    __device__ __forceinline__ bool get(int i, int& pm, int& pn) const {
        const long L = (long)i * G + c; if (L >= nwg) return false;
        int wgid = (int)L; { const int q = nwg / NXCD, r = nwg % NXCD, xcd = wgid % NXCD, off = wgid / NXCD; wgid = (xcd < r ? xcd * (q + 1) : r * (q + 1) + (xcd - r) * q) + off; }
        const int nig = WGM * nN, gid = wgid / nig, fm = gid * WGM, gsz = (nM - fm) < WGM ? (nM - fm) : WGM;
        pm = fm + ((wgid % nig) % gsz); pn = (wgid % nig) / gsz; return true;
    }
};

template <class Epi, class Sched, bool GATHER>
__device__ __forceinline__ void gemm_run(LAS unsigned char* lds, LAS unsigned char* listbuf, const Sched& S, const Epi& E, const int nt, const int jt, const unsigned lda2, const unsigned ldb2) {
    int tid = threadIdx.x; asm volatile("" : "+v"(tid));
    const int wid = __builtin_amdgcn_readfirstlane(tid >> 6), lane = tid & 63, wr = wid >> 2, wc = wid & 3, fr = lane & 15, fq = lane >> 4;
    int Rr[2]; unsigned Cc[2], voffB[2];
#pragma unroll
    for (int i = 0; i < 2; ++i) { int R, C; stage_rc(tid * 16 + i * 8192, R, C); const int Rb = (R & ~31) + perm32(R & 31); Rr[i] = R; Cc[i] = (unsigned)C * 2u; voffB[i] = (unsigned)Rb * ldb2 + (unsigned)C * 2u; }
    const size_t kstep = (size_t)(BK * 2);
    const size_t hstepB = (size_t)HALF * ldb2;
    const size_t hstepA = GATHER ? (size_t)0 : (size_t)HALF * lda2;
    const unsigned ldsw = (unsigned)wid * 1024u;
    const int aoff = lds_byte(wr * 64 + fr, fq * 8), boff = lds_byte(wc * 32 + fr, fq * 8);
#define PG8_SA(b, h) (((b) * 2 + (h)) * HTB)
#define PG8_SB(b, h) ((4 + (b) * 2 + (h)) * HTB)
#define PG8_STAGE(bufoff, gbase, voff) do { _Pragma("unroll") for (int _i = 0; _i < 2; ++_i) \
        __builtin_amdgcn_global_load_lds((const unsigned*)((const char*)(gbase) + (voff)[_i]), (LAS unsigned*)(lds + (bufoff) + ldsw + _i * 8192), 16, 0, 0); } while (0)
#define PG8_LDA(dst, b, h) do { _Pragma("unroll") for (int m = 0; m < 4; ++m) _Pragma("unroll") for (int k = 0; k < 2; ++k) dst[m][k] = *(const LAS bf16x8*)(lds + PG8_SA(b, h) + aoff + m * 2048 + k * 1024); } while (0)
#define PG8_LDB(dst, b, h) do { _Pragma("unroll") for (int n = 0; n < 2; ++n) _Pragma("unroll") for (int k = 0; k < 2; ++k) dst[n][k] = *(const LAS bf16x8*)(lds + PG8_SB(b, h) + boff + n * 2048 + k * 1024); } while (0)
#define PG8_MMA(ai, bj, At, Bt) do { __builtin_amdgcn_s_setprio(1); _Pragma("unroll") for (int m = 0; m < 4; ++m) _Pragma("unroll") for (int n = 0; n < 2; ++n) _Pragma("unroll") for (int k = 0; k < 2; ++k) \
        acc[ai][bj][m][n] = __builtin_amdgcn_mfma_f32_16x16x32_bf16(Bt[n][k], At[m][k], acc[ai][bj][m][n], 0, 0, 0); __builtin_amdgcn_s_setprio(0); } while (0)
#define PG8_WAIT_V(n) asm volatile("s_waitcnt vmcnt(" #n ")" ::: "memory")
#define PG8_WAIT_L(n) asm volatile("s_waitcnt lgkmcnt(" #n ")" ::: "memory")
#define PG8_BAR __builtin_amdgcn_s_barrier()
#define PG8_SCHED __builtin_amdgcn_sched_barrier(0)
#define PG8_BPTR(X, tt) ((X).B + (size_t)(tt) * kstep + (((tt) >= jt) ? (X).bjump : 0))
    Unit cur, nxt; int ui = 0;
    if (!S.next(0, cur)) return;
    unsigned offA[2][2];
#pragma unroll
    for (int h = 0; h < 2; ++h)
#pragma unroll
        for (int i = 0; i < 2; ++i) {
            const int row = h * HALF + Rr[i];
            if constexpr (GATHER) { int idx = cur.list[row]; if (row >= cur.nvalid) idx = 0; offA[h][i] = (unsigned)idx * lda2 + Cc[i]; }
            else offA[h][i] = (unsigned)Rr[i] * lda2 + Cc[i];
        }
    f32x4 acc[2][2][4][2];
#pragma unroll
    for (int a = 0; a < 2; ++a)
#pragma unroll
        for (int b = 0; b < 2; ++b)
#pragma unroll
            for (int m = 0; m < 4; ++m)
#pragma unroll
                for (int n = 0; n < 2; ++n) acc[a][b][m][n] = (f32x4){0.f, 0.f, 0.f, 0.f};
    bf16x8 At[4][2], B0[2][2], B1[2][2];
    {
        const char* cA = cur.A; const char* cB = cur.B;
        PG8_STAGE(PG8_SB(0, 0), cB, voffB); PG8_STAGE(PG8_SB(0, 1), cB + hstepB, voffB); PG8_STAGE(PG8_SA(0, 0), cA, offA[0]); PG8_STAGE(PG8_SA(0, 1), cA + hstepA, offA[1]);
        if (wr == 1) PG8_BAR;
        PG8_WAIT_V(2); PG8_BAR;
        const char* cB1 = PG8_BPTR(cur, 1);
        PG8_STAGE(PG8_SB(1, 0), cB1, voffB); PG8_STAGE(PG8_SA(1, 0), cA + kstep, offA[0]); PG8_STAGE(PG8_SB(1, 1), cB1 + hstepB, voffB);
        PG8_WAIT_V(6); PG8_BAR;
    }
    for (;;) {
        const bool has_next = S.next(ui + 1, nxt);
        if constexpr (GATHER) {
            if (has_next) __builtin_amdgcn_global_load_lds((const unsigned*)((const char*)nxt.list + lane * 16), (LAS unsigned*)(listbuf + ((ui + 1) & 1) * 1024), 16, 0, 0);
        }
        const char* cA = cur.A;
        const char* nA = has_next ? nxt.A : cur.A;
        const char* nB0 = has_next ? nxt.B : cur.B;
        const char* nB1 = has_next ? PG8_BPTR(nxt, 1) : PG8_BPTR(cur, 1);
#pragma unroll 1
        for (int t = 0; t < nt; t += 2) {
            const bool last = (t == nt - 2);
            const char* a1 = cA + (size_t)(t + 1) * kstep;
            const char* a2 = last ? nA : cA + (size_t)(t + 2) * kstep; const char* b2 = last ? nB0 : PG8_BPTR(cur, t + 2);
            const char* a3 = a2 + kstep;                              const char* b3 = last ? nB1 : PG8_BPTR(cur, t + 3);
            PG8_LDB(B0, 0, 0); PG8_LDB(B1, 0, 1); PG8_SCHED; PG8_LDA(At, 0, 0); PG8_STAGE(PG8_SA(1, 1), a1 + hstepA, offA[1]);
            if constexpr (GATHER) {
                if (last && has_next) {
                    const LAS int* lb = (const LAS int*)(listbuf + ((ui + 1) & 1) * 1024);
#pragma unroll
                    for (int h = 0; h < 2; ++h)
#pragma unroll
                        for (int i = 0; i < 2; ++i) { const int row = h * HALF + Rr[i]; int idx = lb[row]; if (row >= nxt.nvalid) idx = 0; offA[h][i] = (unsigned)idx * lda2 + Cc[i]; }
                }
            }
            PG8_WAIT_V(8); PG8_WAIT_L(0); PG8_BAR; PG8_MMA(0, 0, At, B0); PG8_MMA(0, 1, At, B1); PG8_BAR; PG8_SCHED;
            PG8_LDA(At, 0, 1); PG8_STAGE(PG8_SB(0, 0), b2, voffB); PG8_STAGE(PG8_SB(0, 1), b2 + hstepB, voffB); PG8_STAGE(PG8_SA(0, 0), a2, offA[0]);
            PG8_WAIT_V(8); PG8_WAIT_L(0); PG8_BAR; PG8_MMA(1, 0, At, B0); PG8_MMA(1, 1, At, B1); PG8_BAR; PG8_SCHED;
            PG8_LDB(B0, 1, 0); PG8_LDB(B1, 1, 1); PG8_SCHED; PG8_LDA(At, 1, 0); PG8_STAGE(PG8_SA(0, 1), a2 + hstepA, offA[1]);
            PG8_WAIT_V(8); PG8_WAIT_L(0); PG8_BAR; PG8_MMA(0, 0, At, B0); PG8_MMA(0, 1, At, B1); PG8_BAR; PG8_SCHED;
            PG8_LDA(At, 1, 1); PG8_STAGE(PG8_SB(1, 0), b3, voffB); PG8_STAGE(PG8_SB(1, 1), b3 + hstepB, voffB); PG8_STAGE(PG8_SA(1, 0), a3, offA[0]);
            PG8_WAIT_V(8); PG8_WAIT_L(0); PG8_BAR; PG8_MMA(1, 0, At, B0); PG8_MMA(1, 1, At, B1); PG8_BAR; PG8_SCHED;
        }
        if (wr == 0) PG8_BAR;
        E(acc, cur, wr, wc, fr, fq);
        if (!has_next) break;
#pragma unroll
        for (int a = 0; a < 2; ++a)
#pragma unroll
            for (int b = 0; b < 2; ++b)
#pragma unroll
                for (int m = 0; m < 4; ++m)
#pragma unroll
                    for (int n = 0; n < 2; ++n) acc[a][b][m][n] = (f32x4){0.f, 0.f, 0.f, 0.f};
        cur = nxt; ++ui;
        if (wr == 1) PG8_BAR;
    }
    PG8_WAIT_V(0);
    PG8_BAR;
#undef PG8_SA
#undef PG8_SB
#undef PG8_STAGE
#undef PG8_LDA
#undef PG8_LDB
#undef PG8_MMA
#undef PG8_WAIT_V
#undef PG8_WAIT_L
#undef PG8_BAR
#undef PG8_SCHED
#undef PG8_BPTR
}
}
using pg8::Unit;

struct SchedPlain {
    pg8::TileOrder o; const char* A; const char* B; size_t a_tile, b_tile;
    __device__ __forceinline__ bool next(int i, Unit& u) const { int pm, pn; if (!o.get(i, pm, pn)) return false;
        u.A = A + (size_t)pm * a_tile; u.B = B + (size_t)pn * b_tile; u.bjump = 0; u.nvalid = 256; u.list = nullptr; u.pm = pm; u.pn = pn; u.aux = 0; return true; }
};
struct SchedQKV {
    pg8::TileOrder o; const char* Aq; const char* Akv; const char* B;
    __device__ __forceinline__ bool next(int i, Unit& u) const { int pm, pn; if (!o.get(i, pm, pn)) return false;
        u.A = (pn < 5 ? Aq : Akv) + (size_t)pm * (256 * 512); u.B = B + (size_t)pn * (256 * 512); u.bjump = 0; u.nvalid = 256; u.list = nullptr; u.pm = pm; u.pn = pn; u.aux = 0; return true; }
};
struct SchedPool {
    pg8::TileOrder o; const char* A; const char* B;
    __device__ __forceinline__ bool next(int i, Unit& u) const { int pm, pn; if (!o.get(i, pm, pn)) return false;
        u.A = A + ((size_t)pn * T + (size_t)pm * 256) * 512; u.B = B + (size_t)pn * (256 * 512); u.bjump = 0; u.nvalid = 256; u.list = nullptr; u.pm = pm; u.pn = pn; u.aux = 0; return true; }
};
__device__ __forceinline__ void pair_decode(int p, int& lo, int& hi) { int l = 0, rem = p; while (rem >= 7 - l) { rem -= 7 - l; ++l; } lo = l; hi = l + 1 + rem; }
template <bool DOWN> struct SchedMoe {
    const LAS int* tab; int G, c; const char* A; const char* W; const int* list;
    __device__ __forceinline__ bool next(int i, Unit& u) const {
        const int ntile = tab[NBUCKET]; const long L = (long)i * G + c; if (L >= (long)ntile * 4) return false;
        const int tile = (int)(L >> 2), pn = (int)(L & 3);
        int lo_ = 0, hi_ = NBUCKET - 1;
        while (lo_ < hi_) { const int mid = (lo_ + hi_ + 1) >> 1; if (tab[mid] <= tile) lo_ = mid; else hi_ = mid - 1; }
        const int b = __builtin_amdgcn_readfirstlane(lo_);
        const int tib = tile - __builtin_amdgcn_readfirstlane(tab[b]), cnt = __builtin_amdgcn_readfirstlane(tab[128 + b]);
        int elo, ehi; pair_decode(b % 28, elo, ehi); const int g = b / 28;
        u.nvalid = min(256, cnt - tib * 256); u.list = list + (size_t)b * CAP + tib * 256; u.pm = tile; u.pn = pn; u.aux = tile * 256;
        if (!DOWN) { u.A = A; u.B = W + ((size_t)(g * 8 + (pn < 2 ? elo : ehi)) * 512 + (pn & 1) * 256) * 2048; u.bjump = 0; }
        else { u.A = A + (size_t)tile * (256 * 1024); u.B = W + (size_t)g * (1024 * 4096) + (size_t)pn * (256 * 4096) + elo * 512; u.bjump = (ehi - elo - 1) * 512; }
        return true;
    }
};

#define EPI_ROWS(ai, m) (128 * (ai) + 64 * wr + 16 * (m) + fr)
#define EPI_COL(bj) (128 * (bj) + 32 * wc + 8 * fq)
#define EPI_FENCE asm volatile("" ::: "memory")
typedef f32x4 acc_t[2][2][4][2];

struct EpiRowScale {
    bf16_t* O; int ldc; const float* rs;
    __device__ __forceinline__ void operator()(const acc_t& acc, const Unit& u, int wr, int wc, int fr, int fq) const {
        float sv[2][4];
#pragma unroll
        for (int ai = 0; ai < 2; ++ai)
#pragma unroll
            for (int m = 0; m < 4; ++m) sv[ai][m] = rs[u.pm * 256 + EPI_ROWS(ai, m)];
        EPI_FENCE;
#pragma unroll
        for (int ai = 0; ai < 2; ++ai)
#pragma unroll
            for (int m = 0; m < 4; ++m) { const int r = u.pm * 256 + EPI_ROWS(ai, m); const float s = sv[ai][m];
#pragma unroll
                for (int bj = 0; bj < 2; ++bj) *(u32x4*)(O + (size_t)r * ldc + u.pn * 256 + EPI_COL(bj)) = pack8(acc[ai][bj][m][0] * s, acc[ai][bj][m][1] * s); }
    }
};
__device__ __forceinline__ void rope8(f32x4& v0, f32x4& v1, f32x4 c0, f32x4 c1, f32x4 s0, f32x4 s1, int fq) {
    f32x4 p0, p1;
#pragma unroll
    for (int j = 0; j < 4; ++j) { p0[j] = __shfl_xor(v0[j], 32); p1[j] = __shfl_xor(v1[j], 32); }
    const float sg = (fq < 2) ? -1.f : 1.f;
    v0 = v0 * c0 + (p0 * s0) * sg; v1 = v1 * c1 + (p1 * s1) * sg;
}
struct EpiInA {
    const float* rstd0; bf16_t* qlat; bf16_t* qc; bf16_t* kvlat; bf16_t* krope; float* ssqq; float* ssqkv; const float* cs; const float* sn; float qcscale;
    __device__ __forceinline__ void operator()(const acc_t& acc, const Unit& u, int wr, int wc, int fr, int fq) const {
        float sv[2][4];
#pragma unroll
        for (int ai = 0; ai < 2; ++ai)
#pragma unroll
            for (int m = 0; m < 4; ++m) sv[ai][m] = rstd0[u.pm * 256 + EPI_ROWS(ai, m)];
        EPI_FENCE;
        const bool roper = (u.pn == 2) && (wc == 0);
#pragma unroll
        for (int ai = 0; ai < 2; ++ai)
#pragma unroll
          for (int mh = 0; mh < 2; ++mh) {
            f32x4 tc[2][4];
            if (roper) {
#pragma unroll
                for (int mm = 0; mm < 2; ++mm) { const size_t o = (size_t)(u.pm * 256 + EPI_ROWS(ai, 2 * mh + mm)) * 16 + 8 * (fq & 1);
                    tc[mm][0] = *(const f32x4*)(cs + o); tc[mm][1] = *(const f32x4*)(cs + o + 4); tc[mm][2] = *(const f32x4*)(sn + o); tc[mm][3] = *(const f32x4*)(sn + o + 4); }
            }
            EPI_FENCE;
#pragma unroll
            for (int mm = 0; mm < 2; ++mm) { const int m = 2 * mh + mm; const int r = u.pm * 256 + EPI_ROWS(ai, m); const float s = sv[ai][m];
                f32x4 v[2][2];
#pragma unroll
                for (int bj = 0; bj < 2; ++bj) { v[bj][0] = acc[ai][bj][m][0] * s; v[bj][1] = acc[ai][bj][m][1] * s; }
                if (u.pn == 0) {
                    float ss = 0.f;
#pragma unroll
                    for (int bj = 0; bj < 2; ++bj) { *(u32x4*)(qlat + (size_t)r * 256 + EPI_COL(bj)) = pack8(v[bj][0], v[bj][1]);
#pragma unroll
                        for (int n = 0; n < 2; ++n) ss += (v[bj][n][0] * v[bj][n][0] + v[bj][n][1] * v[bj][n][1]) + (v[bj][n][2] * v[bj][n][2] + v[bj][n][3] * v[bj][n][3]); }
                    ss += __shfl_xor(ss, 16); ss += __shfl_xor(ss, 32);
                    if (fq == 0) ssqq[(size_t)r * 4 + wc] = ss;
                } else if (u.pn == 1) {
#pragma unroll
                    for (int bj = 0; bj < 2; ++bj) *(u32x4*)(qc + (size_t)r * 256 + EPI_COL(bj)) = pack8(v[bj][0] * qcscale, v[bj][1] * qcscale);
                } else {
                    float ss = 0.f;
#pragma unroll
                    for (int n = 0; n < 2; ++n) ss += (v[0][n][0] * v[0][n][0] + v[0][n][1] * v[0][n][1]) + (v[0][n][2] * v[0][n][2] + v[0][n][3] * v[0][n][3]);
                    ss += __shfl_xor(ss, 16); ss += __shfl_xor(ss, 32);
                    if (fq == 0) ssqkv[(size_t)r * 4 + wc] = ss;
                    *(u32x4*)(kvlat + (size_t)r * 256 + EPI_COL(0)) = pack8(v[0][0], v[0][1]);
                    *(u32x4*)(kvlat + (size_t)r * 256 + EPI_COL(1)) = (u32x4){0u, 0u, 0u, 0u};
                    if (wc == 0) { f32x4 a = v[1][0], b = v[1][1]; rope8(a, b, tc[mm][0], tc[mm][1], tc[mm][2], tc[mm][3], fq); *(u32x4*)(krope + (size_t)r * 32 + 8 * fq) = pack8(a, b); }
                }
            }
          }
    }
};
struct EpiQKV {
    const float* ssqq; const float* ssqkv; bf16_t* Q; bf16_t* KN; bf16_t* V; const float* cs; const float* sn; float qscale;
    __device__ __forceinline__ void operator()(const acc_t& acc, const Unit& u, int wr, int wc, int fr, int fq) const {
        const bool isq = u.pn < 5;
        const int g32a = isq ? u.pn * 8 + wc : (u.pn - 5) * 8 + wc, g32b = g32a + 4;
        const bool ropea = isq && (g32a % 3 == 2) && g32a < 36, ropeb = isq && (g32b % 3 == 2) && g32b < 36;
#pragma unroll
        for (int ai = 0; ai < 2; ++ai)
#pragma unroll
          for (int mh = 0; mh < 2; ++mh) {
            f32x4 p4[2], tc[2][4];
#pragma unroll
            for (int mm = 0; mm < 2; ++mm) { const int r = u.pm * 256 + EPI_ROWS(ai, 2 * mh + mm); p4[mm] = *(const f32x4*)((isq ? ssqq : ssqkv) + (size_t)r * 4); }
            if (ropea || ropeb) {
#pragma unroll
                for (int mm = 0; mm < 2; ++mm) { const size_t o = (size_t)(u.pm * 256 + EPI_ROWS(ai, 2 * mh + mm)) * 16 + 8 * (fq & 1);
                    tc[mm][0] = *(const f32x4*)(cs + o); tc[mm][1] = *(const f32x4*)(cs + o + 4); tc[mm][2] = *(const f32x4*)(sn + o); tc[mm][3] = *(const f32x4*)(sn + o + 4); }
            }
            EPI_FENCE;
#pragma unroll
            for (int mm = 0; mm < 2; ++mm) { const int m = 2 * mh + mm; const int r = u.pm * 256 + EPI_ROWS(ai, m);
                const float rs = __builtin_amdgcn_rsqf(((p4[mm][0] + p4[mm][1]) + (p4[mm][2] + p4[mm][3])) * (isq ? (1.f / 256.f) : (1.f / 128.f)) + EPS);
#pragma unroll
                for (int bj = 0; bj < 2; ++bj) {
                    f32x4 v0 = acc[ai][bj][m][0] * rs, v1 = acc[ai][bj][m][1] * rs;
                    const int g32 = bj ? g32b : g32a;
                    if (isq) {
                        if (g32 < 36) { if (bj ? ropeb : ropea) rope8(v0, v1, tc[mm][0], tc[mm][1], tc[mm][2], tc[mm][3], fq);
                            *(u32x4*)(Q + (size_t)r * QW + g32 * 32 + 8 * fq) = pack8(v0 * qscale, v1 * qscale); }
                    } else { const int h = g32 >> 2, part = g32 & 3;
                        bf16_t* dst = (part < 2 ? KN : V) + (size_t)r * KVW + h * 64 + (part & 1) * 32 + 8 * fq;
                        *(u32x4*)dst = pack8(v0, v1); }
                }
            }
          }
    }
};
struct EpiWo {
    bf16_t* XS;
    __device__ __forceinline__ void operator()(const acc_t& acc, const Unit& u, int wr, int wc, int fr, int fq) const {
        u32x4 w[2][4][2];
#pragma unroll
        for (int ai = 0; ai < 2; ++ai)
#pragma unroll
            for (int m = 0; m < 4; ++m)
#pragma unroll
                for (int bj = 0; bj < 2; ++bj) w[ai][m][bj] = *(const u32x4*)(XS + (size_t)(u.pm * 256 + EPI_ROWS(ai, m)) * DM + u.pn * 256 + EPI_COL(bj));
        EPI_FENCE;
#pragma unroll
        for (int ai = 0; ai < 2; ++ai)
#pragma unroll
            for (int m = 0; m < 4; ++m)
#pragma unroll
                for (int bj = 0; bj < 2; ++bj) { const u32x4 x = w[ai][m][bj]; const size_t off = (size_t)(u.pm * 256 + EPI_ROWS(ai, m)) * DM + u.pn * 256 + EPI_COL(bj);
                    const f32x4 a = (f32x4){bflo(x.x), bfhi(x.x), bflo(x.y), bfhi(x.y)}, b = (f32x4){bflo(x.z), bfhi(x.z), bflo(x.w), bfhi(x.w)};
                    *(u32x4*)(XS + off) = pack8(acc[ai][bj][m][0] + a, acc[ai][bj][m][1] + b); }
    }
};
struct EpiMoeUp {
    const float* tokr; const float* tokw; bf16_t* ACT;
    __device__ __forceinline__ void operator()(const acc_t& acc, const Unit& u, int wr, int wc, int fr, int fq) const {
        int tok[2][4]; float rsv[2][4], wv[2][4];
#pragma unroll
        for (int ai = 0; ai < 2; ++ai)
#pragma unroll
            for (int m = 0; m < 4; ++m) { const int lr = EPI_ROWS(ai, m); tok[ai][m] = u.list[lr < u.nvalid ? lr : 0]; }
        EPI_FENCE;
#pragma unroll
        for (int ai = 0; ai < 2; ++ai)
#pragma unroll
            for (int m = 0; m < 4; ++m) { rsv[ai][m] = tokr[tok[ai][m]]; wv[ai][m] = tokw[(size_t)tok[ai][m] * 2 + (u.pn >> 1)]; }
        EPI_FENCE;
#pragma unroll
        for (int ai = 0; ai < 2; ++ai)
#pragma unroll
            for (int m = 0; m < 4; ++m) { const int lr = EPI_ROWS(ai, m); const float rs = rsv[ai][m], w = wv[ai][m];
#pragma unroll
                for (int bj = 0; bj < 2; ++bj) { const f32x4 g = acc[ai][bj][m][0] * rs, up = acc[ai][bj][m][1] * rs; f32x4 a;
#pragma unroll
                    for (int j = 0; j < 4; ++j) a[j] = g[j] * __builtin_amdgcn_rcpf(1.0f + __builtin_amdgcn_exp2f(-g[j] * LOG2E)) * up[j] * w;
                    u32x2 o; o.x = pk2(a[0], a[1]); o.y = pk2(a[2], a[3]);
                    *(u32x2*)(ACT + (size_t)(u.aux + lr) * 512 + (u.pn >> 1) * 256 + (u.pn & 1) * 128 + bj * 64 + 16 * wc + 4 * fq) = o; }
            }
    }
};
struct EpiMoeDown {
    bf16_t* XS; float* ssq;
    __device__ __forceinline__ void operator()(const acc_t& acc, const Unit& u, int wr, int wc, int fr, int fq) const {
        int tok[2][4];
#pragma unroll
        for (int ai = 0; ai < 2; ++ai)
#pragma unroll
            for (int m = 0; m < 4; ++m) { const int lr = EPI_ROWS(ai, m); tok[ai][m] = u.list[lr < u.nvalid ? lr : 0]; }
        EPI_FENCE;
#pragma unroll
        for (int ai = 0; ai < 2; ++ai) {
            u32x4 w[4][2];
#pragma unroll
            for (int m = 0; m < 4; ++m)
#pragma unroll
                for (int bj = 0; bj < 2; ++bj) w[m][bj] = *(const u32x4*)(XS + (size_t)tok[ai][m] * DM + u.pn * 256 + EPI_COL(bj));
            EPI_FENCE;
#pragma unroll
            for (int m = 0; m < 4; ++m) { const int lr = EPI_ROWS(ai, m); const bool ok = lr < u.nvalid; float ss = 0.f;
#pragma unroll
                for (int bj = 0; bj < 2; ++bj) { const size_t off = (size_t)tok[ai][m] * DM + u.pn * 256 + EPI_COL(bj); const u32x4 x = w[m][bj];
                    const f32x4 a = acc[ai][bj][m][0] + (f32x4){bflo(x.x), bfhi(x.x), bflo(x.y), bfhi(x.y)}, b = acc[ai][bj][m][1] + (f32x4){bflo(x.z), bfhi(x.z), bflo(x.w), bfhi(x.w)};
                    ss += (a[0] * a[0] + a[1] * a[1]) + (a[2] * a[2] + a[3] * a[3]) + (b[0] * b[0] + b[1] * b[1]) + (b[2] * b[2] + b[3] * b[3]);
                    if (ok) *(u32x4*)(XS + off) = pack8(a, b); }
                ss += __shfl_xor(ss, 16); ss += __shfl_xor(ss, 32);
                if (ok && fq == 0) ssq[(size_t)tok[ai][m] * 16 + u.pn * 4 + wc] = ss;
            }
        }
    }
};
struct EpiInP {
    const float* ssq; bf16_t* Z; float qcscale;
    __device__ __forceinline__ void operator()(const acc_t& acc, const Unit& u, int wr, int wc, int fr, int fq) const {
        const float cscale = (u.pn == 3) ? qcscale : 1.0f;
#pragma unroll
        for (int ai = 0; ai < 2; ++ai) {
            f32x4 p[4][4];
#pragma unroll
            for (int m = 0; m < 4; ++m) { const f32x4* pp = (const f32x4*)(ssq + (size_t)(u.pm * 256 + EPI_ROWS(ai, m)) * 16);
#pragma unroll
                for (int q = 0; q < 4; ++q) p[m][q] = pp[q]; }
            EPI_FENCE;
#pragma unroll
            for (int m = 0; m < 4; ++m) { const int r = u.pm * 256 + EPI_ROWS(ai, m);
                const f32x4 s4 = (p[m][0] + p[m][1]) + (p[m][2] + p[m][3]); const float rs = cscale * __builtin_amdgcn_rsqf(((s4[0] + s4[1]) + (s4[2] + s4[3])) * (1.f / 1024.f) + EPS);
#pragma unroll
                for (int bj = 0; bj < 2; ++bj) *(u32x4*)(Z + (size_t)r * DM + u.pn * 256 + EPI_COL(bj)) = pack8(acc[ai][bj][m][0] * rs, acc[ai][bj][m][1] * rs); }
        }
    }
};
struct EpiPool {
    const float* scale; bf16_t* CC;
    __device__ __forceinline__ void operator()(const acc_t& acc, const Unit& u, int wr, int wc, int fr, int fq) const {
#pragma unroll
        for (int bj = 0; bj < 2; ++bj) { const int cl = EPI_COL(bj); if (cl < 192) { const int col = u.pn * 192 + cl;
            const f32x4 s0 = *(const f32x4*)(scale + col), s1 = *(const f32x4*)(scale + col + 4);
#pragma unroll
            for (int ai = 0; ai < 2; ++ai)
#pragma unroll
                for (int m = 0; m < 4; ++m) { const int r = u.pm * 256 + EPI_ROWS(ai, m); *(u32x4*)(CC + (size_t)r * DM + col) = pack8(acc[ai][bj][m][0] * s0, acc[ai][bj][m][1] * s1); } } }
    }
};

namespace att {
__device__ __forceinline__ int crow(int r, int hi) { return (r & 3) + 8 * (r >> 2) + 4 * hi; }
template <int DQ, bool CAUSAL>
__device__ __forceinline__ void attn_unit(LAS unsigned char* L, const bf16_t* Qw, int ldq, const bf16_t* Kn, int ldk, const bf16_t* Kr, int ldkr,
                                          const bf16_t* Vp, int ldv, bf16_t* Ow, int ldo, const int NT, const int wid, const int lane) {
    constexpr int ND = DQ / 16, NCH = DQ / 8, KSL = NCH * 1024, LV = 2 * KSL, LWS = LV + 16384, LOST = LWS + 2048;
    const int r32 = lane & 31, hi = lane >> 5;
    LAS float* wsf = (LAS float*)(L + LWS) + wid * 64;
#define ATT_DMA(t, slot) do { \
        __builtin_amdgcn_global_load_lds((const unsigned*)(Kn + (size_t)((t) * 64 + lane) * ldk + wid * 8), (LAS unsigned*)(L + (slot) * KSL + wid * 1024), 16, 0, 0); \
        if (NCH > 8 && wid < NCH - 8) __builtin_amdgcn_global_load_lds((const unsigned*)(Kr + (size_t)((t) * 64 + lane) * ldkr + wid * 8), (LAS unsigned*)(L + (slot) * KSL + (8 + wid) * 1024), 16, 0, 0); \
        __builtin_amdgcn_global_load_lds((const unsigned*)(Vp + (size_t)((t) * 64 + 16 * (wid & 3) + (lane >> 2)) * ldv + (wid >> 2) * 32 + (lane & 3) * 8), (LAS unsigned*)(L + LV + (slot) * 8192 + wid * 1024), 16, 0, 0); } while (0)
    ATT_DMA(0, 0);
    bf16x8 qr[ND];
#pragma unroll
    for (int d0 = 0; d0 < ND; ++d0) qr[d0] = *(const bf16x8*)(Qw + (size_t)(wid * 32 + r32) * ldq + d0 * 16 + hi * 8);
    f32x16 o0 = {}, o1 = {};
    float mrun = -1e30f, lrun = 0.f;
    const int vb0 = ((lane >> 4) & 1) * 32 + (lane & 3) * 8 + (4 * hi + ((lane & 15) >> 2)) * 64;
    asm volatile("s_waitcnt vmcnt(0) lgkmcnt(0)" ::: "memory"); __builtin_amdgcn_s_barrier(); asm volatile("" ::: "memory");
    for (int t = 0; t < NT; ++t) {
        const int slot = t & 1;
        if (t + 1 < NT) ATT_DMA(t + 1, slot ^ 1);
        const int jb = t - (NT - 4);
        const bool skip = CAUSAL && jb >= 0 && (64 * jb > 32 * wid + 31);
        if (!skip) {
            f32x16 p0 = {}, p1 = {};
            const LAS unsigned char* kb = L + slot * KSL + hi * 1024 + r32 * 16;
#pragma unroll
            for (int d0 = 0; d0 < ND; ++d0) {
                const bf16x8 b0 = *(const LAS bf16x8*)(kb + d0 * 2048), b1 = *(const LAS bf16x8*)(kb + d0 * 2048 + 512);
                p0 = __builtin_amdgcn_mfma_f32_32x32x16_bf16(b0, qr[d0], p0, 0, 0, 0);
                p1 = __builtin_amdgcn_mfma_f32_32x32x16_bf16(b1, qr[d0], p1, 0, 0, 0);
            }
            if (CAUSAL && jb >= 0) { const int qrel = wid * 32 + r32, kbase = 64 * jb + 4 * hi;
#pragma unroll
                for (int r = 0; r < 16; ++r) { const int kv = kbase + (r & 3) + 8 * (r >> 2); if (kv > qrel) p0[r] = -INFINITY; if (kv + 32 > qrel) p1[r] = -INFINITY; } }
            float rm = fmaxf(p0[0], p1[0]);
#pragma unroll
            for (int r = 1; r < 16; ++r) rm = fmaxf(rm, fmaxf(p0[r], p1[r]));
            rm = fmaxf(rm, __shfl_xor(rm, 32));
            const float mnew = fmaxf(mrun, rm), f = __builtin_amdgcn_exp2f(mrun - mnew);
            mrun = mnew;
            float sacc = 0.f;
#pragma unroll
            for (int r = 0; r < 16; ++r) { p0[r] = __builtin_amdgcn_exp2f(p0[r] - mnew); p1[r] = __builtin_amdgcn_exp2f(p1[r] - mnew); sacc += p0[r] + p1[r]; }
            lrun = lrun * f + sacc;
            if (__any(f != 1.0f)) {
                if (hi == 0) wsf[r32] = f;
                LDS_WAIT();
#pragma unroll
                for (int r = 0; r < 16; ++r) { const float ff = wsf[crow(r, hi)]; o0[r] *= ff; o1[r] *= ff; }
            }
            u32x4 pw[4];
#pragma unroll
            for (int k = 0; k < 2; ++k) { pw[k] = (u32x4){pk2(p0[8 * k], p0[8 * k + 1]), pk2(p0[8 * k + 2], p0[8 * k + 3]), pk2(p0[8 * k + 4], p0[8 * k + 5]), pk2(p0[8 * k + 6], p0[8 * k + 7])};
                                          pw[2 + k] = (u32x4){pk2(p1[8 * k], p1[8 * k + 1]), pk2(p1[8 * k + 2], p1[8 * k + 3]), pk2(p1[8 * k + 4], p1[8 * k + 5]), pk2(p1[8 * k + 6], p1[8 * k + 7])}; }
            const LAS unsigned char* vp = L + LV + slot * 8192 + vb0;
#pragma unroll
            for (int d0 = 0; d0 < 2; ++d0) {
#pragma unroll
                for (int ks = 0; ks < 4; ++ks) {
                    const s16x4 lo = __builtin_bit_cast(s16x4, __builtin_amdgcn_ds_read_tr16_b64_v4i16((LAS s16x4*)(vp + d0 * 4096 + ks * 1024)));
                    const s16x4 hh = __builtin_bit_cast(s16x4, __builtin_amdgcn_ds_read_tr16_b64_v4i16((LAS s16x4*)(vp + d0 * 4096 + ks * 1024 + 512)));
                    const bf16x8 vf = (bf16x8){lo[0], lo[1], lo[2], lo[3], hh[0], hh[1], hh[2], hh[3]};
                    if (d0 == 0) o0 = __builtin_amdgcn_mfma_f32_32x32x16_bf16(__builtin_bit_cast(bf16x8, pw[ks]), vf, o0, 0, 0, 0);
                    else         o1 = __builtin_amdgcn_mfma_f32_32x32x16_bf16(__builtin_bit_cast(bf16x8, pw[ks]), vf, o1, 0, 0, 0);
                }
            }
        }
        asm volatile("s_waitcnt vmcnt(0) lgkmcnt(0)" ::: "memory"); __builtin_amdgcn_s_barrier(); asm volatile("" ::: "memory");
    }
    lrun += __shfl_xor(lrun, 32);
    if (hi == 0) wsf[32 + r32] = lrun;
    LDS_WAIT();
    bf16_t LAS* stg = (bf16_t LAS*)(L + LOST) + wid * 2048;
#pragma unroll
    for (int r = 0; r < 16; ++r) { const int orow = crow(r, hi); const float rl = __builtin_amdgcn_rcpf(wsf[32 + orow]);
        stg[orow * 64 + r32] = (bf16_t)(pk2(o0[r] * rl, 0.f) & 0xffffu); stg[orow * 64 + 32 + r32] = (bf16_t)(pk2(o1[r] * rl, 0.f) & 0xffffu); }
    LDS_WAIT();
#pragma unroll
    for (int i = 0; i < 4; ++i) { const int row = i * 8 + (lane >> 3), ch = lane & 7; const u32x4 v = *(const LAS u32x4*)(stg + row * 64 + ch * 8); *(u32x4*)(Ow + (size_t)(wid * 32 + row) * ldo + ch * 8) = v; }
    asm volatile("s_waitcnt lgkmcnt(0)" ::: "memory"); __builtin_amdgcn_s_barrier(); asm volatile("" ::: "memory");
#undef ATT_DMA
}
}

struct Args { const float* in[24]; float* out; unsigned char* ws; };
struct Frame { LAS unsigned char* lds; unsigned* ctl; int tid, lane, wave, vcu, G; };
__device__ __forceinline__ Frame phase_frame(const Frame& F0) { Frame F = F0; int t = threadIdx.x; asm volatile("" : "+v"(t)); F.tid = t; F.lane = t & 63; F.wave = __builtin_amdgcn_readfirstlane(t >> 6); return F; }

template <class RowMap>
__device__ __forceinline__ void tr_item(const float* W, int ldw, const float* gain, bf16_t* WT, size_t ldt, int dcol0, RowMap rm, LAS float* scr, int k0, int n0, int lane) {
#pragma unroll 8
    for (int i = 0; i < 32; ++i) { const int kk = 2 * i + (lane >> 5); float v = W[(size_t)(k0 + kk) * ldw + n0 + (lane & 31)]; if (gain) v *= gain[k0 + kk]; scr[kk * 33 + (lane & 31)] = v; }
    LDS_WAIT(); asm volatile("" ::: "memory");
    const int c = lane & 7;
#pragma unroll
    for (int j = 0; j < 4; ++j) { const int n = (lane >> 3) + 8 * j; const LAS float* s = scr + (8 * c) * 33 + n;
        u32x4 o; o.x = pk2(s[0 * 33], s[1 * 33]); o.y = pk2(s[2 * 33], s[3 * 33]); o.z = pk2(s[4 * 33], s[5 * 33]); o.w = pk2(s[6 * 33], s[7 * 33]);
        *(u32x4*)(WT + (size_t)rm(n0 + n) * ldt + dcol0 + k0 + 8 * c) = o; }
    LDS_WAIT(); asm volatile("" ::: "memory");
}
struct RmId { __device__ __forceinline__ int operator()(int n) const { return n; } };
struct RmOff { int off; __device__ __forceinline__ int operator()(int n) const { return n + off; } };
struct RmInA { __device__ __forceinline__ int operator()(int n) const { return n < 256 ? n : (n < 384 ? n + 256 : (n < 416 ? n + 256 : n - 160)); } };
struct RmGU { int up; __device__ __forceinline__ int operator()(int h) const { return (h >> 2) * 8 + (h & 3) + 4 * up; } };
__device__ __forceinline__ void zero16(bf16_t* p) { *(u32x4*)p = (u32x4){0u, 0u, 0u, 0u}; }

__device__ __forceinline__ void p0_prologue(const Frame& F0, const Args& a) {
    const Frame F = phase_frame(F0);
    unsigned char* ws = a.ws;
    LAS float* scr = (LAS float*)(F.lds + F.wave * 16384);
    const int gw = F.vcu * 8 + F.wave, NGW = F.G * 8, lane = F.lane;
    bf16_t* WinA = (bf16_t*)(ws + WS_WINA); bf16_t* Wqkv = (bf16_t*)(ws + WS_WQKV); bf16_t* WinP = (bf16_t*)(ws + WS_WINP); bf16_t* Wpool = (bf16_t*)(ws + WS_WPOOL);
    bf16_t* Wmem = (bf16_t*)(ws + WS_WMEM); bf16_t* Wo = (bf16_t*)(ws + WS_WO); bf16_t* Wgu = (bf16_t*)(ws + WS_WGU); bf16_t* Wd = (bf16_t*)(ws + WS_WD);
    constexpr int I_INA = 16 * 21, I_UQ = 4 * 36, I_UKV = 2 * 48, I_INP = 16 * 32, I_POOL = 4 * 18, I_MEM = 16 * 16, I_WO = 2 * 512, I_G = 64 * 128, I_U = 64 * 128, I_D = 64 * 128;
    constexpr int NITEMS = I_INA + I_UQ + I_UKV + I_INP + I_POOL + I_MEM + I_WO + I_G + I_U + I_D;
    for (int it = gw; it < NITEMS; it += NGW) {
        int r = it;
        if (r < I_INA) { tr_item(a.in[4], 672, a.in[3], WinA, 1024, 0, RmInA{}, scr, 64 * (r / 21), 32 * (r % 21), lane); continue; } r -= I_INA;
        if (r < I_UQ) { tr_item(a.in[6], 1152, a.in[5], Wqkv, 256, 0, RmId{}, scr, 64 * (r / 36), 32 * (r % 36), lane); continue; } r -= I_UQ;
        if (r < I_UKV) { tr_item(a.in[8], 1536, a.in[7], Wqkv, 256, 0, RmOff{1280}, scr, 64 * (r / 48), 32 * (r % 48), lane); continue; } r -= I_UKV;
        if (r < I_INP) { tr_item(a.in[9], 1024, a.in[3] + 1024, WinP, 1024, 0, RmId{}, scr, 64 * (r / 32), 32 * (r % 32), lane); continue; } r -= I_INP;
        if (r < I_POOL) { const int g = r / 18, q = r % 18; tr_item(a.in[10] + (size_t)g * 192 * 192, 192, nullptr, Wpool + (size_t)g * 65536, 256, 0, RmId{}, scr, 64 * (q / 6), 32 * (q % 6), lane); continue; } r -= I_POOL;
        if (r < I_MEM) { tr_item(a.in[13], 512, a.in[12], Wmem, 1024, 0, RmId{}, scr, 64 * (r / 16), 32 * (r % 16), lane); continue; } r -= I_MEM;
        if (r < I_WO) { const int l = r / 512, q = r % 512; tr_item(a.in[14] + (size_t)l * 1048576, 1024, nullptr, Wo + (size_t)l * 1048576, 1024, 0, RmId{}, scr, 64 * (q / 32), 32 * (q % 32), lane); continue; } r -= I_WO;
        if (r < I_G) { const int le = r / 128, q = r % 128; tr_item(a.in[20] + (size_t)le * 262144, 256, a.in[15] + (le / 32) * 1024, Wgu + (size_t)le * 524288, 1024, 0, RmGU{0}, scr, 64 * (q / 8), 32 * (q % 8), lane); continue; } r -= I_G;
        if (r < I_U) { const int le = r / 128, q = r % 128; tr_item(a.in[21] + (size_t)le * 262144, 256, a.in[15] + (le / 32) * 1024, Wgu + (size_t)le * 524288, 1024, 0, RmGU{1}, scr, 64 * (q / 8), 32 * (q % 8), lane); continue; } r -= I_U;
        { const int le = r / 128, q = r % 128, l = le / 32, e = le % 32;
          tr_item(a.in[22] + (size_t)le * 262144, 1024, nullptr, Wd + ((size_t)l * 4 + (e >> 3)) * (1024 * 2048), 2048, (e & 7) * 256, RmId{}, scr, 64 * (q / 32), 32 * (q % 32), lane); }
    }
    const int gt = (F.vcu * 8 + F.wave) * 64 + lane, NGT = NGW * 64;
    for (int c = gt; c < 96 * 128; c += NGT) zero16(WinA + (size_t)672 * 1024 + (size_t)c * 8);
    for (int c = gt; c < 128 * 32; c += NGT) zero16(Wqkv + (size_t)1152 * 256 + (size_t)c * 8);
    for (int c = gt; c < 1536 * 16; c += NGT) zero16(Wqkv + (size_t)(1280 + c / 16) * 256 + 128 + (c % 16) * 8);
    for (int c = gt; c < 4 * 64 * 32; c += NGT) { const int g = c / 2048, q = c % 2048; zero16(Wpool + (size_t)g * 65536 + (size_t)(192 + q / 32) * 256 + (q % 32) * 8); }
    for (int c = gt; c < 4 * 192 * 8; c += NGT) { const int g = c / 1536, q = c % 1536; zero16(Wpool + (size_t)g * 65536 + (size_t)(q / 8) * 256 + 192 + (q % 8) * 8); }
    { bf16_t* Wr = (bf16_t*)(ws + WS_WR);
      for (int c = gt; c < 2 * 48 * 1024; c += NGT) { const int l = c / 49152, q = c % 49152, j = q / 1024, k = q % 1024; float w = 0.f;
          if (j < 4) w = a.in[16][((size_t)l * 1024 + k) * 4 + j]; else if (j >= 16) w = a.in[18][((size_t)l * 1024 + k) * 32 + (j - 16)];
          w *= a.in[15][l * 1024 + k]; const unsigned hi = pk2(w, 0.f) & 0xffffu; const float rem = w - __uint_as_float(hi << 16);
          Wr[((size_t)l * 96 + j) * 1024 + k] = (bf16_t)hi; Wr[((size_t)l * 96 + 48 + j) * 1024 + k] = (bf16_t)(pk2(rem, 0.f) & 0xffffu); } }
    { float* cs = (float*)(ws + WS_CS); float* sn = (float*)(ws + WS_SN); const int* pos = (const int*)a.in[2];
      for (int c = gt; c < T * 16; c += NGT) { const int t = c >> 4, i = c & 15; const float inv = powf(10000.0f, -(float)(2 * i) / 32.0f); const float ang = (float)pos[t] * inv; cs[c] = cosf(ang); sn[c] = sinf(ang); } }
    { bf16_t* XS = (bf16_t*)(ws + WS_XS); float* rstd0 = (float*)(ws + WS_RSTD0); bf16_t* MB = (bf16_t*)(ws + WS_MEMB); float* rstdm = (float*)(ws + WS_RSTDM);
      for (int m = gw; m < T + TMEM; m += NGW) { const bool ism = m >= T; const int row = ism ? m - T : m;
          const f32x4* xr = (const f32x4*)((ism ? a.in[1] : a.in[0]) + (size_t)row * DM) + lane; f32x4 v[4]; float s2 = 0.f;
#pragma unroll
          for (int j = 0; j < 4; ++j) { v[j] = xr[64 * j]; s2 += (v[j][0] * v[j][0] + v[j][1] * v[j][1]) + (v[j][2] * v[j][2] + v[j][3] * v[j][3]); }
          s2 = wave_sum(s2); const float rs = 1.0f / sqrtf(s2 * (1.f / DM) + EPS);
          u32x2* o8 = (u32x2*)((ism ? MB : XS) + (size_t)row * DM) + lane;
#pragma unroll
          for (int j = 0; j < 4; ++j) o8[64 * j] = (u32x2){pk2(v[j][0], v[j][1]), pk2(v[j][2], v[j][3])};
          if (lane == 0) (ism ? rstdm : rstd0)[row] = rs; } }
}

__device__ __forceinline__ void attn_phase(const Frame& F0, unsigned char* ws, bool mla, const bf16_t* QC, int ldqc) {
    const Frame F = phase_frame(F0);
    const bf16_t* Q = (const bf16_t*)(ws + WS_Q); const bf16_t* KN = (const bf16_t*)(ws + WS_KN); const bf16_t* KR = (const bf16_t*)(ws + WS_KROPE); const bf16_t* V = (const bf16_t*)(ws + WS_V);
    const bf16_t* MKV = (const bf16_t*)(ws + WS_MEMKV); bf16_t* CC = (bf16_t*)(ws + WS_CONCAT);
    if (mla) {
        for (int i = 0; i < 6; ++i) { const int pidx = i * F.G + F.vcu; if (pidx >= NB * NHEAD * 4) break; const int bh = pidx >> 2, pr = pidx & 3, b = bh / NHEAD, h = bh % NHEAD;
#pragma unroll 1
            for (int k = 0; k < 2; ++k) { const int qb = k == 0 ? 7 - pr : pr; const size_t row0 = (size_t)b * SEQ, q0 = row0 + (size_t)qb * 256;
                att::attn_unit<96, true>(F.lds, Q + q0 * QW + h * DQK, QW, KN + row0 * KVW + h * 64, KVW, KR + row0 * 32, 32, V + row0 * KVW + h * 64, KVW, CC + q0 * DM + h * 64, DM, 4 * (qb + 1), F.wave, F.lane); } }
    }
    for (int i = 0; i < 4; ++i) { const int uidx = i * F.G + F.vcu; if (uidx >= NB * 4 * 8) break; const int qb = uidx & 7, h = (uidx >> 3) & 3, b = uidx >> 5; const size_t q0 = (size_t)b * SEQ + (size_t)qb * 256;
        att::attn_unit<64, false>(F.lds, QC + q0 * ldqc + h * 64, ldqc, MKV + (size_t)b * MEML * 512 + h * 64, 512, nullptr, 0, MKV + (size_t)b * MEML * 512 + 256 + h * 64, 512, CC + q0 * DM + 768 + h * 64, DM, 4, F.wave, F.lane); }
}

__device__ __forceinline__ void router_phase(const Frame& F0, const Args& a, int layer) {
    const Frame F = phase_frame(F0);
    unsigned char* ws = a.ws; const bf16_t* XS = (const bf16_t*)(ws + WS_XS); const bf16_t* Wr = (const bf16_t*)(ws + WS_WR) + (size_t)layer * 96 * 1024;
    float* tokw = (float*)(ws + WS_TOKW); float* tokr = (float*)(ws + WS_TOKR); int* list = (int*)(ws + WS_LIST); unsigned* cnt = F.ctl + CW_CNT + layer * 128;
    const float* brg = a.in[17] + layer * 4; const float* bre = a.in[19] + layer * 32;
    const int lane = F.lane, fr = lane & 15, fq = lane >> 4, wid = F.wave;
    constexpr int WP = 520;
    LAS bf16_t* Bs = (LAS bf16_t*)F.lds;
    LAS float* LG = (LAS float*)F.lds;
    for (int blk = F.vcu; blk < T / 256; blk += F.G) {
        const int row0 = blk * 256 + wid * 32;
        f32x4 acc[2][6]; float ssq[2] = {0.f, 0.f};
#pragma unroll
        for (int mt = 0; mt < 2; ++mt)
#pragma unroll
            for (int i = 0; i < 6; ++i) acc[mt][i] = (f32x4){0.f, 0.f, 0.f, 0.f};
        for (int kc = 0; kc < 2; ++kc) {
            __syncthreads();
            for (int c = F.tid; c < 96 * 64; c += 512) { const int n = c >> 6, ch = c & 63; *(LAS u32x4*)(Bs + n * WP + ch * 8) = *(const u32x4*)(Wr + (size_t)n * 1024 + kc * 512 + ch * 8); }
            __syncthreads();
#pragma unroll 4
            for (int ks = 0; ks < 16; ++ks) {
                bf16x8 af[2];
#pragma unroll
                for (int mt = 0; mt < 2; ++mt) { af[mt] = *(const bf16x8*)(XS + (size_t)(row0 + mt * 16 + fr) * DM + kc * 512 + ks * 32 + fq * 8);
#pragma unroll
                    for (int j = 0; j < 8; ++j) { const float x = __uint_as_float(((unsigned)(unsigned short)af[mt][j]) << 16); ssq[mt] += x * x; } }
#pragma unroll
                for (int i = 0; i < 6; ++i) { const bf16x8 bfr = *(const LAS bf16x8*)(Bs + (i * 16 + fr) * WP + ks * 32 + fq * 8);
#pragma unroll
                    for (int mt = 0; mt < 2; ++mt) acc[mt][i] = __builtin_amdgcn_mfma_f32_16x16x32_bf16(bfr, af[mt], acc[mt][i], 0, 0, 0); }
            }
        }
        __syncthreads();
#pragma unroll
        for (int mt = 0; mt < 2; ++mt) { float s = ssq[mt]; s += __shfl_xor(s, 16); s += __shfl_xor(s, 32); const float rs = 1.0f / sqrtf(s * (1.f / DM) + EPS); const int lr = wid * 32 + mt * 16 + fr;
#pragma unroll
            for (int i = 0; i < 3; ++i) { const f32x4 v = (acc[mt][i] + acc[mt][i + 3]) * rs;
#pragma unroll
                for (int j = 0; j < 4; ++j) LG[lr * 49 + 16 * i + 4 * fq + j] = v[j]; }
            if (fq == 0) LG[lr * 49 + 48] = rs; }
        __syncthreads();
        if (F.tid < 256) { const int tok = blk * 256 + F.tid; const LAS float* lg = LG + F.tid * 49;
            float g[4]; int gs = 0; float gm;
#pragma unroll
            for (int j = 0; j < 4; ++j) g[j] = lg[j] + brg[j];
            gm = g[0];
#pragma unroll
            for (int j = 1; j < 4; ++j) if (g[j] > gm) { gm = g[j]; gs = j; }
            float den = 0.f;
#pragma unroll
            for (int j = 0; j < 4; ++j) den += __expf(g[j] - gm);
            const float gate = 1.0f / den;
            float e[8];
#pragma unroll
            for (int j = 0; j < 8; ++j) e[j] = lg[16 + gs * 8 + j] + bre[gs * 8 + j];
            int i1 = 0; float m1 = e[0];
#pragma unroll
            for (int j = 1; j < 8; ++j) if (e[j] > m1) { m1 = e[j]; i1 = j; }
            int i2 = -1; float m2 = -INFINITY;
#pragma unroll
            for (int j = 0; j < 8; ++j) if (j != i1 && e[j] > m2) { m2 = e[j]; i2 = j; }
            const float w1 = gate / (1.0f + __expf(m2 - m1)), w2 = gate - w1;
            const int elo = i1 < i2 ? i1 : i2, ehi = i1 < i2 ? i2 : i1; const float wlo = i1 < i2 ? w1 : w2, whi = i1 < i2 ? w2 : w1;
            const int pidx = elo * 7 - (elo * (elo - 1)) / 2 + (ehi - elo - 1);
            const int b = gs * 28 + pidx;
            tokw[(size_t)tok * 2] = wlo; tokw[(size_t)tok * 2 + 1] = whi; tokr[tok] = lg[48];
            const unsigned pos = atomicAdd(cnt + b, 1u);
            list[(size_t)b * CAP + pos] = tok;
        }
        __syncthreads();
    }
}
__device__ __forceinline__ void moe_table(const Frame& F0, int layer) {
    const Frame F = phase_frame(F0);
    LAS int* tab = (LAS int*)(F.lds + L_TAB); const unsigned* cnt = F.ctl + CW_CNT + layer * 128;
    if (F.tid < NBUCKET) tab[128 + F.tid] = (int)__hip_atomic_load(cnt + F.tid, __ATOMIC_RELAXED, __HIP_MEMORY_SCOPE_AGENT);
    __syncthreads();
    if (F.tid == 0) { int s = 0; for (int b = 0; b < NBUCKET; ++b) { tab[b] = s; s += (tab[128 + b] + 255) >> 8; } tab[NBUCKET] = s; }
    __syncthreads();
}

__device__ __forceinline__ void pool_diff_phase(const Frame& F0, unsigned char* ws) {
    const Frame F = phase_frame(F0);
    const bf16_t* Z = (const bf16_t*)(ws + WS_Z); bf16_t* DG = (bf16_t*)(ws + WS_DG);
    constexpr int SR = 64, HALO = 15, LROW = 1552;
    for (int strip = F.vcu; strip < T / SR; strip += F.G) {
        const int t0 = strip * SR, s0 = t0 & (SEQ - 1), hl = min(HALO, s0);
        __syncthreads();
        for (int c = F.tid; c < (SR + hl) * 96; c += 512) { const int rr = c / 96, ch = c % 96;
            *(LAS u32x4*)(F.lds + (size_t)(rr + HALO - hl) * LROW + ch * 16) = *(const u32x4*)(Z + (size_t)(t0 - hl + rr) * DM + ch * 8); }
        __syncthreads();
        for (int c = F.tid; c < SR * 128; c += 512) { const int rr = c >> 7, q = c & 127, g = q >> 5, ch = q & 31; const int t = t0 + rr;
            u32x4 o = (u32x4){0u, 0u, 0u, 0u};
            if (ch < 24) { const int win = 2 << g, n = min(s0 + rr + 1, win); float acc[8] = {0.f, 0.f, 0.f, 0.f, 0.f, 0.f, 0.f, 0.f}; float own[8] = {0.f, 0.f, 0.f, 0.f, 0.f, 0.f, 0.f, 0.f};
                const LAS unsigned char* base = F.lds + (size_t)(rr + HALO) * LROW + (g * 24 + ch) * 16;
                for (int j = 0; j < n; ++j) { const u32x4 w = *(const LAS u32x4*)(base - (size_t)j * LROW);
                    const float x[8] = {bflo(w.x), bfhi(w.x), bflo(w.y), bfhi(w.y), bflo(w.z), bfhi(w.z), bflo(w.w), bfhi(w.w)};
#pragma unroll
                    for (int k = 0; k < 8; ++k) { acc[k] += x[k]; if (j == 0) own[k] = x[k]; } }
                const float inv = 1.0f / (float)n;
                o = (u32x4){pk2(acc[0] * inv - own[0], acc[1] * inv - own[1]), pk2(acc[2] * inv - own[2], acc[3] * inv - own[3]), pk2(acc[4] * inv - own[4], acc[5] * inv - own[5]), pk2(acc[6] * inv - own[6], acc[7] * inv - own[7])}; }
            *(u32x4*)(DG + ((size_t)g * T + t) * 256 + ch * 8) = o; }
    }
    __syncthreads();
}
__device__ __forceinline__ void final_phase(const Frame& F0, const Args& a) {
    const Frame F = phase_frame(F0);
    const bf16_t* XS = (const bf16_t*)(a.ws + WS_XS); const float* gf = a.in[23];
    const int gw = F.vcu * 8 + F.wave, NGW = F.G * 8, lane = F.lane;
    f32x4 gv[4];
#pragma unroll
    for (int j = 0; j < 4; ++j) gv[j] = *((const f32x4*)gf + lane + 64 * j);
    for (int m = gw; m < T; m += NGW) { const u32x2* xr = (const u32x2*)(XS + (size_t)m * DM) + lane; f32x4 v[4]; float s2 = 0.f;
#pragma unroll
        for (int j = 0; j < 4; ++j) { const u32x2 w = xr[64 * j]; v[j] = (f32x4){bflo(w.x), bfhi(w.x), bflo(w.y), bfhi(w.y)}; s2 += (v[j][0] * v[j][0] + v[j][1] * v[j][1]) + (v[j][2] * v[j][2] + v[j][3] * v[j][3]); }
        s2 = wave_sum(s2); const float rs = 1.0f / sqrtf(s2 * (1.f / DM) + EPS);
        f32x4* o = (f32x4*)(a.out + (size_t)m * DM) + lane;
#pragma unroll
        for (int j = 0; j < 4; ++j) o[64 * j] = v[j] * rs * gv[j]; }
}

#ifndef PHASE_MASK
#define PHASE_MASK 0xFFFFFFFFu
#endif
#define PH(n) ((PHASE_MASK >> (n)) & 1u)
__global__ void __launch_bounds__(512, 2) fwd_kernel(Args args) {
    extern __shared__ __attribute__((aligned(16))) unsigned char lds_raw[];
    Frame F; F.lds = (LAS unsigned char*)lds_raw; F.tid = threadIdx.x; F.lane = F.tid & 63; F.wave = __builtin_amdgcn_readfirstlane(F.tid >> 6);
    F.G = gridDim.x; { const int bx = blockIdx.x; F.vcu = (F.G % 8 == 0) ? (bx % 8) * (F.G / 8) + bx / 8 : bx; }
    unsigned char* ws = args.ws; F.ctl = (unsigned*)(ws + WS_CTL);
    for (int u = F.tid; u < (LDS_BYTES - RING_BYTES) / 4; u += 512) ((LAS unsigned*)(F.lds + RING_BYTES))[u] = 0u;
    __syncthreads();
    XcdBarrier bar = xcd_barrier_post(F.ctl + CW_BAR, (volatile LAS unsigned*)(F.lds + L_MISC) + 8);
    LAS unsigned char* listbuf = F.lds + L_LIST;
    const float qcscale = 0.125f * LOG2E;
    const float qscale = 0.10206207261596577f * LOG2E;

    if (PH(0)) p0_prologue(F, args);
    xcd_barrier(bar);
    if (PH(1)) {   SchedPlain S; S.o.init(TMEM / 256, 2, F.G, (int)blockIdx.x); S.A = (const char*)(ws + WS_MEMB); S.B = (const char*)(ws + WS_WMEM); S.a_tile = 256 * 2048; S.b_tile = 256 * 2048;
        EpiRowScale E{(bf16_t*)(ws + WS_MEMKV), 512, (const float*)(ws + WS_RSTDM)};
        pg8::gemm_run<EpiRowScale, SchedPlain, false>(F.lds, listbuf, S, E, 16, 1 << 30, 2048u, 2048u); }
    if (PH(2)) {   SchedPlain S; S.o.init(T / 256, 3, F.G, (int)blockIdx.x); S.A = (const char*)(ws + WS_XS); S.B = (const char*)(ws + WS_WINA); S.a_tile = 256 * 2048; S.b_tile = 256 * 2048;
        EpiInA E{(const float*)(ws + WS_RSTD0), (bf16_t*)(ws + WS_QLAT), (bf16_t*)(ws + WS_QC), (bf16_t*)(ws + WS_KVLAT), (bf16_t*)(ws + WS_KROPE), (float*)(ws + WS_SSQQ), (float*)(ws + WS_SSQKV),
                 (const float*)(ws + WS_CS), (const float*)(ws + WS_SN), qcscale};
        pg8::gemm_run<EpiInA, SchedPlain, false>(F.lds, listbuf, S, E, 16, 1 << 30, 2048u, 2048u); }
    xcd_barrier(bar);
    if (PH(3)) {   SchedQKV S; S.o.init(T / 256, 11, F.G, (int)blockIdx.x); S.Aq = (const char*)(ws + WS_QLAT); S.Akv = (const char*)(ws + WS_KVLAT); S.B = (const char*)(ws + WS_WQKV);
        EpiQKV E{(const float*)(ws + WS_SSQQ), (const float*)(ws + WS_SSQKV), (bf16_t*)(ws + WS_Q), (bf16_t*)(ws + WS_KN), (bf16_t*)(ws + WS_V), (const float*)(ws + WS_CS), (const float*)(ws + WS_SN), qscale};
        pg8::gemm_run<EpiQKV, SchedQKV, false>(F.lds, listbuf, S, E, 4, 1 << 30, 512u, 512u); }
    xcd_barrier(bar);
#pragma unroll 1
    for (int layer = 0; layer < 2; ++layer) {
        { size_t zoff = 0; asm volatile("" : "+s"(zoff)); ws = args.ws + zoff; }
        if (layer == 0) {
            if (PH(4)) attn_phase(F, ws, true, (const bf16_t*)(ws + WS_QC), 256);
            xcd_barrier(bar);
        } else {
            if (PH(5)) {   SchedPlain S; S.o.init(T / 256, 4, F.G, (int)blockIdx.x); S.A = (const char*)(ws + WS_XS); S.B = (const char*)(ws + WS_WINP); S.a_tile = 256 * 2048; S.b_tile = 256 * 2048;
                EpiInP E{(const float*)(ws + WS_SSQX), (bf16_t*)(ws + WS_Z), qcscale};
                pg8::gemm_run<EpiInP, SchedPlain, false>(F.lds, listbuf, S, E, 16, 1 << 30, 2048u, 2048u); }
            xcd_barrier(bar);
            if (PH(6)) pool_diff_phase(F, ws);
            if (PH(7)) attn_phase(F, ws, false, (const bf16_t*)(ws + WS_Z) + 768, 1024);
            xcd_barrier(bar);
            if (PH(8)) {   SchedPool S; S.o.init(T / 256, 4, F.G, (int)blockIdx.x); S.A = (const char*)(ws + WS_DG); S.B = (const char*)(ws + WS_WPOOL);
                EpiPool E{args.in[11], (bf16_t*)(ws + WS_CONCAT)};
                pg8::gemm_run<EpiPool, SchedPool, false>(F.lds, listbuf, S, E, 4, 1 << 30, 512u, 512u); }
            xcd_barrier(bar);
        }
        if (PH(9)) {   SchedPlain S; S.o.init(T / 256, 4, F.G, (int)blockIdx.x); S.A = (const char*)(ws + WS_CONCAT); S.B = (const char*)(ws + WS_WO) + (size_t)layer * 2097152; S.a_tile = 256 * 2048; S.b_tile = 256 * 2048;
            EpiWo E{(bf16_t*)(ws + WS_XS)};
            pg8::gemm_run<EpiWo, SchedPlain, false>(F.lds, listbuf, S, E, 16, 1 << 30, 2048u, 2048u); }
        xcd_barrier(bar);
        if (PH(10)) router_phase(F, args, layer);
        xcd_barrier(bar);
        moe_table(F, layer);
        if (PH(11)) {   SchedMoe<false> S{(const LAS int*)(F.lds + L_TAB), F.G, F.vcu, (const char*)(ws + WS_XS), (const char*)(ws + WS_WGU) + (size_t)layer * (32u * 512u * 2048u), (const int*)(ws + WS_LIST)};
            EpiMoeUp E{(const float*)(ws + WS_TOKR), (const float*)(ws + WS_TOKW), (bf16_t*)(ws + WS_ACT)};
            pg8::gemm_run<EpiMoeUp, SchedMoe<false>, true>(F.lds, listbuf, S, E, 16, 1 << 30, 2048u, 2048u); }
        xcd_barrier(bar);
        if (PH(12)) {   SchedMoe<true> S{(const LAS int*)(F.lds + L_TAB), F.G, F.vcu, (const char*)(ws + WS_ACT), (const char*)(ws + WS_WD) + (size_t)layer * (4u * 1024u * 4096u), (const int*)(ws + WS_LIST)};
            EpiMoeDown E{(bf16_t*)(ws + WS_XS), (float*)(ws + WS_SSQX)};
            pg8::gemm_run<EpiMoeDown, SchedMoe<true>, false>(F.lds, listbuf, S, E, 8, 4, 1024u, 4096u); }
        xcd_barrier(bar);
    }
    if (PH(13)) final_phase(F, args);
}

extern "C" void kernel_launch(void* const* d_in, const int* in_sizes, int n_in, void* d_out, int out_size, void* d_ws, size_t ws_size, hipStream_t stream) {
    static int grid = 0;
    if (grid == 0) {
        if (n_in != 24 || in_sizes[0] != T * DM || out_size != T * DM || ws_size < WS_END) { fprintf(stderr, "kernel_launch: unexpected shapes (n_in %d, in0 %d, out %d, ws %zu); nothing launched\n", n_in, n_in > 0 ? in_sizes[0] : -1, out_size, ws_size); grid = -1; return; }
        int dev = 0, cus = 0, per_cu = 0;
        if (hipGetDevice(&dev) != hipSuccess || hipDeviceGetAttribute(&cus, hipDeviceAttributeMultiprocessorCount, dev) != hipSuccess) { grid = -1; return; }
        if (hipFuncSetAttribute((const void*)fwd_kernel, hipFuncAttributeMaxDynamicSharedMemorySize, LDS_BYTES) != hipSuccess) { fprintf(stderr, "kernel_launch: hipFuncSetAttribute failed\n"); grid = -1; return; }
        if (hipOccupancyMaxActiveBlocksPerMultiprocessor(&per_cu, (const void*)fwd_kernel, 512, LDS_BYTES) != hipSuccess || per_cu < 1) fprintf(stderr, "kernel_launch: occupancy query reports %d\n", per_cu);
        (void)hipGetLastError();
        grid = cus;
    }
    if (grid < 0) return;
    if (hipMemsetAsync((char*)d_ws + WS_CTL, 0, CTL_ZERO_BYTES, stream) != hipSuccess) return;
    Args a{};
    for (int i = 0; i < 24; ++i) a.in[i] = (const float*)d_in[i];
    a.out = (float*)d_out; a.ws = (unsigned char*)d_ws;
    hipLaunchKernelGGL(fwd_kernel, dim3(grid), dim3(512), LDS_BYTES, stream, a);
}
```

```cpp
#include <hip/hip_runtime.h>
#include <cstdio>
#include <cstdint>

#define LAS __attribute__((address_space(3)))
#define GAS __attribute__((address_space(1)))
typedef unsigned short bf16_t;
typedef short bf16x8 __attribute__((ext_vector_type(8)));
typedef short s16x4 __attribute__((ext_vector_type(4)));
typedef float f32x2 __attribute__((ext_vector_type(2)));
typedef float f32x4 __attribute__((ext_vector_type(4)));
typedef float f32x16 __attribute__((ext_vector_type(16)));
typedef unsigned u32x2 __attribute__((ext_vector_type(2)));
typedef unsigned u32x4 __attribute__((ext_vector_type(4)));
typedef __bf16 bf16x2_t __attribute__((ext_vector_type(2)));

constexpr int T = 65536, DM = 1024, SEQ = 2048, NB = 32, MEML = 256, TMEM = NB * MEML;
constexpr int NHEAD = 12, DQK = 96, DV = 64, QW = NHEAD * DQK  , KVW = NHEAD * DV  ;
constexpr float EPS = 1e-6f;
constexpr int NBUCKET = 112, CAP = 65536;
constexpr float LOG2E = 1.4426950408889634f;

constexpr size_t MiB = 1u << 20;
constexpr size_t WS_CTL = 0, CTL_ZERO_BYTES = 1 * MiB;
constexpr size_t WS_WINA = 1 * MiB;
constexpr size_t WS_WQKV = 3 * MiB;
constexpr size_t WS_WINP = 5 * MiB;
constexpr size_t WS_WPOOL = 7 * MiB;
constexpr size_t WS_WMEM = 8 * MiB;
constexpr size_t WS_WO = 9 * MiB;
constexpr size_t WS_WR = 13 * MiB;
constexpr size_t WS_WGU = 14 * MiB;
constexpr size_t WS_WD = 78 * MiB;
constexpr size_t WS_XS = 110 * MiB;
constexpr size_t WS_RSTD0 = 238 * MiB;
constexpr size_t WS_RSTDM = 238 * MiB + 512 * 1024;
constexpr size_t WS_CS = 239 * MiB, WS_SN = 243 * MiB;
constexpr size_t WS_MEMB = 247 * MiB;
constexpr size_t WS_MEMKV = 263 * MiB;
constexpr size_t WS_SSQQ = 271 * MiB, WS_SSQKV = 272 * MiB, WS_SSQX = 273 * MiB;
constexpr size_t WS_TOKW = 277 * MiB;
constexpr size_t WS_TOKR = 278 * MiB;
constexpr size_t WS_KROPE = 279 * MiB;
constexpr size_t WS_LIST = 283 * MiB;
constexpr size_t WS_QLAT = 311 * MiB, WS_QC = 343 * MiB, WS_KVLAT = 375 * MiB;
constexpr size_t WS_ACT = 311 * MiB;
constexpr size_t WS_Q = 407 * MiB, WS_KN = 551 * MiB, WS_V = 647 * MiB;
constexpr size_t WS_Z = 407 * MiB, WS_DG = 535 * MiB;
constexpr size_t WS_CONCAT = 743 * MiB;
constexpr size_t WS_END = 871 * MiB;
constexpr int CW_BAR = 4096, CW_CNT = 8192;

constexpr int RING_BYTES = 131072;
constexpr int L_MISC = RING_BYTES, L_LIST = RING_BYTES + 256, L_TAB = RING_BYTES + 256 + 2048, LDS_BYTES = RING_BYTES + 4096;

__device__ __forceinline__ unsigned pk2(float lo, float hi) { f32x2 v = {lo, hi}; bf16x2_t b = __builtin_convertvector(v, bf16x2_t); return __builtin_bit_cast(unsigned, b); }
__device__ __forceinline__ float bflo(unsigned w) { return __uint_as_float(w << 16); }
__device__ __forceinline__ float bfhi(unsigned w) { return __uint_as_float(w & 0xffff0000u); }
__device__ __forceinline__ u32x4 pack8(f32x4 a, f32x4 b) { u32x4 w; w.x = pk2(a[0], a[1]); w.y = pk2(a[2], a[3]); w.z = pk2(b[0], b[1]); w.w = pk2(b[2], b[3]); return w; }
__device__ __forceinline__ float wave_sum(float v) {
#pragma unroll
    for (int o = 1; o < 64; o <<= 1) v += __shfl_xor(v, o);
    return v;
}
#define LDS_WAIT() asm volatile("s_waitcnt lgkmcnt(0)" ::: "memory")
#define VM_WAIT() asm volatile("s_waitcnt vmcnt(0)" ::: "memory")

#define XB_TMO      128
#define XB_XCNT(j)  (256  + 64 * (j))
#define XB_XSUB(j)  (1280 + 64 * (j))
#define XB_XGEN(j)  (2304 + 64 * (j))
#define XB_TOP      3328
#define XB_TOPGEN   3392
#define XCD_BAR_WORDS 3456
#define XB_SPIN_CAP (1u << 18)
__device__ __forceinline__ unsigned xb_ld(unsigned* p)              { return __hip_atomic_load(p, __ATOMIC_RELAXED, __HIP_MEMORY_SCOPE_AGENT); }
__device__ __forceinline__ unsigned xb_add(unsigned* p, unsigned v) { return __hip_atomic_fetch_add(p, v, __ATOMIC_RELAXED, __HIP_MEMORY_SCOPE_AGENT); }
__device__ __forceinline__ unsigned xb_xcc_id() { return (unsigned)__builtin_amdgcn_s_getreg((3 << 11) | 20) & 0xFu; }
#define XB_SPIN(cond, bar) do { unsigned _sp = 0; while (cond) { __builtin_amdgcn_s_sleep(1); \
    if ((++_sp & 255u) == 0u) { if (xb_ld(&(bar)[XB_TMO])) break; if (_sp > XB_SPIN_CAP) { atomicAdd(&(bar)[XB_TMO], 1u); break; } } } } while (0)
struct XcdBarrier { unsigned* bar; unsigned x; volatile LAS unsigned* st; };
__device__ __forceinline__ XcdBarrier xcd_barrier_post(unsigned* bar, volatile LAS unsigned* st) {
    XcdBarrier b; b.bar = bar; b.x = xb_xcc_id(); b.st = st;
    if (threadIdx.x == 0) (void)xb_add(&bar[XB_XCNT(b.x)], 1u);
    return b;
}
__device__ __forceinline__ void xcd_barrier_complete(unsigned* bar, unsigned x, unsigned& nloc, unsigned& nx) {
    const unsigned G = gridDim.x * gridDim.y * gridDim.z;
    unsigned sum, cnt, mine, sp = 0u;
    for (;;) {
        sum = 0u; cnt = 0u; mine = 0u;
#pragma unroll
        for (unsigned j = 0; j < 16; ++j) { const unsigned c = xb_ld(&bar[XB_XCNT(j)]); sum += c; cnt += (c > 0u) ? 1u : 0u; mine = (j == x) ? c : mine; }
        if (sum == G) break;
        __builtin_amdgcn_s_sleep(1);
        if ((++sp & 255u) == 0u) { if (xb_ld(&bar[XB_TMO])) break; if (sp > XB_SPIN_CAP) { atomicAdd(&bar[XB_TMO], 1u); break; } }
    }
    nloc = mine > 0u ? mine : 1u; nx = cnt > 0u ? cnt : 1u;
}
__device__ __forceinline__ void xcd_barrier(const XcdBarrier& b) {
    asm volatile("s_waitcnt vmcnt(0)" ::: "memory");
    __syncthreads();
    if (threadIdx.x == 0) {
        unsigned zoff = 0u; asm volatile("" : "+s"(zoff));
        unsigned* bar = b.bar + zoff;
        __builtin_amdgcn_s_waitcnt(0);
        const unsigned bx = xb_xcc_id();
        unsigned nloc = b.st[0], nx = b.st[1];
        if (nloc == 0u) { xcd_barrier_complete(bar, bx, nloc, nx); b.st[0] = nloc; b.st[1] = nx; }
        const unsigned old = xb_add(&bar[XB_XSUB(bx)], 1u);
        const unsigned gen = old / nloc;
        if (old + 1u == (gen + 1u) * nloc) {
            __builtin_amdgcn_fence(__ATOMIC_RELEASE, "agent");
            asm volatile("s_waitcnt vmcnt(0)" ::: "memory");
            const unsigned og = xb_add(&bar[XB_TOP], 1u);
            const unsigned tg = og / nx;
            if (og + 1u == (tg + 1u) * nx) xb_add(&bar[XB_TOPGEN], 1u);
            else XB_SPIN(xb_ld(&bar[XB_TOPGEN]) == tg, bar);
            __builtin_amdgcn_fence(__ATOMIC_ACQUIRE, "agent");
            xb_add(&bar[XB_XGEN(bx)], 1u);
            asm volatile("s_waitcnt vmcnt(0)" ::: "memory");
        } else {
            XB_SPIN(xb_ld(&bar[XB_XGEN(bx)]) == gen, bar);
            __builtin_amdgcn_fence(__ATOMIC_ACQUIRE, "agent");
            asm volatile("s_waitcnt vmcnt(0)" ::: "memory");
        }
    }
    __syncthreads();
}

namespace pg8 {
constexpr int BM = 256, BK = 64, HALF = 128, HTB = HALF * BK * 2, NXCD = 8, WGM = 8;
__host__ __device__ __forceinline__ int lds_byte(int r, int c) { const int st = (r >> 4) * 2 + (c >> 5), rr = r & 15, cc = c & 31, ob = rr * 64 + cc * 2; return st * 1024 + (ob ^ (((ob >> 9) & 1) << 5)); }
__host__ __device__ __forceinline__ void stage_rc(int b, int& R, int& C) { const int st = b / 1024, sb = b % 1024, swz = sb ^ (((sb >> 9) & 1) << 5); R = (st >> 1) * 16 + swz / 64; C = (st & 1) * 32 + (swz % 64) / 2; }
__host__ __device__ __forceinline__ int perm32(int rho) { const int n = rho >> 4, i = rho & 15; return 8 * (i >> 2) + 4 * n + (i & 3); }

struct Unit { const char* A; const char* B; int bjump; int nvalid; const int* list; int pm, pn, aux; };

struct TileOrder {
    int nM, nN, nwg, G, c;
    __device__ __forceinline__ void init(int nM_, int nN_, int G_, int c_) { nM = nM_; nN = nN_; nwg = nM * nN; G = G_; c = c_; }
    __device__ __forceinline__ bool get(int i, int& pm, int& pn) const {
        const long L = (long)i * G + c; if (L >= nwg) return false;
        int wgid = (int)L; { const int q = nwg / NXCD, r = nwg % NXCD, xcd = wgid % NXCD, off = wgid / NXCD; wgid = (xcd < r ? xcd * (q + 1) : r * (q + 1) + (xcd - r) * q) + off; }
        const int nig = WGM * nN, gid = wgid / nig, fm = gid * WGM, gsz = (nM - fm) < WGM ? (nM - fm) : WGM;
        pm = fm + ((wgid % nig) % gsz); pn = (wgid % nig) / gsz; return true;
    }
};

template <class Epi, class Sched, bool GATHER>
__device__ __forceinline__ void gemm_run(LAS unsigned char* lds, LAS unsigned char* listbuf, const Sched& S, const Epi& E, const int nt, const int jt, const unsigned lda2, const unsigned ldb2) {
    int tid = threadIdx.x; asm volatile("" : "+v"(tid));
    const int wid = __builtin_amdgcn_readfirstlane(tid >> 6), lane = tid & 63, wr = wid >> 2, wc = wid & 3, fr = lane & 15, fq = lane >> 4;
    int Rr[2]; unsigned Cc[2], voffB[2];
#pragma unroll
    for (int i = 0; i < 2; ++i) { int R, C; stage_rc(tid * 16 + i * 8192, R, C); const int Rb = (R & ~31) + perm32(R & 31); Rr[i] = R; Cc[i] = (unsigned)C * 2u; voffB[i] = (unsigned)Rb * ldb2 + (unsigned)C * 2u; }
    const size_t kstep = (size_t)(BK * 2);
    const size_t hstepB = (size_t)HALF * ldb2;
    const size_t hstepA = GATHER ? (size_t)0 : (size_t)HALF * lda2;
    const unsigned ldsw = (unsigned)wid * 1024u;
    const int aoff = lds_byte(wr * 64 + fr, fq * 8), boff = lds_byte(wc * 32 + fr, fq * 8);
#define PG8_SA(b, h) (((b) * 2 + (h)) * HTB)
#define PG8_SB(b, h) ((4 + (b) * 2 + (h)) * HTB)
#define PG8_STAGE(bufoff, gbase, voff) do { _Pragma("unroll") for (int _i = 0; _i < 2; ++_i) \
        __builtin_amdgcn_global_load_lds((const unsigned*)((const char*)(gbase) + (voff)[_i]), (LAS unsigned*)(lds + (bufoff) + ldsw + _i * 8192), 16, 0, 0); } while (0)
#define PG8_LDA(dst, b, h) do { _Pragma("unroll") for (int m = 0; m < 4; ++m) _Pragma("unroll") for (int k = 0; k < 2; ++k) dst[m][k] = *(const LAS bf16x8*)(lds + PG8_SA(b, h) + aoff + m * 2048 + k * 1024); } while (0)
#define PG8_LDB(dst, b, h) do { _Pragma("unroll") for (int n = 0; n < 2; ++n) _Pragma("unroll") for (int k = 0; k < 2; ++k) dst[n][k] = *(const LAS bf16x8*)(lds + PG8_SB(b, h) + boff + n * 2048 + k * 1024); } while (0)
#define PG8_MMA(ai, bj, At, Bt) do { __builtin_amdgcn_s_setprio(1); _Pragma("unroll") for (int m = 0; m < 4; ++m) _Pragma("unroll") for (int n = 0; n < 2; ++n) _Pragma("unroll") for (int k = 0; k < 2; ++k) \
        acc[ai][bj][m][n] = __builtin_amdgcn_mfma_f32_16x16x32_bf16(Bt[n][k], At[m][k], acc[ai][bj][m][n], 0, 0, 0); __builtin_amdgcn_s_setprio(0); } while (0)
#define PG8_WAIT_V(n) asm volatile("s_waitcnt vmcnt(" #n ")" ::: "memory")
#define PG8_WAIT_L(n) asm volatile("s_waitcnt lgkmcnt(" #n ")" ::: "memory")
#define PG8_BAR __builtin_amdgcn_s_barrier()
#define PG8_SCHED __builtin_amdgcn_sched_barrier(0)
#define PG8_BPTR(X, tt) ((X).B + (size_t)(tt) * kstep + (((tt) >= jt) ? (X).bjump : 0))
    Unit cur, nxt; int ui = 0;
    if (!S.next(0, cur)) return;
    unsigned offA[2][2];
#pragma unroll
    for (int h = 0; h < 2; ++h)
#pragma unroll
        for (int i = 0; i < 2; ++i) {
            const int row = h * HALF + Rr[i];
            if constexpr (GATHER) { int idx = cur.list[row]; if (row >= cur.nvalid) idx = 0; offA[h][i] = (unsigned)idx * lda2 + Cc[i]; }
            else offA[h][i] = (unsigned)Rr[i] * lda2 + Cc[i];
        }
    f32x4 acc[2][2][4][2];
#pragma unroll
    for (int a = 0; a < 2; ++a)
#pragma unroll
        for (int b = 0; b < 2; ++b)
#pragma unroll
            for (int m = 0; m < 4; ++m)
#pragma unroll
                for (int n = 0; n < 2; ++n) acc[a][b][m][n] = (f32x4){0.f, 0.f, 0.f, 0.f};
    bf16x8 At[4][2], B0[2][2], B1[2][2];
    {
        const char* cA = cur.A; const char* cB = cur.B;
        PG8_STAGE(PG8_SB(0, 0), cB, voffB); PG8_STAGE(PG8_SB(0, 1), cB + hstepB, voffB); PG8_STAGE(PG8_SA(0, 0), cA, offA[0]); PG8_STAGE(PG8_SA(0, 1), cA + hstepA, offA[1]);
        if (wr == 1) PG8_BAR;
        PG8_WAIT_V(2); PG8_BAR;
        const char* cB1 = PG8_BPTR(cur, 1);
        PG8_STAGE(PG8_SB(1, 0), cB1, voffB); PG8_STAGE(PG8_SA(1, 0), cA + kstep, offA[0]); PG8_STAGE(PG8_SB(1, 1), cB1 + hstepB, voffB);
        PG8_WAIT_V(6); PG8_BAR;
    }
    for (;;) {
        const bool has_next = S.next(ui + 1, nxt);
        if constexpr (GATHER) {
            if (has_next) __builtin_amdgcn_global_load_lds((const unsigned*)((const char*)nxt.list + lane * 16), (LAS unsigned*)(listbuf + ((ui + 1) & 1) * 1024), 16, 0, 0);
        }
        const char* cA = cur.A;
        const char* nA = has_next ? nxt.A : cur.A;
        const char* nB0 = has_next ? nxt.B : cur.B;
        const char* nB1 = has_next ? PG8_BPTR(nxt, 1) : PG8_BPTR(cur, 1);
#pragma unroll 1
        for (int t = 0; t < nt; t += 2) {
            const bool last = (t == nt - 2);
            const char* a1 = cA + (size_t)(t + 1) * kstep;
            const char* a2 = last ? nA : cA + (size_t)(t + 2) * kstep; const char* b2 = last ? nB0 : PG8_BPTR(cur, t + 2);
            const char* a3 = a2 + kstep;                              const char* b3 = last ? nB1 : PG8_BPTR(cur, t + 3);
            PG8_LDB(B0, 0, 0); PG8_LDB(B1, 0, 1); PG8_SCHED; PG8_LDA(At, 0, 0); PG8_STAGE(PG8_SA(1, 1), a1 + hstepA, offA[1]);
            if constexpr (GATHER) {
                if (last && has_next) {
                    const LAS int* lb = (const LAS int*)(listbuf + ((ui + 1) & 1) * 1024);
#pragma unroll
                    for (int h = 0; h < 2; ++h)
#pragma unroll
                        for (int i = 0; i < 2; ++i) { const int row = h * HALF + Rr[i]; int idx = lb[row]; if (row >= nxt.nvalid) idx = 0; offA[h][i] = (unsigned)idx * lda2 + Cc[i]; }
                }
            }
            PG8_WAIT_V(8); PG8_WAIT_L(0); PG8_BAR; PG8_MMA(0, 0, At, B0); PG8_MMA(0, 1, At, B1); PG8_BAR; PG8_SCHED;
            PG8_LDA(At, 0, 1); PG8_STAGE(PG8_SB(0, 0), b2, voffB); PG8_STAGE(PG8_SB(0, 1), b2 + hstepB, voffB); PG8_STAGE(PG8_SA(0, 0), a2, offA[0]);
            PG8_WAIT_V(8); PG8_WAIT_L(0); PG8_BAR; PG8_MMA(1, 0, At, B0); PG8_MMA(1, 1, At, B1); PG8_BAR; PG8_SCHED;
            PG8_LDB(B0, 1, 0); PG8_LDB(B1, 1, 1); PG8_SCHED; PG8_LDA(At, 1, 0); PG8_STAGE(PG8_SA(0, 1), a2 + hstepA, offA[1]);
            PG8_WAIT_V(8); PG8_WAIT_L(0); PG8_BAR; PG8_MMA(0, 0, At, B0); PG8_MMA(0, 1, At, B1); PG8_BAR; PG8_SCHED;
            PG8_LDA(At, 1, 1); PG8_STAGE(PG8_SB(1, 0), b3, voffB); PG8_STAGE(PG8_SB(1, 1), b3 + hstepB, voffB); PG8_STAGE(PG8_SA(1, 0), a3, offA[0]);
            PG8_WAIT_V(8); PG8_WAIT_L(0); PG8_BAR; PG8_MMA(1, 0, At, B0); PG8_MMA(1, 1, At, B1); PG8_BAR; PG8_SCHED;
        }
        if (wr == 0) PG8_BAR;
        E(acc, cur, wr, wc, fr, fq);
        if (!has_next) break;
#pragma unroll
        for (int a = 0; a < 2; ++a)
#pragma unroll
            for (int b = 0; b < 2; ++b)
#pragma unroll
                for (int m = 0; m < 4; ++m)
#pragma unroll
                    for (int n = 0; n < 2; ++n) acc[a][b][m][n] = (f32x4){0.f, 0.f, 0.f, 0.f};
        cur = nxt; ++ui;
        if (wr == 1) PG8_BAR;
    }
    PG8_WAIT_V(0);
    PG8_BAR;
#undef PG8_SA
#undef PG8_SB
#undef PG8_STAGE
#undef PG8_LDA
#undef PG8_LDB
#undef PG8_MMA
#undef PG8_WAIT_V
#undef PG8_WAIT_L
#undef PG8_BAR
#undef PG8_SCHED
#undef PG8_BPTR
}
}
using pg8::Unit;

struct SchedPlain {
    pg8::TileOrder o; const char* A; const char* B; size_t a_tile, b_tile;
    __device__ __forceinline__ bool next(int i, Unit& u) const { int pm, pn; if (!o.get(i, pm, pn)) return false;
        u.A = A + (size_t)pm * a_tile; u.B = B + (size_t)pn * b_tile; u.bjump = 0; u.nvalid = 256; u.list = nullptr; u.pm = pm; u.pn = pn; u.aux = 0; return true; }
};
struct SchedQKV {
    pg8::TileOrder o; const char* Aq; const char* Akv; const char* B;
    __device__ __forceinline__ bool next(int i, Unit& u) const { int pm, pn; if (!o.get(i, pm, pn)) return false;
        u.A = (pn < 5 ? Aq : Akv) + (size_t)pm * (256 * 512); u.B = B + (size_t)pn * (256 * 512); u.bjump = 0; u.nvalid = 256; u.list = nullptr; u.pm = pm; u.pn = pn; u.aux = 0; return true; }
};
struct SchedPool {
    pg8::TileOrder o; const char* A; const char* B;
    __device__ __forceinline__ bool next(int i, Unit& u) const { int pm, pn; if (!o.get(i, pm, pn)) return false;
        u.A = A + ((size_t)pn * T + (size_t)pm * 256) * 512; u.B = B + (size_t)pn * (256 * 512); u.bjump = 0; u.nvalid = 256; u.list = nullptr; u.pm = pm; u.pn = pn; u.aux = 0; return true; }
};
__device__ __forceinline__ void pair_decode(int p, int& lo, int& hi) { int l = 0, rem = p; while (rem >= 7 - l) { rem -= 7 - l; ++l; } lo = l; hi = l + 1 + rem; }
template <bool DOWN> struct SchedMoe {
    const LAS int* tab; int G, c; const char* A; const char* W; const int* list;
    __device__ __forceinline__ bool next(int i, Unit& u) const {
        const int ntile = tab[NBUCKET]; const long L = (long)i * G + c; if (L >= (long)ntile * 4) return false;
        const int tile = (int)(L >> 2), pn = (int)(L & 3);
        int lo_ = 0, hi_ = NBUCKET - 1;
        while (lo_ < hi_) { const int mid = (lo_ + hi_ + 1) >> 1; if (tab[mid] <= tile) lo_ = mid; else hi_ = mid - 1; }
        const int b = __builtin_amdgcn_readfirstlane(lo_);
        const int tib = tile - __builtin_amdgcn_readfirstlane(tab[b]), cnt = __builtin_amdgcn_readfirstlane(tab[128 + b]);
        int elo, ehi; pair_decode(b % 28, elo, ehi); const int g = b / 28;
        u.nvalid = min(256, cnt - tib * 256); u.list = list + (size_t)b * CAP + tib * 256; u.pm = tile; u.pn = pn; u.aux = tile * 256;
        if (!DOWN) { u.A = A; u.B = W + ((size_t)(g * 8 + (pn < 2 ? elo : ehi)) * 512 + (pn & 1) * 256) * 2048; u.bjump = 0; }
        else { u.A = A + (size_t)tile * (256 * 1024); u.B = W + (size_t)g * (1024 * 4096) + (size_t)pn * (256 * 4096) + elo * 512; u.bjump = (ehi - elo - 1) * 512; }
        return true;
    }
};

#define EPI_ROWS(ai, m) (128 * (ai) + 64 * wr + 16 * (m) + fr)
#define EPI_COL(bj) (128 * (bj) + 32 * wc + 8 * fq)
#define EPI_FENCE asm volatile("" ::: "memory")
typedef f32x4 acc_t[2][2][4][2];

struct EpiRowScale {
    bf16_t* O; int ldc; const float* rs;
    __device__ __forceinline__ void operator()(const acc_t& acc, const Unit& u, int wr, int wc, int fr, int fq) const {
        float sv[2][4];
#pragma unroll
        for (int ai = 0; ai < 2; ++ai)
#pragma unroll
            for (int m = 0; m < 4; ++m) sv[ai][m] = rs[u.pm * 256 + EPI_ROWS(ai, m)];
        EPI_FENCE;
#pragma unroll
        for (int ai = 0; ai < 2; ++ai)
#pragma unroll
            for (int m = 0; m < 4; ++m) { const int r = u.pm * 256 + EPI_ROWS(ai, m); const float s = sv[ai][m];
#pragma unroll
                for (int bj = 0; bj < 2; ++bj) *(u32x4*)(O + (size_t)r * ldc + u.pn * 256 + EPI_COL(bj)) = pack8(acc[ai][bj][m][0] * s, acc[ai][bj][m][1] * s); }
    }
};
__device__ __forceinline__ void rope8(f32x4& v0, f32x4& v1, f32x4 c0, f32x4 c1, f32x4 s0, f32x4 s1, int fq) {
    f32x4 p0, p1;
#pragma unroll
    for (int j = 0; j < 4; ++j) { p0[j] = __shfl_xor(v0[j], 32); p1[j] = __shfl_xor(v1[j], 32); }
    const float sg = (fq < 2) ? -1.f : 1.f;
    v0 = v0 * c0 + (p0 * s0) * sg; v1 = v1 * c1 + (p1 * s1) * sg;
}
struct EpiInA {
    const float* rstd0; bf16_t* qlat; bf16_t* qc; bf16_t* kvlat; bf16_t* krope; float* ssqq; float* ssqkv; const float* cs; const float* sn; float qcscale;
    __device__ __forceinline__ void operator()(const acc_t& acc, const Unit& u, int wr, int wc, int fr, int fq) const {
        float sv[2][4];
#pragma unroll
        for (int ai = 0; ai < 2; ++ai)
#pragma unroll
            for (int m = 0; m < 4; ++m) sv[ai][m] = rstd0[u.pm * 256 + EPI_ROWS(ai, m)];
        EPI_FENCE;
        const bool roper = (u.pn == 2) && (wc == 0);
#pragma unroll
        for (int ai = 0; ai < 2; ++ai)
#pragma unroll
          for (int mh = 0; mh < 2; ++mh) {
            f32x4 tc[2][4];
            if (roper) {
#pragma unroll
                for (int mm = 0; mm < 2; ++mm) { const size_t o = (size_t)(u.pm * 256 + EPI_ROWS(ai, 2 * mh + mm)) * 16 + 8 * (fq & 1);
                    tc[mm][0] = *(const f32x4*)(cs + o); tc[mm][1] = *(const f32x4*)(cs + o + 4); tc[mm][2] = *(const f32x4*)(sn + o); tc[mm][3] = *(const f32x4*)(sn + o + 4); }
            }
            EPI_FENCE;
#pragma unroll
            for (int mm = 0; mm < 2; ++mm) { const int m = 2 * mh + mm; const int r = u.pm * 256 + EPI_ROWS(ai, m); const float s = sv[ai][m];
                f32x4 v[2][2];
#pragma unroll
                for (int bj = 0; bj < 2; ++bj) { v[bj][0] = acc[ai][bj][m][0] * s; v[bj][1] = acc[ai][bj][m][1] * s; }
                if (u.pn == 0) {
                    float ss = 0.f;
#pragma unroll
                    for (int bj = 0; bj < 2; ++bj) { *(u32x4*)(qlat + (size_t)r * 256 + EPI_COL(bj)) = pack8(v[bj][0], v[bj][1]);
#pragma unroll
                        for (int n = 0; n < 2; ++n) ss += (v[bj][n][0] * v[bj][n][0] + v[bj][n][1] * v[bj][n][1]) + (v[bj][n][2] * v[bj][n][2] + v[bj][n][3] * v[bj][n][3]); }
                    ss += __shfl_xor(ss, 16); ss += __shfl_xor(ss, 32);
                    if (fq == 0) ssqq[(size_t)r * 4 + wc] = ss;
                } else if (u.pn == 1) {
#pragma unroll
                    for (int bj = 0; bj < 2; ++bj) *(u32x4*)(qc + (size_t)r * 256 + EPI_COL(bj)) = pack8(v[bj][0] * qcscale, v[bj][1] * qcscale);
                } else {
                    float ss = 0.f;
#pragma unroll
                    for (int n = 0; n < 2; ++n) ss += (v[0][n][0] * v[0][n][0] + v[0][n][1] * v[0][n][1]) + (v[0][n][2] * v[0][n][2] + v[0][n][3] * v[0][n][3]);
                    ss += __shfl_xor(ss, 16); ss += __shfl_xor(ss, 32);
                    if (fq == 0) ssqkv[(size_t)r * 4 + wc] = ss;
                    *(u32x4*)(kvlat + (size_t)r * 256 + EPI_COL(0)) = pack8(v[0][0], v[0][1]);
                    *(u32x4*)(kvlat + (size_t)r * 256 + EPI_COL(1)) = (u32x4){0u, 0u, 0u, 0u};
                    if (wc == 0) { f32x4 a = v[1][0], b = v[1][1]; rope8(a, b, tc[mm][0], tc[mm][1], tc[mm][2], tc[mm][3], fq); *(u32x4*)(krope + (size_t)r * 32 + 8 * fq) = pack8(a, b); }
                }
            }
          }
    }
};
struct EpiQKV {
    const float* ssqq; const float* ssqkv; bf16_t* Q; bf16_t* KN; bf16_t* V; const float* cs; const float* sn; float qscale;
    __device__ __forceinline__ void operator()(const acc_t& acc, const Unit& u, int wr, int wc, int fr, int fq) const {
        const bool isq = u.pn < 5;
        const int g32a = isq ? u.pn * 8 + wc : (u.pn - 5) * 8 + wc, g32b = g32a + 4;
        const bool ropea = isq && (g32a % 3 == 2) && g32a < 36, ropeb = isq && (g32b % 3 == 2) && g32b < 36;
#pragma unroll
        for (int ai = 0; ai < 2; ++ai)
#pragma unroll
          for (int mh = 0; mh < 2; ++mh) {
            f32x4 p4[2], tc[2][4];
#pragma unroll
            for (int mm = 0; mm < 2; ++mm) { const int r = u.pm * 256 + EPI_ROWS(ai, 2 * mh + mm); p4[mm] = *(const f32x4*)((isq ? ssqq : ssqkv) + (size_t)r * 4); }
            if (ropea || ropeb) {
#pragma unroll
                for (int mm = 0; mm < 2; ++mm) { const size_t o = (size_t)(u.pm * 256 + EPI_ROWS(ai, 2 * mh + mm)) * 16 + 8 * (fq & 1);
                    tc[mm][0] = *(const f32x4*)(cs + o); tc[mm][1] = *(const f32x4*)(cs + o + 4); tc[mm][2] = *(const f32x4*)(sn + o); tc[mm][3] = *(const f32x4*)(sn + o + 4); }
            }
            EPI_FENCE;
#pragma unroll
            for (int mm = 0; mm < 2; ++mm) { const int m = 2 * mh + mm; const int r = u.pm * 256 + EPI_ROWS(ai, m);
                const float rs = __builtin_amdgcn_rsqf(((p4[mm][0] + p4[mm][1]) + (p4[mm][2] + p4[mm][3])) * (isq ? (1.f / 256.f) : (1.f / 128.f)) + EPS);
#pragma unroll
                for (int bj = 0; bj < 2; ++bj) {
                    f32x4 v0 = acc[ai][bj][m][0] * rs, v1 = acc[ai][bj][m][1] * rs;
                    const int g32 = bj ? g32b : g32a;
                    if (isq) {
                        if (g32 < 36) { if (bj ? ropeb : ropea) rope8(v0, v1, tc[mm][0], tc[mm][1], tc[mm][2], tc[mm][3], fq);
                            *(u32x4*)(Q + (size_t)r * QW + g32 * 32 + 8 * fq) = pack8(v0 * qscale, v1 * qscale); }
                    } else { const int h = g32 >> 2, part = g32 & 3;
                        bf16_t* dst = (part < 2 ? KN : V) + (size_t)r * KVW + h * 64 + (part & 1) * 32 + 8 * fq;
                        *(u32x4*)dst = pack8(v0, v1); }
                }
            }
          }
    }
};
struct EpiWo {
    bf16_t* XS;
    __device__ __forceinline__ void operator()(const acc_t& acc, const Unit& u, int wr, int wc, int fr, int fq) const {
        u32x4 w[2][4][2];
#pragma unroll
        for (int ai = 0; ai < 2; ++ai)
#pragma unroll
            for (int m = 0; m < 4; ++m)
#pragma unroll
                for (int bj = 0; bj < 2; ++bj) w[ai][m][bj] = *(const u32x4*)(XS + (size_t)(u.pm * 256 + EPI_ROWS(ai, m)) * DM + u.pn * 256 + EPI_COL(bj));
        EPI_FENCE;
#pragma unroll
        for (int ai = 0; ai < 2; ++ai)
#pragma unroll
            for (int m = 0; m < 4; ++m)
#pragma unroll
                for (int bj = 0; bj < 2; ++bj) { const u32x4 x = w[ai][m][bj]; const size_t off = (size_t)(u.pm * 256 + EPI_ROWS(ai, m)) * DM + u.pn * 256 + EPI_COL(bj);
                    const f32x4 a = (f32x4){bflo(x.x), bfhi(x.x), bflo(x.y), bfhi(x.y)}, b = (f32x4){bflo(x.z), bfhi(x.z), bflo(x.w), bfhi(x.w)};
                    *(u32x4*)(XS + off) = pack8(acc[ai][bj][m][0] + a, acc[ai][bj][m][1] + b); }
    }
};
struct EpiMoeUp {
    const float* tokr; const float* tokw; bf16_t* ACT;
    __device__ __forceinline__ void operator()(const acc_t& acc, const Unit& u, int wr, int wc, int fr, int fq) const {
        int tok[2][4]; float rsv[2][4], wv[2][4];
#pragma unroll
        for (int ai = 0; ai < 2; ++ai)
#pragma unroll
            for (int m = 0; m < 4; ++m) { const int lr = EPI_ROWS(ai, m); tok[ai][m] = u.list[lr < u.nvalid ? lr : 0]; }
        EPI_FENCE;
#pragma unroll
        for (int ai = 0; ai < 2; ++ai)
#pragma unroll
            for (int m = 0; m < 4; ++m) { rsv[ai][m] = tokr[tok[ai][m]]; wv[ai][m] = tokw[(size_t)tok[ai][m] * 2 + (u.pn >> 1)]; }
        EPI_FENCE;
#pragma unroll
        for (int ai = 0; ai < 2; ++ai)
#pragma unroll
            for (int m = 0; m < 4; ++m) { const int lr = EPI_ROWS(ai, m); const float rs = rsv[ai][m], w = wv[ai][m];
#pragma unroll
                for (int bj = 0; bj < 2; ++bj) { const f32x4 g = acc[ai][bj][m][0] * rs, up = acc[ai][bj][m][1] * rs; f32x4 a;
#pragma unroll
                    for (int j = 0; j < 4; ++j) a[j] = g[j] * __builtin_amdgcn_rcpf(1.0f + __builtin_amdgcn_exp2f(-g[j] * LOG2E)) * up[j] * w;
                    u32x2 o; o.x = pk2(a[0], a[1]); o.y = pk2(a[2], a[3]);
                    *(u32x2*)(ACT + (size_t)(u.aux + lr) * 512 + (u.pn >> 1) * 256 + (u.pn & 1) * 128 + bj * 64 + 16 * wc + 4 * fq) = o; }
            }
    }
};
struct EpiMoeDown {
    bf16_t* XS; float* ssq;
    __device__ __forceinline__ void operator()(const acc_t& acc, const Unit& u, int wr, int wc, int fr, int fq) const {
        int tok[2][4];
#pragma unroll
        for (int ai = 0; ai < 2; ++ai)
#pragma unroll
            for (int m = 0; m < 4; ++m) { const int lr = EPI_ROWS(ai, m); tok[ai][m] = u.list[lr < u.nvalid ? lr : 0]; }
        EPI_FENCE;
#pragma unroll
        for (int ai = 0; ai < 2; ++ai) {
            u32x4 w[4][2];
#pragma unroll
            for (int m = 0; m < 4; ++m)
#pragma unroll
                for (int bj = 0; bj < 2; ++bj) w[m][bj] = *(const u32x4*)(XS + (size_t)tok[ai][m] * DM + u.pn * 256 + EPI_COL(bj));
            EPI_FENCE;
#pragma unroll
            for (int m = 0; m < 4; ++m) { const int lr = EPI_ROWS(ai, m); const bool ok = lr < u.nvalid; float ss = 0.f;
#pragma unroll
                for (int bj = 0; bj < 2; ++bj) { const size_t off = (size_t)tok[ai][m] * DM + u.pn * 256 + EPI_COL(bj); const u32x4 x = w[m][bj];
                    const f32x4 a = acc[ai][bj][m][0] + (f32x4){bflo(x.x), bfhi(x.x), bflo(x.y), bfhi(x.y)}, b = acc[ai][bj][m][1] + (f32x4){bflo(x.z), bfhi(x.z), bflo(x.w), bfhi(x.w)};
                    ss += (a[0] * a[0] + a[1] * a[1]) + (a[2] * a[2] + a[3] * a[3]) + (b[0] * b[0] + b[1] * b[1]) + (b[2] * b[2] + b[3] * b[3]);
                    if (ok) *(u32x4*)(XS + off) = pack8(a, b); }
                ss += __shfl_xor(ss, 16); ss += __shfl_xor(ss, 32);
                if (ok && fq == 0) ssq[(size_t)tok[ai][m] * 16 + u.pn * 4 + wc] = ss;
            }
        }
    }
};
struct EpiInP {
    const float* ssq; bf16_t* Z; float qcscale;
    __device__ __forceinline__ void operator()(const acc_t& acc, const Unit& u, int wr, int wc, int fr, int fq) const {
        const float cscale = (u.pn == 3) ? qcscale : 1.0f;
#pragma unroll
        for (int ai = 0; ai < 2; ++ai) {
            f32x4 p[4][4];
#pragma unroll
            for (int m = 0; m < 4; ++m) { const f32x4* pp = (const f32x4*)(ssq + (size_t)(u.pm * 256 + EPI_ROWS(ai, m)) * 16);
#pragma unroll
                for (int q = 0; q < 4; ++q) p[m][q] = pp[q]; }
            EPI_FENCE;
#pragma unroll
            for (int m = 0; m < 4; ++m) { const int r = u.pm * 256 + EPI_ROWS(ai, m);
                const f32x4 s4 = (p[m][0] + p[m][1]) + (p[m][2] + p[m][3]); const float rs = cscale * __builtin_amdgcn_rsqf(((s4[0] + s4[1]) + (s4[2] + s4[3])) * (1.f / 1024.f) + EPS);
#pragma unroll
                for (int bj = 0; bj < 2; ++bj) *(u32x4*)(Z + (size_t)r * DM + u.pn * 256 + EPI_COL(bj)) = pack8(acc[ai][bj][m][0] * rs, acc[ai][bj][m][1] * rs); }
        }
    }
};
struct EpiPool {
    const float* scale; bf16_t* CC;
    __device__ __forceinline__ void operator()(const acc_t& acc, const Unit& u, int wr, int wc, int fr, int fq) const {
#pragma unroll
        for (int bj = 0; bj < 2; ++bj) { const int cl = EPI_COL(bj); if (cl < 192) { const int col = u.pn * 192 + cl;
            const f32x4 s0 = *(const f32x4*)(scale + col), s1 = *(const f32x4*)(scale + col + 4);
#pragma unroll
            for (int ai = 0; ai < 2; ++ai)
#pragma unroll
                for (int m = 0; m < 4; ++m) { const int r = u.pm * 256 + EPI_ROWS(ai, m); *(u32x4*)(CC + (size_t)r * DM + col) = pack8(acc[ai][bj][m][0] * s0, acc[ai][bj][m][1] * s1); } } }
    }
};

namespace att {
__device__ __forceinline__ int crow(int r, int hi) { return (r & 3) + 8 * (r >> 2) + 4 * hi; }
__device__ __forceinline__ void glds16(const void* gsrc, unsigned lds_dst) { unsigned keep;
    asm volatile("s_mov_b32 %0, m0\n\ts_mov_b32 m0, %2\n\ts_nop 0\n\tglobal_load_lds_dwordx4 %1, off\n\ts_mov_b32 m0, %0" : "=&s"(keep) : "v"(gsrc), "s"(lds_dst) : "memory"); }
template <int DQ, bool CAUSAL>
__device__ __forceinline__ void attn_unit(LAS unsigned char* L, const bf16_t* Qw, int ldq, const bf16_t* Kn, int ldk, const bf16_t* Kr, int ldkr,
                                          const bf16_t* Vp, int ldv, bf16_t* Ow, int ldo, const int NT, const int wid, const int lane_in) {
    constexpr int ND = DQ / 16, NCH = DQ / 8, KSL = NCH * 1024, LV = 4 * KSL, LWS = LV + 3 * 8192, LOST = LWS + 2048;
    int lane = lane_in; asm volatile("" : "+v"(lane));
    constexpr float THR = 8.0f;
    const int r32 = lane & 31, hi = lane >> 5;
    LAS float* wsf = (LAS float*)(L + LWS) + wid * 64;
    const unsigned lds0 = (unsigned)(uintptr_t)L;
#define ATT_DMA_K(t, slot) do { \
        glds16(Kn + (size_t)((t) * 64 + lane) * ldk + wid * 8, (unsigned)__builtin_amdgcn_readfirstlane(lds0 + (slot) * KSL + wid * 1024)); \
        if (NCH > 8 && wid < NCH - 8) glds16(Kr + (size_t)((t) * 64 + lane) * ldkr + wid * 8, (unsigned)__builtin_amdgcn_readfirstlane(lds0 + (slot) * KSL + (8 + wid) * 1024)); } while (0)
#define ATT_DMA_V(t, slot) glds16(Vp + (size_t)((t) * 64 + 16 * (wid & 3) + (lane >> 2)) * ldv + (wid >> 2) * 32 + (lane & 3) * 8, (unsigned)__builtin_amdgcn_readfirstlane(lds0 + LV + (slot) * 8192 + wid * 1024))
#define ATT_SYNC() do { asm volatile("s_waitcnt vmcnt(0) lgkmcnt(0)" ::: "memory"); __builtin_amdgcn_s_barrier(); asm volatile("" ::: "memory"); } while (0)
#define ATT_QK(S0, S1, kslot) do { const LAS unsigned char* kb_ = L + (kslot) * KSL + hi * 1024 + r32 * 16; S0 = f32x16{}; S1 = f32x16{}; \
        _Pragma("unroll") for (int d0 = 0; d0 < ND; ++d0) { const bf16x8 b0_ = *(const LAS bf16x8*)(kb_ + d0 * 2048), b1_ = *(const LAS bf16x8*)(kb_ + d0 * 2048 + 512); \
            S0 = __builtin_amdgcn_mfma_f32_32x32x16_bf16(b0_, qr[d0], S0, 0, 0, 0); S1 = __builtin_amdgcn_mfma_f32_32x32x16_bf16(b1_, qr[d0], S1, 0, 0, 0); } } while (0)
    ATT_DMA_K(0, 0); ATT_DMA_V(0, 0); ATT_DMA_K(1, 1); ATT_DMA_V(1, 1); ATT_DMA_K(2, 2);
    bf16x8 qr[ND];
#pragma unroll
    for (int d0 = 0; d0 < ND; ++d0) qr[d0] = *(const bf16x8*)(Qw + (size_t)(wid * 32 + r32) * ldq + d0 * 16 + hi * 8);
    f32x16 o0 = {}, o1 = {};
    float mrun = -1e30f, lrun = 0.f;
    const int vb0 = ((lane >> 4) & 1) * 32 + (lane & 3) * 8 + (4 * hi + ((lane & 15) >> 2)) * 64;
    const int qrel = wid * 32 + r32;
    ATT_SYNC();
    f32x16 sA0, sA1, sB0, sB1;
    ATT_QK(sA0, sA1, 0);
    int ks_next = 1, vs_cur = 0;
    const int kcnt = (NCH > 8 && wid < NCH - 8) ? 2 : 1;
#define ATT_STEP(C0, C1, N0, N1, t) do { \
        if ((t) < NTw) { \
              \
            bf16x8 kf_[2 * ND]; \
            { const LAS unsigned char* kb_ = L + ks_next * KSL + hi * 1024 + r32 * 16; \
              _Pragma("unroll") for (int d0 = 0; d0 < ND; ++d0) { kf_[2 * d0] = *(const LAS bf16x8*)(kb_ + d0 * 2048); kf_[2 * d0 + 1] = *(const LAS bf16x8*)(kb_ + d0 * 2048 + 512); } } \
            const int jb_ = (t) - (NT - 4); \
            if (CAUSAL && jb_ >= 0) { const int kbase_ = 64 * jb_ + 4 * hi; \
                _Pragma("unroll") for (int r = 0; r < 16; ++r) { const int kv_ = kbase_ + (r & 3) + 8 * (r >> 2); if (kv_ > qrel) C0[r] = -INFINITY; if (kv_ + 32 > qrel) C1[r] = -INFINITY; } } \
            float rm_ = fmaxf(C0[0], C1[0]); \
            _Pragma("unroll") for (int r = 1; r < 16; ++r) rm_ = fmaxf(rm_, fmaxf(C0[r], C1[r])); \
            { auto rr_ = __builtin_amdgcn_permlane32_swap(__float_as_uint(rm_), __float_as_uint(rm_), false, false); rm_ = fmaxf(__uint_as_float(rr_[0]), __uint_as_float(rr_[1])); } \
            if (__any(rm_ > mrun + THR)) { const float mnew_ = fmaxf(mrun, rm_), f_ = __builtin_amdgcn_exp2f(mrun - mnew_); mrun = mnew_; lrun *= f_; \
                if (hi == 0) wsf[r32] = f_; \
                LDS_WAIT(); \
                _Pragma("unroll") for (int r = 0; r < 16; ++r) { const float ff_ = wsf[crow(r, hi)]; o0[r] *= ff_; o1[r] *= ff_; } } \
            __builtin_amdgcn_sched_barrier(0); \
              \
              \
            N0 = f32x16{}; N1 = f32x16{}; \
            float sacc_ = 0.f; unsigned pwv_[16]; bf16x8 vf_[8]; \
            const LAS unsigned char* vp_ = L + LV + vs_cur * 8192 + vb0; \
            _Pragma("unroll") for (int g_ = 0; g_ < 2 * ND; ++g_) { \
                if (g_ & 1) N1 = __builtin_amdgcn_mfma_f32_32x32x16_bf16(kf_[g_], qr[g_ >> 1], N1, 0, 0, 0); else N0 = __builtin_amdgcn_mfma_f32_32x32x16_bf16(kf_[g_], qr[g_ >> 1], N0, 0, 0, 0); \
                _Pragma("unroll") for (int e_ = (g_ * 32) / (2 * ND); e_ < ((g_ + 1) * 32) / (2 * ND); ++e_) { \
                    if (e_ < 16) { C0[e_] = __builtin_amdgcn_exp2f(C0[e_] - mrun); sacc_ += C0[e_]; } else { C1[e_ - 16] = __builtin_amdgcn_exp2f(C1[e_ - 16] - mrun); sacc_ += C1[e_ - 16]; } \
                    if (e_ & 1) { const int j_ = e_ >> 1; pwv_[j_] = (j_ < 8) ? pk2(C0[2 * j_], C0[2 * j_ + 1]) : pk2(C1[2 * j_ - 16], C1[2 * j_ - 15]); } } \
                if (g_ >= 2 * ND - 8) { const int i_ = g_ - (2 * ND - 8); \
                    const s16x4 lo_ = __builtin_bit_cast(s16x4, __builtin_amdgcn_ds_read_tr16_b64_v4i16((LAS s16x4*)(vp_ + (i_ >> 2) * 4096 + (i_ & 3) * 1024))); \
                    const s16x4 hh_ = __builtin_bit_cast(s16x4, __builtin_amdgcn_ds_read_tr16_b64_v4i16((LAS s16x4*)(vp_ + (i_ >> 2) * 4096 + (i_ & 3) * 1024 + 512))); \
                    vf_[i_] = (bf16x8){lo_[0], lo_[1], lo_[2], lo_[3], hh_[0], hh_[1], hh_[2], hh_[3]}; } \
                __builtin_amdgcn_sched_barrier(0); } \
            lrun += sacc_; \
            u32x4 pw_[4]; \
            _Pragma("unroll") for (int k = 0; k < 4; ++k) pw_[k] = (u32x4){pwv_[4 * k], pwv_[4 * k + 1], pwv_[4 * k + 2], pwv_[4 * k + 3]}; \
              \
            _Pragma("unroll") for (int ks = 0; ks < 4; ++ks) { \
                o0 = __builtin_amdgcn_mfma_f32_32x32x16_bf16(__builtin_bit_cast(bf16x8, pw_[ks]), vf_[ks], o0, 0, 0, 0); \
                o1 = __builtin_amdgcn_mfma_f32_32x32x16_bf16(__builtin_bit_cast(bf16x8, pw_[ks]), vf_[4 + ks], o1, 0, 0, 0); } \
        } } while (0)
    const int NTw = CAUSAL ? NT - 3 + (wid >> 1) : NT;
#define ATT_END(nk_) do { const int nw_ = (nk_); if (nw_ == 0) asm volatile("s_waitcnt vmcnt(0) lgkmcnt(0)" ::: "memory"); else if (nw_ == 1) asm volatile("s_waitcnt vmcnt(1) lgkmcnt(0)" ::: "memory"); \
        else if (nw_ == 2) asm volatile("s_waitcnt vmcnt(2) lgkmcnt(0)" ::: "memory"); else asm volatile("s_waitcnt vmcnt(3) lgkmcnt(0)" ::: "memory"); \
        __builtin_amdgcn_s_barrier(); asm volatile("" ::: "memory"); } while (0)
#define ATT_ADV() do { ks_next = (ks_next + 1) & 3; vs_cur = (vs_cur == 2) ? 0 : vs_cur + 1; } while (0)
    for (int t = 0; t < NT; t += 2) {
        { int n_ = 0; if (t + 3 < NT) { ATT_DMA_K(t + 3, (ks_next + 2) & 3); n_ += kcnt; } if (t + 2 < NT) { ATT_DMA_V(t + 2, (vs_cur == 0) ? 2 : vs_cur - 1); n_ += 1; }
          ATT_STEP(sA0, sA1, sB0, sB1, t); ATT_END(n_); ATT_ADV(); }
        { int n_ = 0; if (t + 4 < NT) { ATT_DMA_K(t + 4, (ks_next + 2) & 3); n_ += kcnt; } if (t + 3 < NT) { ATT_DMA_V(t + 3, (vs_cur == 0) ? 2 : vs_cur - 1); n_ += 1; }
          ATT_STEP(sB0, sB1, sA0, sA1, t + 1); ATT_END(n_); ATT_ADV(); }
    }
#undef ATT_END
#undef ATT_ADV
    lrun += __shfl_xor(lrun, 32);
    if (hi == 0) wsf[32 + r32] = lrun;
    LDS_WAIT();
    bf16_t LAS* stg = (bf16_t LAS*)(L + LOST) + wid * 2048;
#pragma unroll
    for (int r = 0; r < 16; ++r) { const int orow = crow(r, hi); const float rl = __builtin_amdgcn_rcpf(wsf[32 + orow]);
        stg[orow * 64 + r32] = (bf16_t)(pk2(o0[r] * rl, 0.f) & 0xffffu); stg[orow * 64 + 32 + r32] = (bf16_t)(pk2(o1[r] * rl, 0.f) & 0xffffu); }
    LDS_WAIT();
#pragma unroll
    for (int i = 0; i < 4; ++i) { const int row = i * 8 + (lane >> 3), ch = lane & 7; const u32x4 v = *(const LAS u32x4*)(stg + row * 64 + ch * 8); *(u32x4*)(Ow + (size_t)(wid * 32 + row) * ldo + ch * 8) = v; }
    asm volatile("s_waitcnt lgkmcnt(0)" ::: "memory"); __builtin_amdgcn_s_barrier(); asm volatile("" ::: "memory");
#undef ATT_DMA_K
#undef ATT_DMA_V
#undef ATT_SYNC
#undef ATT_QK
#undef ATT_STEP
}
}

struct Args { const float* in[24]; float* out; unsigned char* ws; };
struct Frame { LAS unsigned char* lds; unsigned* ctl; int tid, lane, wave, vcu, G; };
__device__ __forceinline__ Frame phase_frame(const Frame& F0) { Frame F = F0; int t = threadIdx.x; asm volatile("" : "+v"(t)); F.tid = t; F.lane = t & 63; F.wave = __builtin_amdgcn_readfirstlane(t >> 6); return F; }

template <class RowMap>
__device__ __forceinline__ void tr_item(const float* W, int ldw, const float* gain, bf16_t* WT, size_t ldt, int dcol0, RowMap rm, LAS float* scr, int k0, int n0, int lane) {
    f32x4 v[8]; float g[8]; const int c4 = lane & 7, r0 = lane >> 3;
#pragma unroll
    for (int j = 0; j < 8; ++j) { const int kk = r0 + 8 * j; v[j] = *(const f32x4*)(W + (size_t)(k0 + kk) * ldw + n0 + 4 * c4); g[j] = gain ? gain[k0 + kk] : 1.0f; }
#pragma unroll
    for (int j = 0; j < 8; ++j) { const int kk = r0 + 8 * j; LAS float* d = scr + kk * 33 + 4 * c4; d[0] = v[j][0] * g[j]; d[1] = v[j][1] * g[j]; d[2] = v[j][2] * g[j]; d[3] = v[j][3] * g[j]; }
    LDS_WAIT(); asm volatile("" ::: "memory");
    const int c = lane & 7;
#pragma unroll
    for (int j = 0; j < 4; ++j) { const int n = (lane >> 3) + 8 * j; const LAS float* s = scr + (8 * c) * 33 + n;
        u32x4 o; o.x = pk2(s[0 * 33], s[1 * 33]); o.y = pk2(s[2 * 33], s[3 * 33]); o.z = pk2(s[4 * 33], s[5 * 33]); o.w = pk2(s[6 * 33], s[7 * 33]);
        *(u32x4*)(WT + (size_t)rm(n0 + n) * ldt + dcol0 + k0 + 8 * c) = o; }
    LDS_WAIT(); asm volatile("" ::: "memory");
}
struct RmId { __device__ __forceinline__ int operator()(int n) const { return n; } };
struct RmOff { int off; __device__ __forceinline__ int operator()(int n) const { return n + off; } };
struct RmInA { __device__ __forceinline__ int operator()(int n) const { return n < 256 ? n : (n < 384 ? n + 256 : (n < 416 ? n + 256 : n - 160)); } };
struct RmGU { int up; __device__ __forceinline__ int operator()(int h) const { return (h >> 2) * 8 + (h & 3) + 4 * up; } };
__device__ __forceinline__ void zero16(bf16_t* p) { *(u32x4*)p = (u32x4){0u, 0u, 0u, 0u}; }

__device__ __forceinline__ void p0_prologue(const Frame& F0, const Args& a) {
    const Frame F = phase_frame(F0);
    unsigned char* ws = a.ws;
    LAS float* scr = (LAS float*)(F.lds + F.wave * 16384);
    const int gw = F.vcu * 8 + F.wave, NGW = F.G * 8, lane = F.lane;
    bf16_t* WinA = (bf16_t*)(ws + WS_WINA); bf16_t* Wqkv = (bf16_t*)(ws + WS_WQKV); bf16_t* WinP = (bf16_t*)(ws + WS_WINP); bf16_t* Wpool = (bf16_t*)(ws + WS_WPOOL);
    bf16_t* Wmem = (bf16_t*)(ws + WS_WMEM); bf16_t* Wo = (bf16_t*)(ws + WS_WO); bf16_t* Wgu = (bf16_t*)(ws + WS_WGU); bf16_t* Wd = (bf16_t*)(ws + WS_WD);
    constexpr int I_INA = 16 * 21, I_UQ = 4 * 36, I_UKV = 2 * 48, I_INP = 16 * 32, I_POOL = 4 * 18, I_MEM = 16 * 16, I_WO = 2 * 512, I_G = 64 * 128, I_U = 64 * 128, I_D = 64 * 128;
    constexpr int NITEMS = I_INA + I_UQ + I_UKV + I_INP + I_POOL + I_MEM + I_WO + I_G + I_U + I_D;
    for (int it = gw; it < NITEMS; it += NGW) {
        int r = it;
        if (r < I_INA) { tr_item(a.in[4], 672, a.in[3], WinA, 1024, 0, RmInA{}, scr, 64 * (r / 21), 32 * (r % 21), lane); continue; } r -= I_INA;
        if (r < I_UQ) { tr_item(a.in[6], 1152, a.in[5], Wqkv, 256, 0, RmId{}, scr, 64 * (r / 36), 32 * (r % 36), lane); continue; } r -= I_UQ;
        if (r < I_UKV) { tr_item(a.in[8], 1536, a.in[7], Wqkv, 256, 0, RmOff{1280}, scr, 64 * (r / 48), 32 * (r % 48), lane); continue; } r -= I_UKV;
        if (r < I_INP) { tr_item(a.in[9], 1024, a.in[3] + 1024, WinP, 1024, 0, RmId{}, scr, 64 * (r / 32), 32 * (r % 32), lane); continue; } r -= I_INP;
        if (r < I_POOL) { const int g = r / 18, q = r % 18; tr_item(a.in[10] + (size_t)g * 192 * 192, 192, nullptr, Wpool + (size_t)g * 65536, 256, 0, RmId{}, scr, 64 * (q / 6), 32 * (q % 6), lane); continue; } r -= I_POOL;
        if (r < I_MEM) { tr_item(a.in[13], 512, a.in[12], Wmem, 1024, 0, RmId{}, scr, 64 * (r / 16), 32 * (r % 16), lane); continue; } r -= I_MEM;
        if (r < I_WO) { const int l = r / 512, q = r % 512; tr_item(a.in[14] + (size_t)l * 1048576, 1024, nullptr, Wo + (size_t)l * 1048576, 1024, 0, RmId{}, scr, 64 * (q / 32), 32 * (q % 32), lane); continue; } r -= I_WO;
        if (r < I_G) { const int le = r / 128, q = r % 128; tr_item(a.in[20] + (size_t)le * 262144, 256, a.in[15] + (le / 32) * 1024, Wgu + (size_t)le * 524288, 1024, 0, RmGU{0}, scr, 64 * (q / 8), 32 * (q % 8), lane); continue; } r -= I_G;
        if (r < I_U) { const int le = r / 128, q = r % 128; tr_item(a.in[21] + (size_t)le * 262144, 256, a.in[15] + (le / 32) * 1024, Wgu + (size_t)le * 524288, 1024, 0, RmGU{1}, scr, 64 * (q / 8), 32 * (q % 8), lane); continue; } r -= I_U;
        { const int le = r / 128, q = r % 128, l = le / 32, e = le % 32;
          tr_item(a.in[22] + (size_t)le * 262144, 1024, nullptr, Wd + ((size_t)l * 4 + (e >> 3)) * (1024 * 2048), 2048, (e & 7) * 256, RmId{}, scr, 64 * (q / 32), 32 * (q % 32), lane); }
    }
    const int gt = (F.vcu * 8 + F.wave) * 64 + lane, NGT = NGW * 64;
    for (int c = gt; c < 96 * 128; c += NGT) zero16(WinA + (size_t)672 * 1024 + (size_t)c * 8);
    for (int c = gt; c < 128 * 32; c += NGT) zero16(Wqkv + (size_t)1152 * 256 + (size_t)c * 8);
    for (int c = gt; c < 1536 * 16; c += NGT) zero16(Wqkv + (size_t)(1280 + c / 16) * 256 + 128 + (c % 16) * 8);
    for (int c = gt; c < 4 * 64 * 32; c += NGT) { const int g = c / 2048, q = c % 2048; zero16(Wpool + (size_t)g * 65536 + (size_t)(192 + q / 32) * 256 + (q % 32) * 8); }
    for (int c = gt; c < 4 * 192 * 8; c += NGT) { const int g = c / 1536, q = c % 1536; zero16(Wpool + (size_t)g * 65536 + (size_t)(q / 8) * 256 + 192 + (q % 8) * 8); }
    { bf16_t* Wr = (bf16_t*)(ws + WS_WR);
      for (int c = gt; c < 2 * 48 * 1024; c += NGT) { const int l = c / 49152, q = c % 49152, j = q / 1024, k = q % 1024; float w = 0.f;
          if (j < 4) w = a.in[16][((size_t)l * 1024 + k) * 4 + j]; else if (j >= 16) w = a.in[18][((size_t)l * 1024 + k) * 32 + (j - 16)];
          w *= a.in[15][l * 1024 + k]; const unsigned hi = pk2(w, 0.f) & 0xffffu; const float rem = w - __uint_as_float(hi << 16);
          Wr[((size_t)l * 96 + j) * 1024 + k] = (bf16_t)hi; Wr[((size_t)l * 96 + 48 + j) * 1024 + k] = (bf16_t)(pk2(rem, 0.f) & 0xffffu); } }
    { float* cs = (float*)(ws + WS_CS); float* sn = (float*)(ws + WS_SN); const int* pos = (const int*)a.in[2];
      for (int c = gt; c < T * 16; c += NGT) { const int t = c >> 4, i = c & 15; const float inv = powf(10000.0f, -(float)(2 * i) / 32.0f); const float ang = (float)pos[t] * inv; cs[c] = cosf(ang); sn[c] = sinf(ang); } }
    { bf16_t* XS = (bf16_t*)(ws + WS_XS); float* rstd0 = (float*)(ws + WS_RSTD0); bf16_t* MB = (bf16_t*)(ws + WS_MEMB); float* rstdm = (float*)(ws + WS_RSTDM);
      for (int m0 = gw; m0 < T + TMEM; m0 += 2 * NGW) { f32x4 v[2][4];
#pragma unroll
          for (int q = 0; q < 2; ++q) { const int m = m0 + q * NGW; if (m < T + TMEM) { const bool ism = m >= T; const int row = ism ? m - T : m;
              const f32x4* xr = (const f32x4*)((ism ? a.in[1] : a.in[0]) + (size_t)row * DM) + lane;
#pragma unroll
              for (int j = 0; j < 4; ++j) v[q][j] = xr[64 * j]; } }
#pragma unroll
          for (int q = 0; q < 2; ++q) { const int m = m0 + q * NGW; if (m < T + TMEM) { const bool ism = m >= T; const int row = ism ? m - T : m; float s2 = 0.f;
#pragma unroll
              for (int j = 0; j < 4; ++j) s2 += (v[q][j][0] * v[q][j][0] + v[q][j][1] * v[q][j][1]) + (v[q][j][2] * v[q][j][2] + v[q][j][3] * v[q][j][3]);
              s2 = wave_sum(s2); const float rs = 1.0f / sqrtf(s2 * (1.f / DM) + EPS);
              u32x2* o8 = (u32x2*)((ism ? MB : XS) + (size_t)row * DM) + lane;
#pragma unroll
              for (int j = 0; j < 4; ++j) o8[64 * j] = (u32x2){pk2(v[q][j][0], v[q][j][1]), pk2(v[q][j][2], v[q][j][3])};
              if (lane == 0) (ism ? rstdm : rstd0)[row] = rs; } } } }
}

__device__ __forceinline__ void attn_phase(const Frame& F0, unsigned char* ws, bool mla, const bf16_t* QC, int ldqc) {
    const Frame F = phase_frame(F0);
    const bf16_t* Q = (const bf16_t*)(ws + WS_Q); const bf16_t* KN = (const bf16_t*)(ws + WS_KN); const bf16_t* KR = (const bf16_t*)(ws + WS_KROPE); const bf16_t* V = (const bf16_t*)(ws + WS_V);
    const bf16_t* MKV = (const bf16_t*)(ws + WS_MEMKV); bf16_t* CC = (bf16_t*)(ws + WS_CONCAT);
    if (mla) {
        for (int i = 0; i < 6; ++i) { const int pidx = i * F.G + F.vcu; if (pidx >= NB * NHEAD * 4) break; const int bh = pidx >> 2, pr = pidx & 3, b = bh / NHEAD, h = bh % NHEAD;
#pragma unroll 1
            for (int k = 0; k < 2; ++k) { const int qb = k == 0 ? 7 - pr : pr; const size_t row0 = (size_t)b * SEQ, q0 = row0 + (size_t)qb * 256;
                att::attn_unit<96, true>(F.lds, Q + q0 * QW + h * DQK, QW, KN + row0 * KVW + h * 64, KVW, KR + row0 * 32, 32, V + row0 * KVW + h * 64, KVW, CC + q0 * DM + h * 64, DM, 4 * (qb + 1), F.wave, F.lane); } }
    }
    for (int i = 0; i < 4; ++i) { const int uidx = i * F.G + F.vcu; if (uidx >= NB * 4 * 8) break; const int qb = uidx & 7, h = (uidx >> 3) & 3, b = uidx >> 5; const size_t q0 = (size_t)b * SEQ + (size_t)qb * 256;
        att::attn_unit<64, false>(F.lds, QC + q0 * ldqc + h * 64, ldqc, MKV + (size_t)b * MEML * 512 + h * 64, 512, nullptr, 0, MKV + (size_t)b * MEML * 512 + 256 + h * 64, 512, CC + q0 * DM + 768 + h * 64, DM, 4, F.wave, F.lane); }
}

__device__ __forceinline__ void router_phase(const Frame& F0, const Args& a, int layer) {
    const Frame F = phase_frame(F0);
    unsigned char* ws = a.ws; const bf16_t* XS = (const bf16_t*)(ws + WS_XS); const bf16_t* Wr = (const bf16_t*)(ws + WS_WR) + (size_t)layer * 96 * 1024;
    float* tokw = (float*)(ws + WS_TOKW); float* tokr = (float*)(ws + WS_TOKR); int* list = (int*)(ws + WS_LIST); unsigned* cnt = F.ctl + CW_CNT + layer * 128;
    const float* brg = a.in[17] + layer * 4; const float* bre = a.in[19] + layer * 32;
    const int lane = F.lane, fr = lane & 15, fq = lane >> 4, wid = F.wave;
    constexpr int WP = 520;
    LAS bf16_t* Bs = (LAS bf16_t*)F.lds;
    LAS float* LG = (LAS float*)F.lds;
    for (int blk = F.vcu; blk < T / 256; blk += F.G) {
        const int row0 = blk * 256 + wid * 32;
        f32x4 acc[2][6]; float ssq[2] = {0.f, 0.f};
#pragma unroll
        for (int mt = 0; mt < 2; ++mt)
#pragma unroll
            for (int i = 0; i < 6; ++i) acc[mt][i] = (f32x4){0.f, 0.f, 0.f, 0.f};
        for (int kc = 0; kc < 2; ++kc) {
            __syncthreads();
            for (int c = F.tid; c < 96 * 64; c += 512) { const int n = c >> 6, ch = c & 63; *(LAS u32x4*)(Bs + n * WP + ch * 8) = *(const u32x4*)(Wr + (size_t)n * 1024 + kc * 512 + ch * 8); }
            __syncthreads();
#pragma unroll 4
            for (int ks = 0; ks < 16; ++ks) {
                bf16x8 af[2];
#pragma unroll
                for (int mt = 0; mt < 2; ++mt) { af[mt] = *(const bf16x8*)(XS + (size_t)(row0 + mt * 16 + fr) * DM + kc * 512 + ks * 32 + fq * 8);
#pragma unroll
                    for (int j = 0; j < 8; ++j) { const float x = __uint_as_float(((unsigned)(unsigned short)af[mt][j]) << 16); ssq[mt] += x * x; } }
#pragma unroll
                for (int i = 0; i < 6; ++i) { const bf16x8 bfr = *(const LAS bf16x8*)(Bs + (i * 16 + fr) * WP + ks * 32 + fq * 8);
#pragma unroll
                    for (int mt = 0; mt < 2; ++mt) acc[mt][i] = __builtin_amdgcn_mfma_f32_16x16x32_bf16(bfr, af[mt], acc[mt][i], 0, 0, 0); }
            }
        }
        __syncthreads();
#pragma unroll
        for (int mt = 0; mt < 2; ++mt) { float s = ssq[mt]; s += __shfl_xor(s, 16); s += __shfl_xor(s, 32); const float rs = 1.0f / sqrtf(s * (1.f / DM) + EPS); const int lr = wid * 32 + mt * 16 + fr;
#pragma unroll
            for (int i = 0; i < 3; ++i) { const f32x4 v = (acc[mt][i] + acc[mt][i + 3]) * rs;
#pragma unroll
                for (int j = 0; j < 4; ++j) LG[lr * 49 + 16 * i + 4 * fq + j] = v[j]; }
            if (fq == 0) LG[lr * 49 + 48] = rs; }
        __syncthreads();
        if (F.tid < 256) { const int tok = blk * 256 + F.tid; const LAS float* lg = LG + F.tid * 49;
            float g[4]; int gs = 0; float gm;
#pragma unroll
            for (int j = 0; j < 4; ++j) g[j] = lg[j] + brg[j];
            gm = g[0];
#pragma unroll
            for (int j = 1; j < 4; ++j) if (g[j] > gm) { gm = g[j]; gs = j; }
            float den = 0.f;
#pragma unroll
            for (int j = 0; j < 4; ++j) den += __expf(g[j] - gm);
            const float gate = 1.0f / den;
            float e[8];
#pragma unroll
            for (int j = 0; j < 8; ++j) e[j] = lg[16 + gs * 8 + j] + bre[gs * 8 + j];
            int i1 = 0; float m1 = e[0];
#pragma unroll
            for (int j = 1; j < 8; ++j) if (e[j] > m1) { m1 = e[j]; i1 = j; }
            int i2 = -1; float m2 = -INFINITY;
#pragma unroll
            for (int j = 0; j < 8; ++j) if (j != i1 && e[j] > m2) { m2 = e[j]; i2 = j; }
            const float w1 = gate / (1.0f + __expf(m2 - m1)), w2 = gate - w1;
            const int elo = i1 < i2 ? i1 : i2, ehi = i1 < i2 ? i2 : i1; const float wlo = i1 < i2 ? w1 : w2, whi = i1 < i2 ? w2 : w1;
            const int pidx = elo * 7 - (elo * (elo - 1)) / 2 + (ehi - elo - 1);
            const int b = gs * 28 + pidx;
            tokw[(size_t)tok * 2] = wlo; tokw[(size_t)tok * 2 + 1] = whi; tokr[tok] = lg[48];
            const unsigned pos = atomicAdd(cnt + b, 1u);
            list[(size_t)b * CAP + pos] = tok;
        }
        __syncthreads();
    }
}
__device__ __forceinline__ void moe_table(const Frame& F0, int layer) {
    const Frame F = phase_frame(F0);
    LAS int* tab = (LAS int*)(F.lds + L_TAB); const unsigned* cnt = F.ctl + CW_CNT + layer * 128;
    if (F.tid < NBUCKET) tab[128 + F.tid] = (int)__hip_atomic_load(cnt + F.tid, __ATOMIC_RELAXED, __HIP_MEMORY_SCOPE_AGENT);
    __syncthreads();
    if (F.tid == 0) { int s = 0; for (int b = 0; b < NBUCKET; ++b) { tab[b] = s; s += (tab[128 + b] + 255) >> 8; } tab[NBUCKET] = s; }
    __syncthreads();
}

__device__ __forceinline__ void pool_diff_phase(const Frame& F0, unsigned char* ws) {
    const Frame F = phase_frame(F0);
    const bf16_t* Z = (const bf16_t*)(ws + WS_Z); bf16_t* DG = (bf16_t*)(ws + WS_DG);
    constexpr int SR = 64, HALO = 15, LROW = 1552;
    for (int strip = F.vcu; strip < T / SR; strip += F.G) {
        const int t0 = strip * SR, s0 = t0 & (SEQ - 1), hl = min(HALO, s0);
        __syncthreads();
        for (int c = F.tid; c < (SR + hl) * 96; c += 512) { const int rr = c / 96, ch = c % 96;
            *(LAS u32x4*)(F.lds + (size_t)(rr + HALO - hl) * LROW + ch * 16) = *(const u32x4*)(Z + (size_t)(t0 - hl + rr) * DM + ch * 8); }
        __syncthreads();
        for (int c = F.tid; c < SR * 128; c += 512) { const int rr = c >> 7, q = c & 127, g = q >> 5, ch = q & 31; const int t = t0 + rr;
            u32x4 o = (u32x4){0u, 0u, 0u, 0u};
            if (ch < 24) { const int win = 2 << g, n = min(s0 + rr + 1, win); float acc[8] = {0.f, 0.f, 0.f, 0.f, 0.f, 0.f, 0.f, 0.f}; float own[8] = {0.f, 0.f, 0.f, 0.f, 0.f, 0.f, 0.f, 0.f};
                const LAS unsigned char* base = F.lds + (size_t)(rr + HALO) * LROW + (g * 24 + ch) * 16;
                for (int j = 0; j < n; ++j) { const u32x4 w = *(const LAS u32x4*)(base - (size_t)j * LROW);
                    const float x[8] = {bflo(w.x), bfhi(w.x), bflo(w.y), bfhi(w.y), bflo(w.z), bfhi(w.z), bflo(w.w), bfhi(w.w)};
#pragma unroll
                    for (int k = 0; k < 8; ++k) { acc[k] += x[k]; if (j == 0) own[k] = x[k]; } }
                const float inv = 1.0f / (float)n;
                o = (u32x4){pk2(acc[0] * inv - own[0], acc[1] * inv - own[1]), pk2(acc[2] * inv - own[2], acc[3] * inv - own[3]), pk2(acc[4] * inv - own[4], acc[5] * inv - own[5]), pk2(acc[6] * inv - own[6], acc[7] * inv - own[7])}; }
            *(u32x4*)(DG + ((size_t)g * T + t) * 256 + ch * 8) = o; }
    }
    __syncthreads();
}
__device__ __forceinline__ void final_phase(const Frame& F0, const Args& a) {
    const Frame F = phase_frame(F0);
    const bf16_t* XS = (const bf16_t*)(a.ws + WS_XS); const float* gf = a.in[23];
    const int gw = F.vcu * 8 + F.wave, NGW = F.G * 8, lane = F.lane;
    f32x4 gv[4];
#pragma unroll
    for (int j = 0; j < 4; ++j) gv[j] = *((const f32x4*)gf + lane + 64 * j);
    for (int m = gw; m < T; m += NGW) { const u32x2* xr = (const u32x2*)(XS + (size_t)m * DM) + lane; f32x4 v[4]; float s2 = 0.f;
#pragma unroll
        for (int j = 0; j < 4; ++j) { const u32x2 w = xr[64 * j]; v[j] = (f32x4){bflo(w.x), bfhi(w.x), bflo(w.y), bfhi(w.y)}; s2 += (v[j][0] * v[j][0] + v[j][1] * v[j][1]) + (v[j][2] * v[j][2] + v[j][3] * v[j][3]); }
        s2 = wave_sum(s2); const float rs = 1.0f / sqrtf(s2 * (1.f / DM) + EPS);
        f32x4* o = (f32x4*)(a.out + (size_t)m * DM) + lane;
#pragma unroll
        for (int j = 0; j < 4; ++j) o[64 * j] = v[j] * rs * gv[j]; }
}

#ifndef PHASE_MASK
#define PHASE_MASK 0xFFFFFFFFu
#endif
#define PH(n) ((PHASE_MASK >> (n)) & 1u)
__global__ void __launch_bounds__(512, 2) fwd_kernel(Args args) {
    extern __shared__ __attribute__((aligned(16))) unsigned char lds_raw[];
    Frame F; F.lds = (LAS unsigned char*)lds_raw; F.tid = threadIdx.x; F.lane = F.tid & 63; F.wave = __builtin_amdgcn_readfirstlane(F.tid >> 6);
    F.G = gridDim.x; { const int bx = blockIdx.x; F.vcu = (F.G % 8 == 0) ? (bx % 8) * (F.G / 8) + bx / 8 : bx; }
    unsigned char* ws = args.ws; F.ctl = (unsigned*)(ws + WS_CTL);
    for (int u = F.tid; u < (LDS_BYTES - RING_BYTES) / 4; u += 512) ((LAS unsigned*)(F.lds + RING_BYTES))[u] = 0u;
    __syncthreads();
    XcdBarrier bar = xcd_barrier_post(F.ctl + CW_BAR, (volatile LAS unsigned*)(F.lds + L_MISC) + 8);
    LAS unsigned char* listbuf = F.lds + L_LIST;
    const float qcscale = 0.125f * LOG2E;
    const float qscale = 0.10206207261596577f * LOG2E;

    if (PH(0)) p0_prologue(F, args);
    xcd_barrier(bar);
    if (PH(1)) {   SchedPlain S; S.o.init(TMEM / 256, 2, F.G, (int)blockIdx.x); S.A = (const char*)(ws + WS_MEMB); S.B = (const char*)(ws + WS_WMEM); S.a_tile = 256 * 2048; S.b_tile = 256 * 2048;
        EpiRowScale E{(bf16_t*)(ws + WS_MEMKV), 512, (const float*)(ws + WS_RSTDM)};
        pg8::gemm_run<EpiRowScale, SchedPlain, false>(F.lds, listbuf, S, E, 16, 1 << 30, 2048u, 2048u); }
    if (PH(2)) {   SchedPlain S; S.o.init(T / 256, 3, F.G, (int)blockIdx.x); S.A = (const char*)(ws + WS_XS); S.B = (const char*)(ws + WS_WINA); S.a_tile = 256 * 2048; S.b_tile = 256 * 2048;
        EpiInA E{(const float*)(ws + WS_RSTD0), (bf16_t*)(ws + WS_QLAT), (bf16_t*)(ws + WS_QC), (bf16_t*)(ws + WS_KVLAT), (bf16_t*)(ws + WS_KROPE), (float*)(ws + WS_SSQQ), (float*)(ws + WS_SSQKV),
                 (const float*)(ws + WS_CS), (const float*)(ws + WS_SN), qcscale};
        pg8::gemm_run<EpiInA, SchedPlain, false>(F.lds, listbuf, S, E, 16, 1 << 30, 2048u, 2048u); }
    xcd_barrier(bar);
    if (PH(3)) {   SchedQKV S; S.o.init(T / 256, 11, F.G, (int)blockIdx.x); S.Aq = (const char*)(ws + WS_QLAT); S.Akv = (const char*)(ws + WS_KVLAT); S.B = (const char*)(ws + WS_WQKV);
        EpiQKV E{(const float*)(ws + WS_SSQQ), (const float*)(ws + WS_SSQKV), (bf16_t*)(ws + WS_Q), (bf16_t*)(ws + WS_KN), (bf16_t*)(ws + WS_V), (const float*)(ws + WS_CS), (const float*)(ws + WS_SN), qscale};
        pg8::gemm_run<EpiQKV, SchedQKV, false>(F.lds, listbuf, S, E, 4, 1 << 30, 512u, 512u); }
    xcd_barrier(bar);
#pragma unroll 1
    for (int layer = 0; layer < 2; ++layer) {
        { size_t zoff = 0; asm volatile("" : "+s"(zoff)); ws = args.ws + zoff; }
        if (layer == 0) {
            if (PH(4)) attn_phase(F, ws, true, (const bf16_t*)(ws + WS_QC), 256);
            xcd_barrier(bar);
        } else {
            if (PH(5)) {   SchedPlain S; S.o.init(T / 256, 4, F.G, (int)blockIdx.x); S.A = (const char*)(ws + WS_XS); S.B = (const char*)(ws + WS_WINP); S.a_tile = 256 * 2048; S.b_tile = 256 * 2048;
                EpiInP E{(const float*)(ws + WS_SSQX), (bf16_t*)(ws + WS_Z), qcscale};
                pg8::gemm_run<EpiInP, SchedPlain, false>(F.lds, listbuf, S, E, 16, 1 << 30, 2048u, 2048u); }
            xcd_barrier(bar);
            if (PH(6)) pool_diff_phase(F, ws);
            if (PH(7)) attn_phase(F, ws, false, (const bf16_t*)(ws + WS_Z) + 768, 1024);
            xcd_barrier(bar);
            if (PH(8)) {   SchedPool S; S.o.init(T / 256, 4, F.G, (int)blockIdx.x); S.A = (const char*)(ws + WS_DG); S.B = (const char*)(ws + WS_WPOOL);
                EpiPool E{args.in[11], (bf16_t*)(ws + WS_CONCAT)};
                pg8::gemm_run<EpiPool, SchedPool, false>(F.lds, listbuf, S, E, 4, 1 << 30, 512u, 512u); }
            xcd_barrier(bar);
        }
        if (PH(9)) {   SchedPlain S; S.o.init(T / 256, 4, F.G, (int)blockIdx.x); S.A = (const char*)(ws + WS_CONCAT); S.B = (const char*)(ws + WS_WO) + (size_t)layer * 2097152; S.a_tile = 256 * 2048; S.b_tile = 256 * 2048;
            EpiWo E{(bf16_t*)(ws + WS_XS)};
            pg8::gemm_run<EpiWo, SchedPlain, false>(F.lds, listbuf, S, E, 16, 1 << 30, 2048u, 2048u); }
        xcd_barrier(bar);
        if (PH(10)) router_phase(F, args, layer);
        xcd_barrier(bar);
        moe_table(F, layer);
        if (PH(11)) {   SchedMoe<false> S{(const LAS int*)(F.lds + L_TAB), F.G, F.vcu, (const char*)(ws + WS_XS), (const char*)(ws + WS_WGU) + (size_t)layer * (32u * 512u * 2048u), (const int*)(ws + WS_LIST)};
            EpiMoeUp E{(const float*)(ws + WS_TOKR), (const float*)(ws + WS_TOKW), (bf16_t*)(ws + WS_ACT)};
            pg8::gemm_run<EpiMoeUp, SchedMoe<false>, true>(F.lds, listbuf, S, E, 16, 1 << 30, 2048u, 2048u); }
        xcd_barrier(bar);
        if (PH(12)) {   SchedMoe<true> S{(const LAS int*)(F.lds + L_TAB), F.G, F.vcu, (const char*)(ws + WS_ACT), (const char*)(ws + WS_WD) + (size_t)layer * (4u * 1024u * 4096u), (const int*)(ws + WS_LIST)};
            EpiMoeDown E{(bf16_t*)(ws + WS_XS), (float*)(ws + WS_SSQX)};
            pg8::gemm_run<EpiMoeDown, SchedMoe<true>, false>(F.lds, listbuf, S, E, 8, 4, 1024u, 4096u); }
        xcd_barrier(bar);
    }
    if (PH(13)) final_phase(F, args);
}

extern "C" void kernel_launch(void* const* d_in, const int* in_sizes, int n_in, void* d_out, int out_size, void* d_ws, size_t ws_size, hipStream_t stream) {
    static int grid = 0;
    if (grid == 0) {
        if (n_in != 24 || in_sizes[0] != T * DM || out_size != T * DM || ws_size < WS_END) { fprintf(stderr, "kernel_launch: unexpected shapes (n_in %d, in0 %d, out %d, ws %zu); nothing launched\n", n_in, n_in > 0 ? in_sizes[0] : -1, out_size, ws_size); grid = -1; return; }
        int dev = 0, cus = 0, per_cu = 0;
        if (hipGetDevice(&dev) != hipSuccess || hipDeviceGetAttribute(&cus, hipDeviceAttributeMultiprocessorCount, dev) != hipSuccess) { grid = -1; return; }
        if (hipFuncSetAttribute((const void*)fwd_kernel, hipFuncAttributeMaxDynamicSharedMemorySize, LDS_BYTES) != hipSuccess) { fprintf(stderr, "kernel_launch: hipFuncSetAttribute failed\n"); grid = -1; return; }
        if (hipOccupancyMaxActiveBlocksPerMultiprocessor(&per_cu, (const void*)fwd_kernel, 512, LDS_BYTES) != hipSuccess || per_cu < 1) fprintf(stderr, "kernel_launch: occupancy query reports %d\n", per_cu);
        (void)hipGetLastError();
        grid = cus;
    }
    if (grid < 0) return;
    if (hipMemsetAsync((char*)d_ws + WS_CTL, 0, CTL_ZERO_BYTES, stream) != hipSuccess) return;
    Args a{};
    for (int i = 0; i < 24; ++i) a.in[i] = (const float*)d_in[i];
    a.out = (float*)d_out; a.ws = (unsigned char*)d_ws;
    hipLaunchKernelGGL(fwd_kernel, dim3(grid), dim3(512), LDS_BYTES, stream, a);
}
```

```cpp
#include <hip/hip_runtime.h>
#include <cstdio>
#include <cstdint>

#define LAS __attribute__((address_space(3)))
#define GAS __attribute__((address_space(1)))
typedef unsigned short bf16_t;
typedef short bf16x8 __attribute__((ext_vector_type(8)));
typedef short s16x4 __attribute__((ext_vector_type(4)));
typedef float f32x2 __attribute__((ext_vector_type(2)));
typedef float f32x4 __attribute__((ext_vector_type(4)));
typedef float f32x16 __attribute__((ext_vector_type(16)));
typedef unsigned u32x2 __attribute__((ext_vector_type(2)));
typedef unsigned u32x4 __attribute__((ext_vector_type(4)));
typedef __bf16 bf16x2_t __attribute__((ext_vector_type(2)));

constexpr int T = 65536, DM = 1024, SEQ = 2048, NB = 32, MEML = 256, TMEM = NB * MEML;
constexpr int NHEAD = 12, DQK = 96, DV = 64, QW = NHEAD * DQK  , KVW = NHEAD * DV  ;
constexpr float EPS = 1e-6f;
constexpr int NBUCKET = 112, CAP = 65536;
constexpr float LOG2E = 1.4426950408889634f;

constexpr size_t MiB = 1u << 20;
constexpr size_t WS_CTL = 0, CTL_ZERO_BYTES = 1 * MiB;
constexpr size_t WS_WINA = 1 * MiB;
constexpr size_t WS_WQKV = 3 * MiB;
constexpr size_t WS_WINP = 5 * MiB;
constexpr size_t WS_WPOOL = 7 * MiB;
constexpr size_t WS_WMEM = 8 * MiB;
constexpr size_t WS_WO = 9 * MiB;
constexpr size_t WS_WR = 13 * MiB;
constexpr size_t WS_WGU = 14 * MiB;
constexpr size_t WS_WD = 78 * MiB;
constexpr size_t WS_XS = 110 * MiB;
constexpr size_t WS_RSTD0 = 238 * MiB;
constexpr size_t WS_RSTDM = 238 * MiB + 512 * 1024;
constexpr size_t WS_CS = 239 * MiB, WS_SN = 243 * MiB;
constexpr size_t WS_MEMB = 247 * MiB;
constexpr size_t WS_MEMKV = 263 * MiB;
constexpr size_t WS_SSQQ = 271 * MiB, WS_SSQKV = 272 * MiB, WS_SSQX = 273 * MiB;
constexpr size_t WS_TOKW = 277 * MiB;
constexpr size_t WS_TOKR = 278 * MiB;
constexpr size_t WS_KROPE = 279 * MiB;
constexpr size_t WS_LIST = 283 * MiB;
constexpr size_t WS_QLAT = 311 * MiB, WS_QC = 343 * MiB, WS_KVLAT = 375 * MiB;
constexpr size_t WS_ACT = 311 * MiB;
constexpr size_t WS_Q = 407 * MiB, WS_KN = 551 * MiB, WS_V = 647 * MiB;
constexpr size_t WS_Z = 407 * MiB, WS_DG = 535 * MiB;
constexpr size_t WS_CONCAT = 743 * MiB;
constexpr size_t WS_END = 871 * MiB;
constexpr int CW_BAR = 4096, CW_CNT = 8192;

constexpr int RING_BYTES = 131072;
constexpr int L_MISC = RING_BYTES, L_LIST = RING_BYTES + 256, L_TAB = RING_BYTES + 256 + 2048, LDS_BYTES = RING_BYTES + 4096;

__device__ __forceinline__ unsigned pk2(float lo, float hi) { f32x2 v = {lo, hi}; bf16x2_t b = __builtin_convertvector(v, bf16x2_t); return __builtin_bit_cast(unsigned, b); }
__device__ __forceinline__ float bflo(unsigned w) { return __uint_as_float(w << 16); }
__device__ __forceinline__ float bfhi(unsigned w) { return __uint_as_float(w & 0xffff0000u); }
__device__ __forceinline__ u32x4 pack8(f32x4 a, f32x4 b) { u32x4 w; w.x = pk2(a[0], a[1]); w.y = pk2(a[2], a[3]); w.z = pk2(b[0], b[1]); w.w = pk2(b[2], b[3]); return w; }
__device__ __forceinline__ float wave_sum(float v) {
#pragma unroll
    for (int o = 1; o < 64; o <<= 1) v += __shfl_xor(v, o);
    return v;
}
#define LDS_WAIT() asm volatile("s_waitcnt lgkmcnt(0)" ::: "memory")
#define VM_WAIT() asm volatile("s_waitcnt vmcnt(0)" ::: "memory")

#define XB_TMO      128
#define XB_XCNT(j)  (256  + 64 * (j))
#define XB_XSUB(j)  (1280 + 64 * (j))
#define XB_XGEN(j)  (2304 + 64 * (j))
#define XB_TOP      3328
#define XB_TOPGEN   3392
#define XCD_BAR_WORDS 3456
#define XB_SPIN_CAP (1u << 18)
__device__ __forceinline__ unsigned xb_ld(unsigned* p)              { return __hip_atomic_load(p, __ATOMIC_RELAXED, __HIP_MEMORY_SCOPE_AGENT); }
__device__ __forceinline__ unsigned xb_add(unsigned* p, unsigned v) { return __hip_atomic_fetch_add(p, v, __ATOMIC_RELAXED, __HIP_MEMORY_SCOPE_AGENT); }
__device__ __forceinline__ unsigned xb_xcc_id() { return (unsigned)__builtin_amdgcn_s_getreg((3 << 11) | 20) & 0xFu; }
#define XB_SPIN(cond, bar) do { unsigned _sp = 0; while (cond) { __builtin_amdgcn_s_sleep(1); \
    if ((++_sp & 255u) == 0u) { if (xb_ld(&(bar)[XB_TMO])) break; if (_sp > XB_SPIN_CAP) { atomicAdd(&(bar)[XB_TMO], 1u); break; } } } } while (0)
struct XcdBarrier { unsigned* bar; unsigned x; volatile LAS unsigned* st; };
__device__ __forceinline__ XcdBarrier xcd_barrier_post(unsigned* bar, volatile LAS unsigned* st) {
    XcdBarrier b; b.bar = bar; b.x = xb_xcc_id(); b.st = st;
    if (threadIdx.x == 0) (void)xb_add(&bar[XB_XCNT(b.x)], 1u);
    return b;
}
__device__ __forceinline__ void xcd_barrier_complete(unsigned* bar, unsigned x, unsigned& nloc, unsigned& nx) {
    const unsigned G = gridDim.x * gridDim.y * gridDim.z;
    unsigned sum, cnt, mine, sp = 0u;
    for (;;) {
        sum = 0u; cnt = 0u; mine = 0u;
#pragma unroll
        for (unsigned j = 0; j < 16; ++j) { const unsigned c = xb_ld(&bar[XB_XCNT(j)]); sum += c; cnt += (c > 0u) ? 1u : 0u; mine = (j == x) ? c : mine; }
        if (sum == G) break;
        __builtin_amdgcn_s_sleep(1);
        if ((++sp & 255u) == 0u) { if (xb_ld(&bar[XB_TMO])) break; if (sp > XB_SPIN_CAP) { atomicAdd(&bar[XB_TMO], 1u); break; } }
    }
    nloc = mine > 0u ? mine : 1u; nx = cnt > 0u ? cnt : 1u;
}
__device__ __forceinline__ void xcd_barrier(const XcdBarrier& b) {
    asm volatile("s_waitcnt vmcnt(0)" ::: "memory");
    __syncthreads();
    if (threadIdx.x == 0) {
        unsigned zoff = 0u; asm volatile("" : "+s"(zoff));
        unsigned* bar = b.bar + zoff;
        __builtin_amdgcn_s_waitcnt(0);
        const unsigned bx = xb_xcc_id();
        unsigned nloc = b.st[0], nx = b.st[1];
        if (nloc == 0u) { xcd_barrier_complete(bar, bx, nloc, nx); b.st[0] = nloc; b.st[1] = nx; }
        const unsigned old = xb_add(&bar[XB_XSUB(bx)], 1u);
        const unsigned gen = old / nloc;
        if (old + 1u == (gen + 1u) * nloc) {
            __builtin_amdgcn_fence(__ATOMIC_RELEASE, "agent");
            asm volatile("s_waitcnt vmcnt(0)" ::: "memory");
            const unsigned og = xb_add(&bar[XB_TOP], 1u);
            const unsigned tg = og / nx;
            if (og + 1u == (tg + 1u) * nx) xb_add(&bar[XB_TOPGEN], 1u);
            else XB_SPIN(xb_ld(&bar[XB_TOPGEN]) == tg, bar);
            __builtin_amdgcn_fence(__ATOMIC_ACQUIRE, "agent");
            xb_add(&bar[XB_XGEN(bx)], 1u);
            asm volatile("s_waitcnt vmcnt(0)" ::: "memory");
        } else {
            XB_SPIN(xb_ld(&bar[XB_XGEN(bx)]) == gen, bar);
            __builtin_amdgcn_fence(__ATOMIC_ACQUIRE, "agent");
            asm volatile("s_waitcnt vmcnt(0)" ::: "memory");
        }
    }
    __syncthreads();
}

namespace pg8 {
constexpr int BM = 256, BK = 64, HALF = 128, HTB = HALF * BK * 2, NXCD = 8, WGM = 8;
__host__ __device__ __forceinline__ int lds_byte(int r, int c) { const int st = (r >> 4) * 2 + (c >> 5), rr = r & 15, cc = c & 31, ob = rr * 64 + cc * 2; return st * 1024 + (ob ^ (((ob >> 9) & 1) << 5)); }
__host__ __device__ __forceinline__ void stage_rc(int b, int& R, int& C) { const int st = b / 1024, sb = b % 1024, swz = sb ^ (((sb >> 9) & 1) << 5); R = (st >> 1) * 16 + swz / 64; C = (st & 1) * 32 + (swz % 64) / 2; }
__host__ __device__ __forceinline__ int perm32(int rho) { const int n = rho >> 4, i = rho & 15; return 8 * (i >> 2) + 4 * n + (i & 3); }

struct Unit { const char* A; const char* B; int bjump; int nvalid; const int* list; int pm, pn, aux; };

struct TileOrder {
    int nM, nN, nwg, G, c;
    __device__ __forceinline__ void init(int nM_, int nN_, int G_, int c_) { nM = nM_; nN = nN_; nwg = nM * nN; G = G_; c = c_; }
    __device__ __forceinline__ bool get(int i, int& pm, int& pn) const {
        const long L = (long)i * G + c; if (L >= nwg) return false;
        int wgid = (int)L; { const int q = nwg / NXCD, r = nwg % NXCD, xcd = wgid % NXCD, off = wgid / NXCD; wgid = (xcd < r ? xcd * (q + 1) : r * (q + 1) + (xcd - r) * q) + off; }
        const int nig = WGM * nN, gid = wgid / nig, fm = gid * WGM, gsz = (nM - fm) < WGM ? (nM - fm) : WGM;
        pm = fm + ((wgid % nig) % gsz); pn = (wgid % nig) / gsz; return true;
    }
};

template <class Epi, class Sched, bool GATHER>
__device__ __forceinline__ void gemm_run(LAS unsigned char* lds, LAS unsigned char* listbuf, const Sched& S, const Epi& E, const int nt, const int jt, const unsigned lda2, const unsigned ldb2) {
    int tid = threadIdx.x; asm volatile("" : "+v"(tid));
    const int wid = __builtin_amdgcn_readfirstlane(tid >> 6), lane = tid & 63, wr = wid >> 2, wc = wid & 3, fr = lane & 15, fq = lane >> 4;
    int Rr[2]; unsigned Cc[2], voffB[2];
#pragma unroll
    for (int i = 0; i < 2; ++i) { int R, C; stage_rc(tid * 16 + i * 8192, R, C); const int Rb = (R & ~31) + perm32(R & 31); Rr[i] = R; Cc[i] = (unsigned)C * 2u; voffB[i] = (unsigned)Rb * ldb2 + (unsigned)C * 2u; }
    const size_t kstep = (size_t)(BK * 2);
    const size_t hstepB = (size_t)HALF * ldb2;
    const size_t hstepA = GATHER ? (size_t)0 : (size_t)HALF * lda2;
    const unsigned ldsw = (unsigned)wid * 1024u;
    const int aoff = lds_byte(wr * 64 + fr, fq * 8), boff = lds_byte(wc * 32 + fr, fq * 8);
#define PG8_SA(b, h) (((b) * 2 + (h)) * HTB)
#define PG8_SB(b, h) ((4 + (b) * 2 + (h)) * HTB)
#define PG8_STAGE(bufoff, gbase, voff) do { _Pragma("unroll") for (int _i = 0; _i < 2; ++_i) \
        __builtin_amdgcn_global_load_lds((const unsigned*)((const char*)(gbase) + (voff)[_i]), (LAS unsigned*)(lds + (bufoff) + ldsw + _i * 8192), 16, 0, 0); } while (0)
#define PG8_LDA(dst, b, h) do { _Pragma("unroll") for (int m = 0; m < 4; ++m) _Pragma("unroll") for (int k = 0; k < 2; ++k) dst[m][k] = *(const LAS bf16x8*)(lds + PG8_SA(b, h) + aoff + m * 2048 + k * 1024); } while (0)
#define PG8_LDB(dst, b, h) do { _Pragma("unroll") for (int n = 0; n < 2; ++n) _Pragma("unroll") for (int k = 0; k < 2; ++k) dst[n][k] = *(const LAS bf16x8*)(lds + PG8_SB(b, h) + boff + n * 2048 + k * 1024); } while (0)
#define PG8_MMA(ai, bj, At, Bt) do { __builtin_amdgcn_s_setprio(1); _Pragma("unroll") for (int m = 0; m < 4; ++m) _Pragma("unroll") for (int n = 0; n < 2; ++n) _Pragma("unroll") for (int k = 0; k < 2; ++k) \
        acc[ai][bj][m][n] = __builtin_amdgcn_mfma_f32_16x16x32_bf16(Bt[n][k], At[m][k], acc[ai][bj][m][n], 0, 0, 0); __builtin_amdgcn_s_setprio(0); } while (0)
#define PG8_WAIT_V(n) asm volatile("s_waitcnt vmcnt(" #n ")" ::: "memory")
#define PG8_WAIT_L(n) asm volatile("s_waitcnt lgkmcnt(" #n ")" ::: "memory")
#define PG8_BAR __builtin_amdgcn_s_barrier()
#define PG8_SCHED __builtin_amdgcn_sched_barrier(0)
#define PG8_BPTR(X, tt) ((X).B + (size_t)(tt) * kstep + (((tt) >= jt) ? (X).bjump : 0))
    Unit cur, nxt; int ui = 0;
    if (!S.next(0, cur)) return;
    unsigned offA[2][2];
#pragma unroll
    for (int h = 0; h < 2; ++h)
#pragma unroll
        for (int i = 0; i < 2; ++i) {
            const int row = h * HALF + Rr[i];
            if constexpr (GATHER) { int idx = cur.list[row]; if (row >= cur.nvalid) idx = 0; offA[h][i] = (unsigned)idx * lda2 + Cc[i]; }
            else offA[h][i] = (unsigned)Rr[i] * lda2 + Cc[i];
        }
    f32x4 acc[2][2][4][2];
#pragma unroll
    for (int a = 0; a < 2; ++a)
#pragma unroll
        for (int b = 0; b < 2; ++b)
#pragma unroll
            for (int m = 0; m < 4; ++m)
#pragma unroll
                for (int n = 0; n < 2; ++n) acc[a][b][m][n] = (f32x4){0.f, 0.f, 0.f, 0.f};
    bf16x8 At[4][2], B0[2][2], B1[2][2];
    {
        const char* cA = cur.A; const char* cB = cur.B;
        PG8_STAGE(PG8_SB(0, 0), cB, voffB); PG8_STAGE(PG8_SB(0, 1), cB + hstepB, voffB); PG8_STAGE(PG8_SA(0, 0), cA, offA[0]); PG8_STAGE(PG8_SA(0, 1), cA + hstepA, offA[1]);
        if (wr == 1) PG8_BAR;
        PG8_WAIT_V(2); PG8_BAR;
        const char* cB1 = PG8_BPTR(cur, 1);
        PG8_STAGE(PG8_SB(1, 0), cB1, voffB); PG8_STAGE(PG8_SA(1, 0), cA + kstep, offA[0]); PG8_STAGE(PG8_SB(1, 1), cB1 + hstepB, voffB);
        PG8_WAIT_V(6); PG8_BAR;
    }
    for (;;) {
        const bool has_next = S.next(ui + 1, nxt);
        if constexpr (GATHER) {
            if (has_next) __builtin_amdgcn_global_load_lds((const unsigned*)((const char*)nxt.list + lane * 16), (LAS unsigned*)(listbuf + ((ui + 1) & 1) * 1024), 16, 0, 0);
        }
        const char* cA = cur.A;
        const char* nA = has_next ? nxt.A : cur.A;
        const char* nB0 = has_next ? nxt.B : cur.B;
        const char* nB1 = has_next ? PG8_BPTR(nxt, 1) : PG8_BPTR(cur, 1);
#pragma unroll 1
        for (int t = 0; t < nt; t += 2) {
            const bool last = (t == nt - 2);
            const char* a1 = cA + (size_t)(t + 1) * kstep;
            const char* a2 = last ? nA : cA + (size_t)(t + 2) * kstep; const char* b2 = last ? nB0 : PG8_BPTR(cur, t + 2);
            const char* a3 = a2 + kstep;                              const char* b3 = last ? nB1 : PG8_BPTR(cur, t + 3);
            PG8_LDB(B0, 0, 0); PG8_LDB(B1, 0, 1); PG8_SCHED; PG8_LDA(At, 0, 0); PG8_STAGE(PG8_SA(1, 1), a1 + hstepA, offA[1]);
            if constexpr (GATHER) {
                if (last && has_next) {
                    const LAS int* lb = (const LAS int*)(listbuf + ((ui + 1) & 1) * 1024);
#pragma unroll
                    for (int h = 0; h < 2; ++h)
#pragma unroll
                        for (int i = 0; i < 2; ++i) { const int row = h * HALF + Rr[i]; int idx = lb[row]; if (row >= nxt.nvalid) idx = 0; offA[h][i] = (unsigned)idx * lda2 + Cc[i]; }
                }
            }
            PG8_WAIT_V(8); PG8_WAIT_L(0); PG8_BAR; PG8_MMA(0, 0, At, B0); PG8_MMA(0, 1, At, B1); PG8_BAR; PG8_SCHED;
            PG8_LDA(At, 0, 1); PG8_STAGE(PG8_SB(0, 0), b2, voffB); PG8_STAGE(PG8_SB(0, 1), b2 + hstepB, voffB); PG8_STAGE(PG8_SA(0, 0), a2, offA[0]);
            PG8_WAIT_V(8); PG8_WAIT_L(0); PG8_BAR; PG8_MMA(1, 0, At, B0); PG8_MMA(1, 1, At, B1); PG8_BAR; PG8_SCHED;
            PG8_LDB(B0, 1, 0); PG8_LDB(B1, 1, 1); PG8_SCHED; PG8_LDA(At, 1, 0); PG8_STAGE(PG8_SA(0, 1), a2 + hstepA, offA[1]);
            PG8_WAIT_V(8); PG8_WAIT_L(0); PG8_BAR; PG8_MMA(0, 0, At, B0); PG8_MMA(0, 1, At, B1); PG8_BAR; PG8_SCHED;
            PG8_LDA(At, 1, 1); PG8_STAGE(PG8_SB(1, 0), b3, voffB); PG8_STAGE(PG8_SB(1, 1), b3 + hstepB, voffB); PG8_STAGE(PG8_SA(1, 0), a3, offA[0]);
            PG8_WAIT_V(8); PG8_WAIT_L(0); PG8_BAR; PG8_MMA(1, 0, At, B0); PG8_MMA(1, 1, At, B1); PG8_BAR; PG8_SCHED;
        }
        if (wr == 0) PG8_BAR;
        E(acc, cur, wr, wc, fr, fq);
        if (!has_next) break;
#pragma unroll
        for (int a = 0; a < 2; ++a)
#pragma unroll
            for (int b = 0; b < 2; ++b)
#pragma unroll
                for (int m = 0; m < 4; ++m)
#pragma unroll
                    for (int n = 0; n < 2; ++n) acc[a][b][m][n] = (f32x4){0.f, 0.f, 0.f, 0.f};
        cur = nxt; ++ui;
        if (wr == 1) PG8_BAR;
    }
    PG8_WAIT_V(0);
    PG8_BAR;
#undef PG8_SA
#undef PG8_SB
#undef PG8_STAGE
#undef PG8_LDA
#undef PG8_LDB
#undef PG8_MMA
#undef PG8_WAIT_V
#undef PG8_WAIT_L
#undef PG8_BAR
#undef PG8_SCHED
#undef PG8_BPTR
}
}
using pg8::Unit;

struct SchedPlain {
    pg8::TileOrder o; const char* A; const char* B; size_t a_tile, b_tile;
    __device__ __forceinline__ bool next(int i, Unit& u) const { int pm, pn; if (!o.get(i, pm, pn)) return false;
        u.A = A + (size_t)pm * a_tile; u.B = B + (size_t)pn * b_tile; u.bjump = 0; u.nvalid = 256; u.list = nullptr; u.pm = pm; u.pn = pn; u.aux = 0; return true; }
};
struct SchedQKV {
    pg8::TileOrder o; const char* Aq; const char* Akv; const char* B;
    __device__ __forceinline__ bool next(int i, Unit& u) const { int pm, pn; if (!o.get(i, pm, pn)) return false;
        u.A = (pn < 5 ? Aq : Akv) + (size_t)pm * (256 * 512); u.B = B + (size_t)pn * (256 * 512); u.bjump = 0; u.nvalid = 256; u.list = nullptr; u.pm = pm; u.pn = pn; u.aux = 0; return true; }
};
struct SchedPool {
    pg8::TileOrder o; const char* A; const char* B;
    __device__ __forceinline__ bool next(int i, Unit& u) const { int pm, pn; if (!o.get(i, pm, pn)) return false;
        u.A = A + ((size_t)pn * T + (size_t)pm * 256) * 512; u.B = B + (size_t)pn * (256 * 512); u.bjump = 0; u.nvalid = 256; u.list = nullptr; u.pm = pm; u.pn = pn; u.aux = 0; return true; }
};
__device__ __forceinline__ void pair_decode(int p, int& lo, int& hi) { int l = 0, rem = p; while (rem >= 7 - l) { rem -= 7 - l; ++l; } lo = l; hi = l + 1 + rem; }
template <bool DOWN> struct SchedMoe {
    const LAS int* tab; int G, c; const char* A; const char* W; const int* list;
    __device__ __forceinline__ bool next(int i, Unit& u) const {
        const int ntile = tab[NBUCKET]; const long L = (long)i * G + c; if (L >= (long)ntile * 4) return false;
        const int tile = (int)(L >> 2), pn = (int)(L & 3);
        int lo_ = 0, hi_ = NBUCKET - 1;
        while (lo_ < hi_) { const int mid = (lo_ + hi_ + 1) >> 1; if (tab[mid] <= tile) lo_ = mid; else hi_ = mid - 1; }
        const int b = __builtin_amdgcn_readfirstlane(lo_);
        const int tib = tile - __builtin_amdgcn_readfirstlane(tab[b]), cnt = __builtin_amdgcn_readfirstlane(tab[128 + b]);
        int elo, ehi; pair_decode(b % 28, elo, ehi); const int g = b / 28;
        u.nvalid = min(256, cnt - tib * 256); u.list = list + (size_t)b * CAP + tib * 256; u.pm = tile; u.pn = pn; u.aux = tile * 256;
        if (!DOWN) { u.A = A; u.B = W + ((size_t)(g * 8 + (pn < 2 ? elo : ehi)) * 512 + (pn & 1) * 256) * 2048; u.bjump = 0; }
        else { u.A = A + (size_t)tile * (256 * 1024); u.B = W + (size_t)g * (1024 * 4096) + (size_t)pn * (256 * 4096) + elo * 512; u.bjump = (ehi - elo - 1) * 512; }
        return true;
    }
};

#define EPI_ROWS(ai, m) (128 * (ai) + 64 * wr + 16 * (m) + fr)
#define EPI_COL(bj) (128 * (bj) + 32 * wc + 8 * fq)
#define EPI_FENCE asm volatile("" ::: "memory")
typedef f32x4 acc_t[2][2][4][2];

struct EpiRowScale {
    bf16_t* O; int ldc; const float* rs;
    __device__ __forceinline__ void operator()(const acc_t& acc, const Unit& u, int wr, int wc, int fr, int fq) const {
        float sv[2][4];
#pragma unroll
        for (int ai = 0; ai < 2; ++ai)
#pragma unroll
            for (int m = 0; m < 4; ++m) sv[ai][m] = rs[u.pm * 256 + EPI_ROWS(ai, m)];
        EPI_FENCE;
#pragma unroll
        for (int ai = 0; ai < 2; ++ai)
#pragma unroll
            for (int m = 0; m < 4; ++m) { const int r = u.pm * 256 + EPI_ROWS(ai, m); const float s = sv[ai][m];
#pragma unroll
                for (int bj = 0; bj < 2; ++bj) *(u32x4*)(O + (size_t)r * ldc + u.pn * 256 + EPI_COL(bj)) = pack8(acc[ai][bj][m][0] * s, acc[ai][bj][m][1] * s); }
    }
};
__device__ __forceinline__ void rope8(f32x4& v0, f32x4& v1, f32x4 c0, f32x4 c1, f32x4 s0, f32x4 s1, int fq) {
    f32x4 p0, p1;
#pragma unroll
    for (int j = 0; j < 4; ++j) { p0[j] = __shfl_xor(v0[j], 32); p1[j] = __shfl_xor(v1[j], 32); }
    const float sg = (fq < 2) ? -1.f : 1.f;
    v0 = v0 * c0 + (p0 * s0) * sg; v1 = v1 * c1 + (p1 * s1) * sg;
}
struct EpiInA {
    const float* rstd0; bf16_t* qlat; bf16_t* qc; bf16_t* kvlat; bf16_t* krope; float* ssqq; float* ssqkv; const float* cs; const float* sn; float qcscale;
    __device__ __forceinline__ void operator()(const acc_t& acc, const Unit& u, int wr, int wc, int fr, int fq) const {
        float sv[2][4];
#pragma unroll
        for (int ai = 0; ai < 2; ++ai)
#pragma unroll
            for (int m = 0; m < 4; ++m) sv[ai][m] = rstd0[u.pm * 256 + EPI_ROWS(ai, m)];
        EPI_FENCE;
        const bool roper = (u.pn == 2) && (wc == 0);
#pragma unroll
        for (int ai = 0; ai < 2; ++ai)
#pragma unroll
          for (int mh = 0; mh < 2; ++mh) {
            f32x4 tc[2][4];
            if (roper) {
#pragma unroll
                for (int mm = 0; mm < 2; ++mm) { const size_t o = (size_t)(u.pm * 256 + EPI_ROWS(ai, 2 * mh + mm)) * 16 + 8 * (fq & 1);
                    tc[mm][0] = *(const f32x4*)(cs + o); tc[mm][1] = *(const f32x4*)(cs + o + 4); tc[mm][2] = *(const f32x4*)(sn + o); tc[mm][3] = *(const f32x4*)(sn + o + 4); }
            }
            EPI_FENCE;
#pragma unroll
            for (int mm = 0; mm < 2; ++mm) { const int m = 2 * mh + mm; const int r = u.pm * 256 + EPI_ROWS(ai, m); const float s = sv[ai][m];
                f32x4 v[2][2];
#pragma unroll
                for (int bj = 0; bj < 2; ++bj) { v[bj][0] = acc[ai][bj][m][0] * s; v[bj][1] = acc[ai][bj][m][1] * s; }
                if (u.pn == 0) {
                    float ss = 0.f;
#pragma unroll
                    for (int bj = 0; bj < 2; ++bj) { *(u32x4*)(qlat + (size_t)r * 256 + EPI_COL(bj)) = pack8(v[bj][0], v[bj][1]);
#pragma unroll
                        for (int n = 0; n < 2; ++n) ss += (v[bj][n][0] * v[bj][n][0] + v[bj][n][1] * v[bj][n][1]) + (v[bj][n][2] * v[bj][n][2] + v[bj][n][3] * v[bj][n][3]); }
                    ss += __shfl_xor(ss, 16); ss += __shfl_xor(ss, 32);
                    if (fq == 0) ssqq[(size_t)r * 4 + wc] = ss;
                } else if (u.pn == 1) {
#pragma unroll
                    for (int bj = 0; bj < 2; ++bj) *(u32x4*)(qc + (size_t)r * 256 + EPI_COL(bj)) = pack8(v[bj][0] * qcscale, v[bj][1] * qcscale);
                } else {
                    float ss = 0.f;
#pragma unroll
                    for (int n = 0; n < 2; ++n) ss += (v[0][n][0] * v[0][n][0] + v[0][n][1] * v[0][n][1]) + (v[0][n][2] * v[0][n][2] + v[0][n][3] * v[0][n][3]);
                    ss += __shfl_xor(ss, 16); ss += __shfl_xor(ss, 32);
                    if (fq == 0) ssqkv[(size_t)r * 4 + wc] = ss;
                    *(u32x4*)(kvlat + (size_t)r * 256 + EPI_COL(0)) = pack8(v[0][0], v[0][1]);
                    *(u32x4*)(kvlat + (size_t)r * 256 + EPI_COL(1)) = (u32x4){0u, 0u, 0u, 0u};
                    if (wc == 0) { f32x4 a = v[1][0], b = v[1][1]; rope8(a, b, tc[mm][0], tc[mm][1], tc[mm][2], tc[mm][3], fq); *(u32x4*)(krope + (size_t)r * 32 + 8 * fq) = pack8(a, b); }
                }
            }
          }
    }
};
struct EpiQKV {
    const float* ssqq; const float* ssqkv; bf16_t* Q; bf16_t* KN; bf16_t* V; float qscale;
    __device__ __forceinline__ void operator()(const acc_t& acc, const Unit& u, int wr, int wc, int fr, int fq) const {
        const bool isq = u.pn < 5;
        const int g32a = isq ? u.pn * 8 + wc : (u.pn - 5) * 8 + wc, g32b = g32a + 4;
        f32x4 p4[2][4];
#pragma unroll
        for (int ai = 0; ai < 2; ++ai)
#pragma unroll
            for (int m = 0; m < 4; ++m) p4[ai][m] = *(const f32x4*)((isq ? ssqq : ssqkv) + (size_t)(u.pm * 256 + EPI_ROWS(ai, m)) * 4);
        EPI_FENCE;
#pragma unroll
        for (int ai = 0; ai < 2; ++ai)
#pragma unroll
            for (int m = 0; m < 4; ++m) { const int r = u.pm * 256 + EPI_ROWS(ai, m);
                const float rs = __builtin_amdgcn_rsqf(((p4[ai][m][0] + p4[ai][m][1]) + (p4[ai][m][2] + p4[ai][m][3])) * (isq ? (1.f / 256.f) : (1.f / 128.f)) + EPS) * (isq ? qscale : 1.0f);
#pragma unroll
                for (int bj = 0; bj < 2; ++bj) {
                    const f32x4 v0 = acc[ai][bj][m][0] * rs, v1 = acc[ai][bj][m][1] * rs;
                    const int g32 = bj ? g32b : g32a;
                    if (isq) { if (g32 < 36) *(u32x4*)(Q + (size_t)r * QW + g32 * 32 + 8 * fq) = pack8(v0, v1); }
                    else { const int h = g32 >> 2, part = g32 & 3;
                        bf16_t* dst = (part < 2 ? KN : V) + (size_t)r * KVW + h * 64 + (part & 1) * 32 + 8 * fq;
                        *(u32x4*)dst = pack8(v0, v1); }
                }
            }
    }
};
struct EpiWo {
    bf16_t* XS;
    __device__ __forceinline__ void operator()(const acc_t& acc, const Unit& u, int wr, int wc, int fr, int fq) const {
        u32x4 w[2][4][2];
#pragma unroll
        for (int ai = 0; ai < 2; ++ai)
#pragma unroll
            for (int m = 0; m < 4; ++m)
#pragma unroll
                for (int bj = 0; bj < 2; ++bj) w[ai][m][bj] = *(const u32x4*)(XS + (size_t)(u.pm * 256 + EPI_ROWS(ai, m)) * DM + u.pn * 256 + EPI_COL(bj));
        EPI_FENCE;
#pragma unroll
        for (int ai = 0; ai < 2; ++ai)
#pragma unroll
            for (int m = 0; m < 4; ++m)
#pragma unroll
                for (int bj = 0; bj < 2; ++bj) { const u32x4 x = w[ai][m][bj]; const size_t off = (size_t)(u.pm * 256 + EPI_ROWS(ai, m)) * DM + u.pn * 256 + EPI_COL(bj);
                    const f32x4 a = (f32x4){bflo(x.x), bfhi(x.x), bflo(x.y), bfhi(x.y)}, b = (f32x4){bflo(x.z), bfhi(x.z), bflo(x.w), bfhi(x.w)};
                    *(u32x4*)(XS + off) = pack8(acc[ai][bj][m][0] + a, acc[ai][bj][m][1] + b); }
    }
};
struct EpiMoeUp {
    const float* tokr; const float* tokw; bf16_t* ACT;
    __device__ __forceinline__ void operator()(const acc_t& acc, const Unit& u, int wr, int wc, int fr, int fq) const {
        int tok[2][4]; float rsv[2][4], wv[2][4];
#pragma unroll
        for (int ai = 0; ai < 2; ++ai)
#pragma unroll
            for (int m = 0; m < 4; ++m) { const int lr = EPI_ROWS(ai, m); tok[ai][m] = u.list[lr < u.nvalid ? lr : 0]; }
        EPI_FENCE;
#pragma unroll
        for (int ai = 0; ai < 2; ++ai)
#pragma unroll
            for (int m = 0; m < 4; ++m) { rsv[ai][m] = tokr[tok[ai][m]]; wv[ai][m] = tokw[(size_t)tok[ai][m] * 2 + (u.pn >> 1)]; }
        EPI_FENCE;
#pragma unroll
        for (int ai = 0; ai < 2; ++ai)
#pragma unroll
            for (int m = 0; m < 4; ++m) { const int lr = EPI_ROWS(ai, m); const float rs = rsv[ai][m], w = wv[ai][m];
#pragma unroll
                for (int bj = 0; bj < 2; ++bj) { const f32x4 g = acc[ai][bj][m][0] * rs, up = acc[ai][bj][m][1] * rs; f32x4 a;
#pragma unroll
                    for (int j = 0; j < 4; ++j) a[j] = g[j] * __builtin_amdgcn_rcpf(1.0f + __builtin_amdgcn_exp2f(-g[j] * LOG2E)) * up[j] * w;
                    u32x2 o; o.x = pk2(a[0], a[1]); o.y = pk2(a[2], a[3]);
                    *(u32x2*)(ACT + (size_t)(u.aux + lr) * 512 + (u.pn >> 1) * 256 + (u.pn & 1) * 128 + bj * 64 + 16 * wc + 4 * fq) = o; }
            }
    }
};
struct EpiMoeDown {
    bf16_t* XS; float* ssq;
    __device__ __forceinline__ void operator()(const acc_t& acc, const Unit& u, int wr, int wc, int fr, int fq) const {
        int tok[2][4];
#pragma unroll
        for (int ai = 0; ai < 2; ++ai)
#pragma unroll
            for (int m = 0; m < 4; ++m) { const int lr = EPI_ROWS(ai, m); tok[ai][m] = u.list[lr < u.nvalid ? lr : 0]; }
        EPI_FENCE;
#pragma unroll
        for (int ai = 0; ai < 2; ++ai) {
            u32x4 w[4][2];
#pragma unroll
            for (int m = 0; m < 4; ++m)
#pragma unroll
                for (int bj = 0; bj < 2; ++bj) w[m][bj] = *(const u32x4*)(XS + (size_t)tok[ai][m] * DM + u.pn * 256 + EPI_COL(bj));
            EPI_FENCE;
#pragma unroll
            for (int m = 0; m < 4; ++m) { const int lr = EPI_ROWS(ai, m); const bool ok = lr < u.nvalid; float ss = 0.f;
#pragma unroll
                for (int bj = 0; bj < 2; ++bj) { const size_t off = (size_t)tok[ai][m] * DM + u.pn * 256 + EPI_COL(bj); const u32x4 x = w[m][bj];
                    const f32x4 a = acc[ai][bj][m][0] + (f32x4){bflo(x.x), bfhi(x.x), bflo(x.y), bfhi(x.y)}, b = acc[ai][bj][m][1] + (f32x4){bflo(x.z), bfhi(x.z), bflo(x.w), bfhi(x.w)};
                    ss += (a[0] * a[0] + a[1] * a[1]) + (a[2] * a[2] + a[3] * a[3]) + (b[0] * b[0] + b[1] * b[1]) + (b[2] * b[2] + b[3] * b[3]);
                    if (ok) *(u32x4*)(XS + off) = pack8(a, b); }
                ss += __shfl_xor(ss, 16); ss += __shfl_xor(ss, 32);
                if (ok && fq == 0) ssq[(size_t)tok[ai][m] * 16 + u.pn * 4 + wc] = ss;
            }
        }
    }
};
struct EpiInP {
    const float* ssq; bf16_t* Z; float qcscale;
    __device__ __forceinline__ void operator()(const acc_t& acc, const Unit& u, int wr, int wc, int fr, int fq) const {
        const float cscale = (u.pn == 3) ? qcscale : 1.0f;
#pragma unroll
        for (int ai = 0; ai < 2; ++ai) {
            f32x4 p[4][4];
#pragma unroll
            for (int m = 0; m < 4; ++m) { const f32x4* pp = (const f32x4*)(ssq + (size_t)(u.pm * 256 + EPI_ROWS(ai, m)) * 16);
#pragma unroll
                for (int q = 0; q < 4; ++q) p[m][q] = pp[q]; }
            EPI_FENCE;
#pragma unroll
            for (int m = 0; m < 4; ++m) { const int r = u.pm * 256 + EPI_ROWS(ai, m);
                const f32x4 s4 = (p[m][0] + p[m][1]) + (p[m][2] + p[m][3]); const float rs = cscale * __builtin_amdgcn_rsqf(((s4[0] + s4[1]) + (s4[2] + s4[3])) * (1.f / 1024.f) + EPS);
#pragma unroll
                for (int bj = 0; bj < 2; ++bj) *(u32x4*)(Z + (size_t)r * DM + u.pn * 256 + EPI_COL(bj)) = pack8(acc[ai][bj][m][0] * rs, acc[ai][bj][m][1] * rs); }
        }
    }
};
struct EpiPool {
    const float* scale; bf16_t* CC;
    __device__ __forceinline__ void operator()(const acc_t& acc, const Unit& u, int wr, int wc, int fr, int fq) const {
#pragma unroll
        for (int bj = 0; bj < 2; ++bj) { const int cl = EPI_COL(bj); if (cl < 192) { const int col = u.pn * 192 + cl;
            const f32x4 s0 = *(const f32x4*)(scale + col), s1 = *(const f32x4*)(scale + col + 4);
#pragma unroll
            for (int ai = 0; ai < 2; ++ai)
#pragma unroll
                for (int m = 0; m < 4; ++m) { const int r = u.pm * 256 + EPI_ROWS(ai, m); *(u32x4*)(CC + (size_t)r * DM + col) = pack8(acc[ai][bj][m][0] * s0, acc[ai][bj][m][1] * s1); } } }
    }
};

namespace att {
__device__ __forceinline__ int crow(int r, int hi) { return (r & 3) + 8 * (r >> 2) + 4 * hi; }
__device__ __forceinline__ void glds16(const void* gsrc, unsigned lds_dst) { unsigned keep;
    asm volatile("s_mov_b32 %0, m0\n\ts_mov_b32 m0, %2\n\ts_nop 0\n\tglobal_load_lds_dwordx4 %1, off\n\ts_mov_b32 m0, %0" : "=&s"(keep) : "v"(gsrc), "s"(lds_dst) : "memory"); }
template <int DQ, bool CAUSAL>
__device__ __forceinline__ void attn_unit(LAS unsigned char* L, const bf16_t* Qw, int ldq, const bf16_t* Kn, int ldk, const bf16_t* Kr, int ldkr,
                                          const bf16_t* Vp, int ldv, bf16_t* Ow, int ldo, const int NT, const int wid, const int lane_in, const float* ropecs = nullptr, const float* ropesn = nullptr) {
    constexpr int ND = DQ / 16, NCH = DQ / 8, KSL = NCH * 1024, LV = 4 * KSL, LWS = LV + 3 * 8192, LOST = LWS + 2048;
    int lane = lane_in; asm volatile("" : "+v"(lane));
    constexpr float THR = 8.0f;
    const int r32 = lane & 31, hi = lane >> 5;
    LAS float* wsf = (LAS float*)(L + LWS) + wid * 64;
    const unsigned lds0 = (unsigned)(uintptr_t)L;
#define ATT_DMA_K(t, slot) do { \
        glds16(Kn + (size_t)((t) * 64 + lane) * ldk + wid * 8, (unsigned)__builtin_amdgcn_readfirstlane(lds0 + (slot) * KSL + wid * 1024)); \
        if (NCH > 8 && wid < NCH - 8) glds16(Kr + (size_t)((t) * 64 + lane) * ldkr + wid * 8, (unsigned)__builtin_amdgcn_readfirstlane(lds0 + (slot) * KSL + (8 + wid) * 1024)); } while (0)
#define ATT_DMA_V(t, slot) glds16(Vp + (size_t)((t) * 64 + 16 * (wid & 3) + (lane >> 2)) * ldv + (wid >> 2) * 32 + (lane & 3) * 8, (unsigned)__builtin_amdgcn_readfirstlane(lds0 + LV + (slot) * 8192 + wid * 1024))
#define ATT_SYNC() do { asm volatile("s_waitcnt vmcnt(0) lgkmcnt(0)" ::: "memory"); __builtin_amdgcn_s_barrier(); asm volatile("" ::: "memory"); } while (0)
#define ATT_QK(S0, S1, kslot) do { const LAS unsigned char* kb_ = L + (kslot) * KSL + hi * 1024 + r32 * 16; S0 = f32x16{}; S1 = f32x16{}; \
        _Pragma("unroll") for (int d0 = 0; d0 < ND; ++d0) { const bf16x8 b0_ = *(const LAS bf16x8*)(kb_ + d0 * 2048), b1_ = *(const LAS bf16x8*)(kb_ + d0 * 2048 + 512); \
            S0 = __builtin_amdgcn_mfma_f32_32x32x16_bf16(b0_, qr[d0], S0, 0, 0, 0); S1 = __builtin_amdgcn_mfma_f32_32x32x16_bf16(b1_, qr[d0], S1, 0, 0, 0); } } while (0)
    ATT_DMA_K(0, 0); ATT_DMA_V(0, 0); ATT_DMA_K(1, 1); ATT_DMA_V(1, 1); ATT_DMA_K(2, 2);
    bf16x8 qr[ND];
#pragma unroll
    for (int d0 = 0; d0 < ND; ++d0) qr[d0] = *(const bf16x8*)(Qw + (size_t)(wid * 32 + r32) * ldq + d0 * 16 + hi * 8);
    if constexpr (DQ == 96) {
        const float* cp = ropecs + (size_t)(wid * 32 + r32) * 16 + 8 * hi; const float* sp = ropesn + (size_t)(wid * 32 + r32) * 16 + 8 * hi;
        const f32x4 c0 = *(const f32x4*)cp, c1 = *(const f32x4*)(cp + 4), s0 = *(const f32x4*)sp, s1 = *(const f32x4*)(sp + 4);
        bf16x8 a = qr[4], b = qr[5];
#pragma unroll
        for (int j = 0; j < 8; ++j) { const float x1 = __uint_as_float(((unsigned)(unsigned short)a[j]) << 16), x2 = __uint_as_float(((unsigned)(unsigned short)b[j]) << 16);
            const float c = j < 4 ? c0[j & 3] : c1[j & 3], sn_ = j < 4 ? s0[j & 3] : s1[j & 3];
            a[j] = (short)(pk2(x1 * c - x2 * sn_, 0.f) & 0xffffu); b[j] = (short)(pk2(x2 * c + x1 * sn_, 0.f) & 0xffffu); }
        qr[4] = a; qr[5] = b;
    }
    f32x16 o0 = {}, o1 = {};
    float mrun = -1e30f, lrun = 0.f;
    const int vb0 = ((lane >> 4) & 1) * 32 + (lane & 3) * 8 + (4 * hi + ((lane & 15) >> 2)) * 64;
    const int qrel = wid * 32 + r32;
    ATT_SYNC();
    f32x16 sA0, sA1, sB0, sB1;
    ATT_QK(sA0, sA1, 0);
    int ks_next = 1, vs_cur = 0;
    const int kcnt = (NCH > 8 && wid < NCH - 8) ? 2 : 1;
#define ATT_STEP(C0, C1, N0, N1, t) do { \
        if ((t) < NTw) { \
              \
            bf16x8 kf_[2 * ND]; \
            { const LAS unsigned char* kb_ = L + ks_next * KSL + hi * 1024 + r32 * 16; \
              _Pragma("unroll") for (int d0 = 0; d0 < ND; ++d0) { kf_[2 * d0] = *(const LAS bf16x8*)(kb_ + d0 * 2048); kf_[2 * d0 + 1] = *(const LAS bf16x8*)(kb_ + d0 * 2048 + 512); } } \
            const int jb_ = (t) - (NT - 4); \
            if (CAUSAL && jb_ >= 0) { const int kbase_ = 64 * jb_ + 4 * hi; \
                _Pragma("unroll") for (int r = 0; r < 16; ++r) { const int kv_ = kbase_ + (r & 3) + 8 * (r >> 2); if (kv_ > qrel) C0[r] = -INFINITY; if (kv_ + 32 > qrel) C1[r] = -INFINITY; } } \
            float rm_ = fmaxf(C0[0], C1[0]); \
            _Pragma("unroll") for (int r = 1; r < 16; ++r) rm_ = fmaxf(rm_, fmaxf(C0[r], C1[r])); \
            { auto rr_ = __builtin_amdgcn_permlane32_swap(__float_as_uint(rm_), __float_as_uint(rm_), false, false); rm_ = fmaxf(__uint_as_float(rr_[0]), __uint_as_float(rr_[1])); } \
            if (__any(rm_ > mrun + THR)) { const float mnew_ = fmaxf(mrun, rm_), f_ = __builtin_amdgcn_exp2f(mrun - mnew_); mrun = mnew_; lrun *= f_; \
                if (hi == 0) wsf[r32] = f_; \
                LDS_WAIT(); \
                _Pragma("unroll") for (int r = 0; r < 16; ++r) { const float ff_ = wsf[crow(r, hi)]; o0[r] *= ff_; o1[r] *= ff_; } } \
            __builtin_amdgcn_sched_barrier(0); \
              \
              \
            N0 = f32x16{}; N1 = f32x16{}; \
            float sacc_ = 0.f; unsigned pwv_[16]; bf16x8 vf_[8]; \
            const LAS unsigned char* vp_ = L + LV + vs_cur * 8192 + vb0; \
            _Pragma("unroll") for (int g_ = 0; g_ < 2 * ND; ++g_) { \
                if (g_ & 1) N1 = __builtin_amdgcn_mfma_f32_32x32x16_bf16(kf_[g_], qr[g_ >> 1], N1, 0, 0, 0); else N0 = __builtin_amdgcn_mfma_f32_32x32x16_bf16(kf_[g_], qr[g_ >> 1], N0, 0, 0, 0); \
                _Pragma("unroll") for (int e_ = (g_ * 32) / (2 * ND); e_ < ((g_ + 1) * 32) / (2 * ND); ++e_) { \
                    if (e_ < 16) { C0[e_] = __builtin_amdgcn_exp2f(C0[e_] - mrun); sacc_ += C0[e_]; } else { C1[e_ - 16] = __builtin_amdgcn_exp2f(C1[e_ - 16] - mrun); sacc_ += C1[e_ - 16]; } \
                    if (e_ & 1) { const int j_ = e_ >> 1; pwv_[j_] = (j_ < 8) ? pk2(C0[2 * j_], C0[2 * j_ + 1]) : pk2(C1[2 * j_ - 16], C1[2 * j_ - 15]); } } \
                if (g_ >= 2 * ND - 8) { const int i_ = g_ - (2 * ND - 8); \
                    const s16x4 lo_ = __builtin_bit_cast(s16x4, __builtin_amdgcn_ds_read_tr16_b64_v4i16((LAS s16x4*)(vp_ + (i_ >> 2) * 4096 + (i_ & 3) * 1024))); \
                    const s16x4 hh_ = __builtin_bit_cast(s16x4, __builtin_amdgcn_ds_read_tr16_b64_v4i16((LAS s16x4*)(vp_ + (i_ >> 2) * 4096 + (i_ & 3) * 1024 + 512))); \
                    vf_[i_] = (bf16x8){lo_[0], lo_[1], lo_[2], lo_[3], hh_[0], hh_[1], hh_[2], hh_[3]}; } \
                __builtin_amdgcn_sched_barrier(0); } \
            lrun += sacc_; \
            u32x4 pw_[4]; \
            _Pragma("unroll") for (int k = 0; k < 4; ++k) pw_[k] = (u32x4){pwv_[4 * k], pwv_[4 * k + 1], pwv_[4 * k + 2], pwv_[4 * k + 3]}; \
              \
            _Pragma("unroll") for (int ks = 0; ks < 4; ++ks) { \
                o0 = __builtin_amdgcn_mfma_f32_32x32x16_bf16(__builtin_bit_cast(bf16x8, pw_[ks]), vf_[ks], o0, 0, 0, 0); \
                o1 = __builtin_amdgcn_mfma_f32_32x32x16_bf16(__builtin_bit_cast(bf16x8, pw_[ks]), vf_[4 + ks], o1, 0, 0, 0); } \
        } } while (0)
    const int NTw = CAUSAL ? NT - 3 + (wid >> 1) : NT;
#define ATT_END(nk_) do { const int nw_ = (nk_); if (nw_ == 0) asm volatile("s_waitcnt vmcnt(0) lgkmcnt(0)" ::: "memory"); else if (nw_ == 1) asm volatile("s_waitcnt vmcnt(1) lgkmcnt(0)" ::: "memory"); \
        else if (nw_ == 2) asm volatile("s_waitcnt vmcnt(2) lgkmcnt(0)" ::: "memory"); else asm volatile("s_waitcnt vmcnt(3) lgkmcnt(0)" ::: "memory"); \
        __builtin_amdgcn_s_barrier(); asm volatile("" ::: "memory"); } while (0)
#define ATT_ADV() do { ks_next = (ks_next + 1) & 3; vs_cur = (vs_cur == 2) ? 0 : vs_cur + 1; } while (0)
    for (int t = 0; t < NT; t += 2) {
        { int n_ = 0; if (t + 3 < NT) { ATT_DMA_K(t + 3, (ks_next + 2) & 3); n_ += kcnt; } if (t + 2 < NT) { ATT_DMA_V(t + 2, (vs_cur == 0) ? 2 : vs_cur - 1); n_ += 1; }
          ATT_STEP(sA0, sA1, sB0, sB1, t); ATT_END(n_); ATT_ADV(); }
        { int n_ = 0; if (t + 4 < NT) { ATT_DMA_K(t + 4, (ks_next + 2) & 3); n_ += kcnt; } if (t + 3 < NT) { ATT_DMA_V(t + 3, (vs_cur == 0) ? 2 : vs_cur - 1); n_ += 1; }
          ATT_STEP(sB0, sB1, sA0, sA1, t + 1); ATT_END(n_); ATT_ADV(); }
    }
#undef ATT_END
#undef ATT_ADV
    lrun += __shfl_xor(lrun, 32);
    if (hi == 0) wsf[32 + r32] = lrun;
    LDS_WAIT();
    bf16_t LAS* stg = (bf16_t LAS*)(L + LOST) + wid * 2048;
#pragma unroll
    for (int r = 0; r < 16; ++r) { const int orow = crow(r, hi); const float rl = __builtin_amdgcn_rcpf(wsf[32 + orow]);
        stg[orow * 64 + r32] = (bf16_t)(pk2(o0[r] * rl, 0.f) & 0xffffu); stg[orow * 64 + 32 + r32] = (bf16_t)(pk2(o1[r] * rl, 0.f) & 0xffffu); }
    LDS_WAIT();
#pragma unroll
    for (int i = 0; i < 4; ++i) { const int row = i * 8 + (lane >> 3), ch = lane & 7; const u32x4 v = *(const LAS u32x4*)(stg + row * 64 + ch * 8); *(u32x4*)(Ow + (size_t)(wid * 32 + row) * ldo + ch * 8) = v; }
    asm volatile("s_waitcnt lgkmcnt(0)" ::: "memory"); __builtin_amdgcn_s_barrier(); asm volatile("" ::: "memory");
#undef ATT_DMA_K
#undef ATT_DMA_V
#undef ATT_SYNC
#undef ATT_QK
#undef ATT_STEP
}
}

struct Args { const float* in[24]; float* out; unsigned char* ws; };
struct Frame { LAS unsigned char* lds; unsigned* ctl; int tid, lane, wave, vcu, G; };
__device__ __forceinline__ Frame phase_frame(const Frame& F0) { Frame F = F0; int t = threadIdx.x; asm volatile("" : "+v"(t)); F.tid = t; F.lane = t & 63; F.wave = __builtin_amdgcn_readfirstlane(t >> 6); return F; }

template <class RowMap>
__device__ __forceinline__ void tr_item(const float* W, int ldw, const float* gain, bf16_t* WT, size_t ldt, int dcol0, RowMap rm, LAS float* scr, int k0, int n0, int lane) {
    f32x4 v[8]; float g[8]; const int c4 = lane & 7, r0 = lane >> 3;
#pragma unroll
    for (int j = 0; j < 8; ++j) { const int kk = r0 + 8 * j; v[j] = *(const f32x4*)(W + (size_t)(k0 + kk) * ldw + n0 + 4 * c4); g[j] = gain ? gain[k0 + kk] : 1.0f; }
#pragma unroll
    for (int j = 0; j < 8; ++j) { const int kk = r0 + 8 * j; LAS float* d = scr + kk * 33 + 4 * c4; d[0] = v[j][0] * g[j]; d[1] = v[j][1] * g[j]; d[2] = v[j][2] * g[j]; d[3] = v[j][3] * g[j]; }
    LDS_WAIT(); asm volatile("" ::: "memory");
    const int c = lane & 7;
#pragma unroll
    for (int j = 0; j < 4; ++j) { const int n = (lane >> 3) + 8 * j; const LAS float* s = scr + (8 * c) * 33 + n;
        u32x4 o; o.x = pk2(s[0 * 33], s[1 * 33]); o.y = pk2(s[2 * 33], s[3 * 33]); o.z = pk2(s[4 * 33], s[5 * 33]); o.w = pk2(s[6 * 33], s[7 * 33]);
        *(u32x4*)(WT + (size_t)rm(n0 + n) * ldt + dcol0 + k0 + 8 * c) = o; }
    LDS_WAIT(); asm volatile("" ::: "memory");
}
struct RmId { __device__ __forceinline__ int operator()(int n) const { return n; } };
struct RmOff { int off; __device__ __forceinline__ int operator()(int n) const { return n + off; } };
struct RmInA { __device__ __forceinline__ int operator()(int n) const { return n < 256 ? n : (n < 384 ? n + 256 : (n < 416 ? n + 256 : n - 160)); } };
struct RmGU { int up; __device__ __forceinline__ int operator()(int h) const { return (h >> 2) * 8 + (h & 3) + 4 * up; } };
__device__ __forceinline__ void zero16(bf16_t* p) { *(u32x4*)p = (u32x4){0u, 0u, 0u, 0u}; }

__device__ __forceinline__ void p0_prologue(const Frame& F0, const Args& a) {
    const Frame F = phase_frame(F0);
    unsigned char* ws = a.ws;
    LAS float* scr = (LAS float*)(F.lds + F.wave * 16384);
    const int gw = F.vcu * 8 + F.wave, NGW = F.G * 8, lane = F.lane;
    bf16_t* WinA = (bf16_t*)(ws + WS_WINA); bf16_t* Wqkv = (bf16_t*)(ws + WS_WQKV); bf16_t* WinP = (bf16_t*)(ws + WS_WINP);
    bf16_t* Wmem = (bf16_t*)(ws + WS_WMEM); bf16_t* Wo = (bf16_t*)(ws + WS_WO); bf16_t* Wgu = (bf16_t*)(ws + WS_WGU); bf16_t* Wd = (bf16_t*)(ws + WS_WD);
    constexpr int I_INA = 16 * 21, I_UQ = 4 * 36, I_UKV = 2 * 48, I_INP = 16 * 32, I_MEM = 16 * 16, I_WO = 2 * 512, I_G = 64 * 128, I_U = 64 * 128, I_D = 64 * 128;
    constexpr int NITEMS = I_INA + I_UQ + I_UKV + I_INP + I_MEM + I_WO + I_G + I_U + I_D;
    for (int it = gw; it < NITEMS; it += NGW) {
        int r = it;
        if (r < I_INA) { tr_item(a.in[4], 672, a.in[3], WinA, 1024, 0, RmInA{}, scr, 64 * (r / 21), 32 * (r % 21), lane); continue; } r -= I_INA;
        if (r < I_UQ) { tr_item(a.in[6], 1152, a.in[5], Wqkv, 256, 0, RmId{}, scr, 64 * (r / 36), 32 * (r % 36), lane); continue; } r -= I_UQ;
        if (r < I_UKV) { tr_item(a.in[8], 1536, a.in[7], Wqkv, 256, 0, RmOff{1280}, scr, 64 * (r / 48), 32 * (r % 48), lane); continue; } r -= I_UKV;
        if (r < I_INP) { tr_item(a.in[9], 1024, a.in[3] + 1024, WinP, 1024, 0, RmId{}, scr, 64 * (r / 32), 32 * (r % 32), lane); continue; } r -= I_INP;
        if (r < I_MEM) { tr_item(a.in[13], 512, a.in[12], Wmem, 1024, 0, RmId{}, scr, 64 * (r / 16), 32 * (r % 16), lane); continue; } r -= I_MEM;
        if (r < I_WO) { const int l = r / 512, q = r % 512; if (l == 1 && q < 12 * 32) continue;
            tr_item(a.in[14] + (size_t)l * 1048576, 1024, nullptr, Wo + (size_t)l * 1048576, 1024, 0, RmId{}, scr, 64 * (q / 32), 32 * (q % 32), lane); continue; } r -= I_WO;
        if (r < I_G) { const int le = r / 128, q = r % 128; tr_item(a.in[20] + (size_t)le * 262144, 256, a.in[15] + (le / 32) * 1024, Wgu + (size_t)le * 524288, 1024, 0, RmGU{0}, scr, 64 * (q / 8), 32 * (q % 8), lane); continue; } r -= I_G;
        if (r < I_U) { const int le = r / 128, q = r % 128; tr_item(a.in[21] + (size_t)le * 262144, 256, a.in[15] + (le / 32) * 1024, Wgu + (size_t)le * 524288, 1024, 0, RmGU{1}, scr, 64 * (q / 8), 32 * (q % 8), lane); continue; } r -= I_U;
        { const int le = r / 128, q = r % 128, l = le / 32, e = le % 32;
          tr_item(a.in[22] + (size_t)le * 262144, 1024, nullptr, Wd + ((size_t)l * 4 + (e >> 3)) * (1024 * 2048), 2048, (e & 7) * 256, RmId{}, scr, 64 * (q / 32), 32 * (q % 32), lane); }
    }
    const int gt = (F.vcu * 8 + F.wave) * 64 + lane, NGT = NGW * 64;
    for (int c = gt; c < 96 * 128; c += NGT) zero16(WinA + (size_t)672 * 1024 + (size_t)c * 8);
    for (int c = gt; c < 128 * 32; c += NGT) zero16(Wqkv + (size_t)1152 * 256 + (size_t)c * 8);
    for (int c = gt; c < 1536 * 16; c += NGT) zero16(Wqkv + (size_t)(1280 + c / 16) * 256 + 128 + (c % 16) * 8);
    for (int it = gw; it < 4 * 24 * 16; it += NGW) { const int g = it / 384, q = it % 384, c0 = 8 * (q / 16), n = 64 * (q % 16) + lane;
        const float* wg = a.in[10] + ((size_t)g * 192 + c0) * 192; const float* sc = a.in[11] + g * 192; const float* wo = a.in[14] + 1048576 + (size_t)g * 192 * 1024 + n;
        float acc[8] = {0.f, 0.f, 0.f, 0.f, 0.f, 0.f, 0.f, 0.f};
#pragma unroll 8
        for (int d = 0; d < 192; ++d) { const float w = wo[(size_t)d * 1024] * sc[d];
#pragma unroll
            for (int i = 0; i < 8; ++i) acc[i] += wg[i * 192 + d] * w; }
        *(u32x4*)(Wo + 1048576 + (size_t)n * 1024 + g * 192 + c0) = (u32x4){pk2(acc[0], acc[1]), pk2(acc[2], acc[3]), pk2(acc[4], acc[5]), pk2(acc[6], acc[7])}; }
    { bf16_t* Wr = (bf16_t*)(ws + WS_WR);
      for (int c = gt; c < 2 * 48 * 1024; c += NGT) { const int l = c / 49152, q = c % 49152, j = q / 1024, k = q % 1024; float w = 0.f;
          if (j < 4) w = a.in[16][((size_t)l * 1024 + k) * 4 + j]; else if (j >= 16) w = a.in[18][((size_t)l * 1024 + k) * 32 + (j - 16)];
          w *= a.in[15][l * 1024 + k]; const unsigned hi = pk2(w, 0.f) & 0xffffu; const float rem = w - __uint_as_float(hi << 16);
          Wr[((size_t)l * 96 + j) * 1024 + k] = (bf16_t)hi; Wr[((size_t)l * 96 + 48 + j) * 1024 + k] = (bf16_t)(pk2(rem, 0.f) & 0xffffu); } }
    { float* cs = (float*)(ws + WS_CS); float* sn = (float*)(ws + WS_SN); const int* pos = (const int*)a.in[2];
      for (int c = gt; c < T * 16; c += NGT) { const int t = c >> 4, i = c & 15; const float inv = powf(10000.0f, -(float)(2 * i) / 32.0f); const float ang = (float)pos[t] * inv; cs[c] = cosf(ang); sn[c] = sinf(ang); } }
    { bf16_t* XS = (bf16_t*)(ws + WS_XS); float* rstd0 = (float*)(ws + WS_RSTD0); bf16_t* MB = (bf16_t*)(ws + WS_MEMB); float* rstdm = (float*)(ws + WS_RSTDM);
      for (int m0 = gw; m0 < T + TMEM; m0 += 2 * NGW) { f32x4 v[2][4];
#pragma unroll
          for (int q = 0; q < 2; ++q) { const int m = m0 + q * NGW; if (m < T + TMEM) { const bool ism = m >= T; const int row = ism ? m - T : m;
              const f32x4* xr = (const f32x4*)((ism ? a.in[1] : a.in[0]) + (size_t)row * DM) + lane;
#pragma unroll
              for (int j = 0; j < 4; ++j) v[q][j] = xr[64 * j]; } }
#pragma unroll
          for (int q = 0; q < 2; ++q) { const int m = m0 + q * NGW; if (m < T + TMEM) { const bool ism = m >= T; const int row = ism ? m - T : m; float s2 = 0.f;
#pragma unroll
              for (int j = 0; j < 4; ++j) s2 += (v[q][j][0] * v[q][j][0] + v[q][j][1] * v[q][j][1]) + (v[q][j][2] * v[q][j][2] + v[q][j][3] * v[q][j][3]);
              s2 = wave_sum(s2); const float rs = 1.0f / sqrtf(s2 * (1.f / DM) + EPS);
              u32x2* o8 = (u32x2*)((ism ? MB : XS) + (size_t)row * DM) + lane;
#pragma unroll
              for (int j = 0; j < 4; ++j) o8[64 * j] = (u32x2){pk2(v[q][j][0], v[q][j][1]), pk2(v[q][j][2], v[q][j][3])};
              if (lane == 0) (ism ? rstdm : rstd0)[row] = rs; } } } }
}

__device__ __forceinline__ void attn_phase(const Frame& F0, unsigned char* ws, bool mla, const bf16_t* QC, int ldqc) {
    const Frame F = phase_frame(F0);
    const bf16_t* Q = (const bf16_t*)(ws + WS_Q); const bf16_t* KN = (const bf16_t*)(ws + WS_KN); const bf16_t* KR = (const bf16_t*)(ws + WS_KROPE); const bf16_t* V = (const bf16_t*)(ws + WS_V);
    const bf16_t* MKV = (const bf16_t*)(ws + WS_MEMKV); bf16_t* CC = (bf16_t*)(ws + WS_CONCAT);
    if (mla) {
        for (int i = 0; i < 6; ++i) { const int pidx = i * F.G + F.vcu; if (pidx >= NB * NHEAD * 4) break; const int bh = pidx >> 2, pr = pidx & 3, b = bh / NHEAD, h = bh % NHEAD;
#pragma unroll 1
            for (int k = 0; k < 2; ++k) { const int qb = k == 0 ? 7 - pr : pr; const size_t row0 = (size_t)b * SEQ, q0 = row0 + (size_t)qb * 256;
                att::attn_unit<96, true>(F.lds, Q + q0 * QW + h * DQK, QW, KN + row0 * KVW + h * 64, KVW, KR + row0 * 32, 32, V + row0 * KVW + h * 64, KVW, CC + q0 * DM + h * 64, DM, 4 * (qb + 1), F.wave, F.lane, (const float*)(ws + WS_CS) + q0 * 16, (const float*)(ws + WS_SN) + q0 * 16); } }
    }
    for (int i = 0; i < 4; ++i) { const int uidx = i * F.G + F.vcu; if (uidx >= NB * 4 * 8) break; const int qb = uidx & 7, h = (uidx >> 3) & 3, b = uidx >> 5; const size_t q0 = (size_t)b * SEQ + (size_t)qb * 256;
        att::attn_unit<64, false>(F.lds, QC + q0 * ldqc + h * 64, ldqc, MKV + (size_t)b * MEML * 512 + h * 64, 512, nullptr, 0, MKV + (size_t)b * MEML * 512 + 256 + h * 64, 512, CC + q0 * DM + 768 + h * 64, DM, 4, F.wave, F.lane); }
}

__device__ __forceinline__ void router_phase(const Frame& F0, const Args& a, int layer) {
    const Frame F = phase_frame(F0);
    unsigned char* ws = a.ws; const bf16_t* XS = (const bf16_t*)(ws + WS_XS); const bf16_t* Wr = (const bf16_t*)(ws + WS_WR) + (size_t)layer * 96 * 1024;
    float* tokw = (float*)(ws + WS_TOKW); float* tokr = (float*)(ws + WS_TOKR); int* list = (int*)(ws + WS_LIST); unsigned* cnt = F.ctl + CW_CNT + layer * 128;
    const float* brg = a.in[17] + layer * 4; const float* bre = a.in[19] + layer * 32;
    const int lane = F.lane, fr = lane & 15, fq = lane >> 4, wid = F.wave;
    constexpr int WP = 520;
    LAS bf16_t* Bs = (LAS bf16_t*)F.lds;
    LAS float* LG = (LAS float*)F.lds;
    for (int blk = F.vcu; blk < T / 256; blk += F.G) {
        const int row0 = blk * 256 + wid * 32;
        f32x4 acc[2][6]; float ssq[2] = {0.f, 0.f};
#pragma unroll
        for (int mt = 0; mt < 2; ++mt)
#pragma unroll
            for (int i = 0; i < 6; ++i) acc[mt][i] = (f32x4){0.f, 0.f, 0.f, 0.f};
        for (int kc = 0; kc < 2; ++kc) {
            __syncthreads();
            for (int c = F.tid; c < 96 * 64; c += 512) { const int n = c >> 6, ch = c & 63; *(LAS u32x4*)(Bs + n * WP + ch * 8) = *(const u32x4*)(Wr + (size_t)n * 1024 + kc * 512 + ch * 8); }
            __syncthreads();
#pragma unroll
            for (int kb8 = 0; kb8 < 2; ++kb8) {
                bf16x8 af[8][2];
#pragma unroll
                for (int k8 = 0; k8 < 8; ++k8)
#pragma unroll
                    for (int mt = 0; mt < 2; ++mt) af[k8][mt] = *(const bf16x8*)(XS + (size_t)(row0 + mt * 16 + fr) * DM + kc * 512 + (kb8 * 8 + k8) * 32 + fq * 8);
                asm volatile("" ::: "memory");
#pragma unroll
                for (int k8 = 0; k8 < 8; ++k8) { const int ks = kb8 * 8 + k8;
#pragma unroll
                    for (int mt = 0; mt < 2; ++mt) {
#pragma unroll
                        for (int j = 0; j < 8; ++j) { const float x = __uint_as_float(((unsigned)(unsigned short)af[k8][mt][j]) << 16); ssq[mt] += x * x; } }
#pragma unroll
                    for (int i = 0; i < 6; ++i) { const bf16x8 bfr = *(const LAS bf16x8*)(Bs + (i * 16 + fr) * WP + ks * 32 + fq * 8);
#pragma unroll
                        for (int mt = 0; mt < 2; ++mt) acc[mt][i] = __builtin_amdgcn_mfma_f32_16x16x32_bf16(bfr, af[k8][mt], acc[mt][i], 0, 0, 0); }
                }
            }
        }
        __syncthreads();
#pragma unroll
        for (int mt = 0; mt < 2; ++mt) { float s = ssq[mt]; s += __shfl_xor(s, 16); s += __shfl_xor(s, 32); const float rs = 1.0f / sqrtf(s * (1.f / DM) + EPS); const int lr = wid * 32 + mt * 16 + fr;
#pragma unroll
            for (int i = 0; i < 3; ++i) { const f32x4 v = (acc[mt][i] + acc[mt][i + 3]) * rs;
#pragma unroll
                for (int j = 0; j < 4; ++j) LG[lr * 49 + 16 * i + 4 * fq + j] = v[j]; }
            if (fq == 0) LG[lr * 49 + 48] = rs; }
        __syncthreads();
        if (F.tid < 256) { const int tok = blk * 256 + F.tid; const LAS float* lg = LG + F.tid * 49;
            float g[4]; int gs = 0; float gm;
#pragma unroll
            for (int j = 0; j < 4; ++j) g[j] = lg[j] + brg[j];
            gm = g[0];
#pragma unroll
            for (int j = 1; j < 4; ++j) if (g[j] > gm) { gm = g[j]; gs = j; }
            float den = 0.f;
#pragma unroll
            for (int j = 0; j < 4; ++j) den += __expf(g[j] - gm);
            const float gate = 1.0f / den;
            float e[8];
#pragma unroll
            for (int j = 0; j < 8; ++j) e[j] = lg[16 + gs * 8 + j] + bre[gs * 8 + j];
            int i1 = 0; float m1 = e[0];
#pragma unroll
            for (int j = 1; j < 8; ++j) if (e[j] > m1) { m1 = e[j]; i1 = j; }
            int i2 = -1; float m2 = -INFINITY;
#pragma unroll
            for (int j = 0; j < 8; ++j) if (j != i1 && e[j] > m2) { m2 = e[j]; i2 = j; }
            const float w1 = gate / (1.0f + __expf(m2 - m1)), w2 = gate - w1;
            const int elo = i1 < i2 ? i1 : i2, ehi = i1 < i2 ? i2 : i1; const float wlo = i1 < i2 ? w1 : w2, whi = i1 < i2 ? w2 : w1;
            const int pidx = elo * 7 - (elo * (elo - 1)) / 2 + (ehi - elo - 1);
            const int b = gs * 28 + pidx;
            tokw[(size_t)tok * 2] = wlo; tokw[(size_t)tok * 2 + 1] = whi; tokr[tok] = lg[48];
            const unsigned pos = atomicAdd(cnt + b, 1u);
            list[(size_t)b * CAP + pos] = tok;
        }
        __syncthreads();
    }
}
__device__ __forceinline__ void moe_table(const Frame& F0, int layer) {
    const Frame F = phase_frame(F0);
    LAS int* tab = (LAS int*)(F.lds + L_TAB); const unsigned* cnt = F.ctl + CW_CNT + layer * 128;
    if (F.tid < NBUCKET) tab[128 + F.tid] = (int)__hip_atomic_load(cnt + F.tid, __ATOMIC_RELAXED, __HIP_MEMORY_SCOPE_AGENT);
    __syncthreads();
    if (F.tid == 0) { int s = 0; for (int b = 0; b < NBUCKET; ++b) { tab[b] = s; s += (tab[128 + b] + 255) >> 8; } tab[NBUCKET] = s; }
    __syncthreads();
}

__device__ __forceinline__ void pool_diff_phase(const Frame& F0, unsigned char* ws) {
    const Frame F = phase_frame(F0);
    const bf16_t* Z = (const bf16_t*)(ws + WS_Z); bf16_t* CC = (bf16_t*)(ws + WS_CONCAT);
    constexpr int SR = 64, HALO = 15, LROW = 1552;
    for (int strip = F.vcu; strip < T / SR; strip += F.G) {
        const int t0 = strip * SR, s0 = t0 & (SEQ - 1), hl = min(HALO, s0);
        __syncthreads();
        for (int c = F.tid; c < (SR + hl) * 96; c += 512) { const int rr = c / 96, ch = c % 96;
            *(LAS u32x4*)(F.lds + (size_t)(rr + HALO - hl) * LROW + ch * 16) = *(const u32x4*)(Z + (size_t)(t0 - hl + rr) * DM + ch * 8); }
        __syncthreads();
        for (int c = F.tid; c < SR * 96; c += 512) { const int rr = c / 96, q = c % 96, g = q / 24, ch = q % 24; const int t = t0 + rr;
            const int win = 2 << g, n = min(s0 + rr + 1, win); float acc[8] = {0.f, 0.f, 0.f, 0.f, 0.f, 0.f, 0.f, 0.f}; float own[8] = {0.f, 0.f, 0.f, 0.f, 0.f, 0.f, 0.f, 0.f};
            const LAS unsigned char* base = F.lds + (size_t)(rr + HALO) * LROW + q * 16;
            for (int j = 0; j < n; ++j) { const u32x4 w = *(const LAS u32x4*)(base - (size_t)j * LROW);
                const float x[8] = {bflo(w.x), bfhi(w.x), bflo(w.y), bfhi(w.y), bflo(w.z), bfhi(w.z), bflo(w.w), bfhi(w.w)};
#pragma unroll
                for (int k = 0; k < 8; ++k) { acc[k] += x[k]; if (j == 0) own[k] = x[k]; } }
            const float inv = 1.0f / (float)n;
            *(u32x4*)(CC + (size_t)t * DM + q * 8) = (u32x4){pk2(acc[0] * inv - own[0], acc[1] * inv - own[1]), pk2(acc[2] * inv - own[2], acc[3] * inv - own[3]), pk2(acc[4] * inv - own[4], acc[5] * inv - own[5]), pk2(acc[6] * inv - own[6], acc[7] * inv - own[7])}; }
    }
    __syncthreads();
}
__device__ __forceinline__ void final_phase(const Frame& F0, const Args& a) {
    const Frame F = phase_frame(F0);
    const bf16_t* XS = (const bf16_t*)(a.ws + WS_XS); const float* gf = a.in[23];
    const int gw = F.vcu * 8 + F.wave, NGW = F.G * 8, lane = F.lane;
    f32x4 gv[4];
#pragma unroll
    for (int j = 0; j < 4; ++j) gv[j] = *((const f32x4*)gf + lane + 64 * j);
    for (int m = gw; m < T; m += NGW) { const u32x2* xr = (const u32x2*)(XS + (size_t)m * DM) + lane; f32x4 v[4]; float s2 = 0.f;
#pragma unroll
        for (int j = 0; j < 4; ++j) { const u32x2 w = xr[64 * j]; v[j] = (f32x4){bflo(w.x), bfhi(w.x), bflo(w.y), bfhi(w.y)}; s2 += (v[j][0] * v[j][0] + v[j][1] * v[j][1]) + (v[j][2] * v[j][2] + v[j][3] * v[j][3]); }
        s2 = wave_sum(s2); const float rs = 1.0f / sqrtf(s2 * (1.f / DM) + EPS);
        f32x4* o = (f32x4*)(a.out + (size_t)m * DM) + lane;
#pragma unroll
        for (int j = 0; j < 4; ++j) o[64 * j] = v[j] * rs * gv[j]; }
}

#ifndef PHASE_MASK
#define PHASE_MASK 0xFFFFFFFFu
#endif
#define PH(n) ((PHASE_MASK >> (n)) & 1u)
__global__ void __launch_bounds__(512, 2) fwd_kernel(Args args) {
    extern __shared__ __attribute__((aligned(16))) unsigned char lds_raw[];
    Frame F; F.lds = (LAS unsigned char*)lds_raw; F.tid = threadIdx.x; F.lane = F.tid & 63; F.wave = __builtin_amdgcn_readfirstlane(F.tid >> 6);
    F.G = gridDim.x; { const int bx = blockIdx.x; F.vcu = (F.G % 8 == 0) ? (bx % 8) * (F.G / 8) + bx / 8 : bx; }
    unsigned char* ws = args.ws; F.ctl = (unsigned*)(ws + WS_CTL);
    for (int u = F.tid; u < (LDS_BYTES - RING_BYTES) / 4; u += 512) ((LAS unsigned*)(F.lds + RING_BYTES))[u] = 0u;
    __syncthreads();
    XcdBarrier bar = xcd_barrier_post(F.ctl + CW_BAR, (volatile LAS unsigned*)(F.lds + L_MISC) + 8);
    LAS unsigned char* listbuf = F.lds + L_LIST;
    const float qcscale = 0.125f * LOG2E;
    const float qscale = 0.10206207261596577f * LOG2E;

    if (PH(0)) p0_prologue(F, args);
    xcd_barrier(bar);
    if (PH(1)) {   SchedPlain S; S.o.init(TMEM / 256, 2, F.G, (int)blockIdx.x); S.A = (const char*)(ws + WS_MEMB); S.B = (const char*)(ws + WS_WMEM); S.a_tile = 256 * 2048; S.b_tile = 256 * 2048;
        EpiRowScale E{(bf16_t*)(ws + WS_MEMKV), 512, (const float*)(ws + WS_RSTDM)};
        pg8::gemm_run<EpiRowScale, SchedPlain, false>(F.lds, listbuf, S, E, 16, 1 << 30, 2048u, 2048u); }
    if (PH(2)) {   SchedPlain S; S.o.init(T / 256, 3, F.G, (int)blockIdx.x); S.A = (const char*)(ws + WS_XS); S.B = (const char*)(ws + WS_WINA); S.a_tile = 256 * 2048; S.b_tile = 256 * 2048;
        EpiInA E{(const float*)(ws + WS_RSTD0), (bf16_t*)(ws + WS_QLAT), (bf16_t*)(ws + WS_QC), (bf16_t*)(ws + WS_KVLAT), (bf16_t*)(ws + WS_KROPE), (float*)(ws + WS_SSQQ), (float*)(ws + WS_SSQKV),
                 (const float*)(ws + WS_CS), (const float*)(ws + WS_SN), qcscale};
        pg8::gemm_run<EpiInA, SchedPlain, false>(F.lds, listbuf, S, E, 16, 1 << 30, 2048u, 2048u); }
    xcd_barrier(bar);
    if (PH(3)) {   SchedQKV S; S.o.init(T / 256, 11, F.G, (int)blockIdx.x); S.Aq = (const char*)(ws + WS_QLAT); S.Akv = (const char*)(ws + WS_KVLAT); S.B = (const char*)(ws + WS_WQKV);
        EpiQKV E{(const float*)(ws + WS_SSQQ), (const float*)(ws + WS_SSQKV), (bf16_t*)(ws + WS_Q), (bf16_t*)(ws + WS_KN), (bf16_t*)(ws + WS_V), qscale};
        pg8::gemm_run<EpiQKV, SchedQKV, false>(F.lds, listbuf, S, E, 4, 1 << 30, 512u, 512u); }
    xcd_barrier(bar);
#pragma unroll 1
    for (int layer = 0; layer < 2; ++layer) {
        { size_t zoff = 0; asm volatile("" : "+s"(zoff)); ws = args.ws + zoff; }
        if (layer == 0) {
            if (PH(4)) attn_phase(F, ws, true, (const bf16_t*)(ws + WS_QC), 256);
            xcd_barrier(bar);
        } else {
            if (PH(5)) {   SchedPlain S; S.o.init(T / 256, 4, F.G, (int)blockIdx.x); S.A = (const char*)(ws + WS_XS); S.B = (const char*)(ws + WS_WINP); S.a_tile = 256 * 2048; S.b_tile = 256 * 2048;
                EpiInP E{(const float*)(ws + WS_SSQX), (bf16_t*)(ws + WS_Z), qcscale};
                pg8::gemm_run<EpiInP, SchedPlain, false>(F.lds, listbuf, S, E, 16, 1 << 30, 2048u, 2048u); }
            xcd_barrier(bar);
            if (PH(6)) pool_diff_phase(F, ws);
            if (PH(7)) attn_phase(F, ws, false, (const bf16_t*)(ws + WS_Z) + 768, 1024);
            xcd_barrier(bar);
        }
        if (PH(9)) {   SchedPlain S; S.o.init(T / 256, 4, F.G, (int)blockIdx.x); S.A = (const char*)(ws + WS_CONCAT); S.B = (const char*)(ws + WS_WO) + (size_t)layer * 2097152; S.a_tile = 256 * 2048; S.b_tile = 256 * 2048;
            EpiWo E{(bf16_t*)(ws + WS_XS)};
            pg8::gemm_run<EpiWo, SchedPlain, false>(F.lds, listbuf, S, E, 16, 1 << 30, 2048u, 2048u); }
        xcd_barrier(bar);
        if (PH(10)) router_phase(F, args, layer);
        xcd_barrier(bar);
        moe_table(F, layer);
        if (PH(11)) {   SchedMoe<false> S{(const LAS int*)(F.lds + L_TAB), F.G, F.vcu, (const char*)(ws + WS_XS), (const char*)(ws + WS_WGU) + (size_t)layer * (32u * 512u * 2048u), (const int*)(ws + WS_LIST)};
            EpiMoeUp E{(const float*)(ws + WS_TOKR), (const float*)(ws + WS_TOKW), (bf16_t*)(ws + WS_ACT)};
            pg8::gemm_run<EpiMoeUp, SchedMoe<false>, true>(F.lds, listbuf, S, E, 16, 1 << 30, 2048u, 2048u); }
        xcd_barrier(bar);
        if (PH(12)) {   SchedMoe<true> S{(const LAS int*)(F.lds + L_TAB), F.G, F.vcu, (const char*)(ws + WS_ACT), (const char*)(ws + WS_WD) + (size_t)layer * (4u * 1024u * 4096u), (const int*)(ws + WS_LIST)};
            EpiMoeDown E{(bf16_t*)(ws + WS_XS), (float*)(ws + WS_SSQX)};
            pg8::gemm_run<EpiMoeDown, SchedMoe<true>, false>(F.lds, listbuf, S, E, 8, 4, 1024u, 4096u); }
        xcd_barrier(bar);
    }
    if (PH(13)) final_phase(F, args);
}

extern "C" void kernel_launch(void* const* d_in, const int* in_sizes, int n_in, void* d_out, int out_size, void* d_ws, size_t ws_size, hipStream_t stream) {
    static int grid = 0;
    if (grid == 0) {
        if (n_in != 24 || in_sizes[0] != T * DM || out_size != T * DM || ws_size < WS_END) { fprintf(stderr, "kernel_launch: unexpected shapes (n_in %d, in0 %d, out %d, ws %zu); nothing launched\n", n_in, n_in > 0 ? in_sizes[0] : -1, out_size, ws_size); grid = -1; return; }
        int dev = 0, cus = 0, per_cu = 0;
        if (hipGetDevice(&dev) != hipSuccess || hipDeviceGetAttribute(&cus, hipDeviceAttributeMultiprocessorCount, dev) != hipSuccess) { grid = -1; return; }
        if (hipFuncSetAttribute((const void*)fwd_kernel, hipFuncAttributeMaxDynamicSharedMemorySize, LDS_BYTES) != hipSuccess) { fprintf(stderr, "kernel_launch: hipFuncSetAttribute failed\n"); grid = -1; return; }
        if (hipOccupancyMaxActiveBlocksPerMultiprocessor(&per_cu, (const void*)fwd_kernel, 512, LDS_BYTES) != hipSuccess || per_cu < 1) fprintf(stderr, "kernel_launch: occupancy query reports %d\n", per_cu);
        (void)hipGetLastError();
        grid = cus;
    }
    if (grid < 0) return;
    if (hipMemsetAsync((char*)d_ws + WS_CTL, 0, CTL_ZERO_BYTES, stream) != hipSuccess) return;
    Args a{};
    for (int i = 0; i < 24; ++i) a.in[i] = (const float*)d_in[i];
    a.out = (float*)d_out; a.ws = (unsigned char*)d_ws;
    hipLaunchKernelGGL(fwd_kernel, dim3(grid), dim3(512), LDS_BYTES, stream, a);
}
```

```cpp
#include <hip/hip_runtime.h>
#include <cstdio>
#include <cstdint>

#define LAS __attribute__((address_space(3)))
#define GAS __attribute__((address_space(1)))
typedef unsigned short bf16_t;
typedef short bf16x8 __attribute__((ext_vector_type(8)));
typedef short s16x4 __attribute__((ext_vector_type(4)));
typedef float f32x2 __attribute__((ext_vector_type(2)));
typedef float f32x4 __attribute__((ext_vector_type(4)));
typedef float f32x16 __attribute__((ext_vector_type(16)));
typedef unsigned u32x2 __attribute__((ext_vector_type(2)));
typedef unsigned u32x4 __attribute__((ext_vector_type(4)));
typedef __bf16 bf16x2_t __attribute__((ext_vector_type(2)));

constexpr int T = 65536, DM = 1024, SEQ = 2048, NB = 32, MEML = 256, TMEM = NB * MEML;
constexpr int NHEAD = 12, DQK = 96, DV = 64, QW = NHEAD * DQK  , KVW = NHEAD * DV  ;
constexpr float EPS = 1e-6f;
constexpr int NBUCKET = 112, CAP = 65536;
constexpr float LOG2E = 1.4426950408889634f;

constexpr size_t MiB = 1u << 20;
constexpr size_t WS_CTL = 0, CTL_ZERO_BYTES = 64 * 1024;
constexpr size_t WS_WINA = 1 * MiB;
constexpr size_t WS_WQKV = 3 * MiB;
constexpr size_t WS_WINP = 5 * MiB;
constexpr size_t WS_WMEM = 8 * MiB;
constexpr size_t WS_WO = 9 * MiB;
constexpr size_t WS_WR = 13 * MiB;
constexpr size_t WS_WGU = 14 * MiB;
constexpr size_t WS_WD = 78 * MiB;
constexpr size_t WS_XS = 110 * MiB;
constexpr size_t WS_RSTD0 = 238 * MiB;
constexpr size_t WS_RSTDM = 238 * MiB + 512 * 1024;
constexpr size_t WS_CS = 239 * MiB, WS_SN = 243 * MiB;
constexpr size_t WS_MEMB = 247 * MiB;
constexpr size_t WS_MEMKV = 263 * MiB;
constexpr size_t WS_SSQQ = 271 * MiB, WS_SSQKV = 272 * MiB, WS_SSQX = 273 * MiB;
constexpr size_t WS_TOKW = 277 * MiB;
constexpr size_t WS_TOKR = 278 * MiB;
constexpr size_t WS_KROPE = 279 * MiB;
constexpr size_t WS_LIST = 283 * MiB;
constexpr size_t WS_QLAT = 311 * MiB, WS_QC = 343 * MiB, WS_KVLAT = 375 * MiB;
constexpr size_t WS_ACT = 311 * MiB;
constexpr size_t WS_Q = 407 * MiB, WS_KN = 551 * MiB, WS_V = 647 * MiB;
constexpr size_t WS_Z = 407 * MiB;
constexpr size_t WS_CONCAT = 743 * MiB;
constexpr size_t WS_END = 871 * MiB;
constexpr int CW_BAR = 4096, CW_CNT = 8192;

constexpr int RING_BYTES = 147456;
constexpr int L_MISC = RING_BYTES, L_LIST = RING_BYTES + 256, L_TAB = RING_BYTES + 256 + 2048, LDS_BYTES = RING_BYTES + 4096;

__device__ __forceinline__ unsigned pk2(float lo, float hi) { f32x2 v = {lo, hi}; bf16x2_t b = __builtin_convertvector(v, bf16x2_t); return __builtin_bit_cast(unsigned, b); }
__device__ __forceinline__ float bflo(unsigned w) { return __uint_as_float(w << 16); }
__device__ __forceinline__ float bfhi(unsigned w) { return __uint_as_float(w & 0xffff0000u); }
__device__ __forceinline__ u32x4 pack8(f32x4 a, f32x4 b) { u32x4 w; w.x = pk2(a[0], a[1]); w.y = pk2(a[2], a[3]); w.z = pk2(b[0], b[1]); w.w = pk2(b[2], b[3]); return w; }
__device__ __forceinline__ float wave_sum(float v) {
#pragma unroll
    for (int o = 1; o < 64; o <<= 1) v += __shfl_xor(v, o);
    return v;
}
#define LDS_WAIT() asm volatile("s_waitcnt lgkmcnt(0)" ::: "memory")
__device__ __forceinline__ int hw_lane() { int l; asm volatile("v_mbcnt_lo_u32_b32 %0, -1, 0\n\tv_mbcnt_hi_u32_b32 %0, -1, %0" : "=v"(l)); return l; }
#define VM_WAIT() asm volatile("s_waitcnt vmcnt(0)" ::: "memory")

#define XB_TMO      128
#define XB_XCNT(j)  (256  + 64 * (j))
#define XB_XSUB(j)  (1280 + 64 * (j))
#define XB_XGEN(j)  (2304 + 64 * (j))
#define XB_TOP      3328
#define XB_TOPGEN   3392
#define XCD_BAR_WORDS 3456
#define XB_SPIN_CAP (1u << 18)
__device__ __forceinline__ unsigned xb_ld(unsigned* p)              { return __hip_atomic_load(p, __ATOMIC_RELAXED, __HIP_MEMORY_SCOPE_AGENT); }
__device__ __forceinline__ unsigned xb_add(unsigned* p, unsigned v) { return __hip_atomic_fetch_add(p, v, __ATOMIC_RELAXED, __HIP_MEMORY_SCOPE_AGENT); }
__device__ __forceinline__ unsigned xb_xcc_id() { return (unsigned)__builtin_amdgcn_s_getreg((3 << 11) | 20) & 0xFu; }
#define XB_SPIN(cond, bar) do { unsigned _sp = 0; while (cond) { __builtin_amdgcn_s_sleep(1); \
    if ((++_sp & 255u) == 0u) { if (xb_ld(&(bar)[XB_TMO])) break; if (_sp > XB_SPIN_CAP) { atomicAdd(&(bar)[XB_TMO], 1u); break; } } } } while (0)
struct XcdBarrier { unsigned* bar; unsigned x; volatile LAS unsigned* st; int w; };
__device__ __forceinline__ XcdBarrier xcd_barrier_post(unsigned* bar, volatile LAS unsigned* st, int wave) {
    XcdBarrier b; b.bar = bar; b.x = xb_xcc_id(); b.st = st; b.w = wave;
    if (threadIdx.x == 0) (void)xb_add(&bar[XB_XCNT(b.x)], 1u);
    return b;
}
__device__ __forceinline__ void xcd_barrier_complete(unsigned* bar, unsigned x, unsigned& nloc, unsigned& nx) {
    const unsigned G = gridDim.x * gridDim.y * gridDim.z;
    unsigned sum, cnt, mine, sp = 0u;
    for (;;) {
        sum = 0u; cnt = 0u; mine = 0u;
#pragma unroll
        for (unsigned j = 0; j < 16; ++j) { const unsigned c = xb_ld(&bar[XB_XCNT(j)]); sum += c; cnt += (c > 0u) ? 1u : 0u; mine = (j == x) ? c : mine; }
        if (sum == G) break;
        __builtin_amdgcn_s_sleep(1);
        if ((++sp & 255u) == 0u) { if (xb_ld(&bar[XB_TMO])) break; if (sp > XB_SPIN_CAP) { atomicAdd(&bar[XB_TMO], 1u); break; } }
    }
    nloc = mine > 0u ? mine : 1u; nx = cnt > 0u ? cnt : 1u;
}
__device__ __forceinline__ void xcd_barrier(const XcdBarrier& b) {
    asm volatile("s_waitcnt vmcnt(0)" ::: "memory");
    __syncthreads();
    if (b.w == 0 && hw_lane() == 0) {
        unsigned zoff = 0u; asm volatile("" : "+s"(zoff));
        unsigned* bar = b.bar + zoff;
        __builtin_amdgcn_s_waitcnt(0);
        const unsigned bx = xb_xcc_id();
        unsigned nloc = b.st[0], nx = b.st[1];
        if (nloc == 0u) { xcd_barrier_complete(bar, bx, nloc, nx); b.st[0] = nloc; b.st[1] = nx; }
        const unsigned old = xb_add(&bar[XB_XSUB(bx)], 1u);
        const unsigned gen = old / nloc;
        if (old + 1u == (gen + 1u) * nloc) {
            __builtin_amdgcn_fence(__ATOMIC_RELEASE, "agent");
            asm volatile("s_waitcnt vmcnt(0)" ::: "memory");
            const unsigned og = xb_add(&bar[XB_TOP], 1u);
            const unsigned tg = og / nx;
            if (og + 1u == (tg + 1u) * nx) xb_add(&bar[XB_TOPGEN], 1u);
            else XB_SPIN(xb_ld(&bar[XB_TOPGEN]) == tg, bar);
            __builtin_amdgcn_fence(__ATOMIC_ACQUIRE, "agent");
            xb_add(&bar[XB_XGEN(bx)], 1u);
            asm volatile("s_waitcnt vmcnt(0)" ::: "memory");
        } else {
            XB_SPIN(xb_ld(&bar[XB_XGEN(bx)]) == gen, bar);
            __builtin_amdgcn_fence(__ATOMIC_ACQUIRE, "agent");
            asm volatile("s_waitcnt vmcnt(0)" ::: "memory");
        }
    }
    __syncthreads();
}

namespace pg8 {
constexpr int BM = 256, BK = 64, HALF = 128, HTB = HALF * BK * 2, NXCD = 8, WGM = 8;
__host__ __device__ __forceinline__ int lds_byte(int r, int c) { const int st = (r >> 4) * 2 + (c >> 5), rr = r & 15, cc = c & 31, ob = rr * 64 + cc * 2; return st * 1024 + (ob ^ (((ob >> 9) & 1) << 5)); }
__host__ __device__ __forceinline__ void stage_rc(int b, int& R, int& C) { const int st = b / 1024, sb = b % 1024, swz = sb ^ (((sb >> 9) & 1) << 5); R = (st >> 1) * 16 + swz / 64; C = (st & 1) * 32 + (swz % 64) / 2; }
__host__ __device__ __forceinline__ int perm32(int rho) { const int n = rho >> 4, i = rho & 15; return 8 * (i >> 2) + 4 * n + (i & 3); }

struct Unit { const char* A; const char* B; int bjump; int nvalid; const int* list; int pm, pn, aux; unsigned ll; int half; };

struct TileOrder {
    int nM, nN, nwg, G, c;
    __device__ __forceinline__ void init(int nM_, int nN_, int G_, int c_) { nM = nM_; nN = nN_; nwg = nM * nN; G = G_; c = c_; }
    __device__ __forceinline__ bool get(int i, int& pm, int& pn) const {
        const long L = (long)i * G + c; if (L >= nwg) return false;
        int wgid = (int)L; { const int q = nwg / NXCD, r = nwg % NXCD, xcd = wgid % NXCD, off = wgid / NXCD; wgid = (xcd < r ? xcd * (q + 1) : r * (q + 1) + (xcd - r) * q) + off; }
        const int nig = WGM * nN, gid = wgid / nig, fm = gid * WGM, gsz = (nM - fm) < WGM ? (nM - fm) : WGM;
        pm = fm + ((wgid % nig) % gsz); pn = (wgid % nig) / gsz; return true;
    }
};

template <class E_> struct epi_wants_list { template <class X> static constexpr bool get(decltype(X::LDS_LIST)*) { return X::LDS_LIST; } template <class X> static constexpr bool get(...) { return false; } static constexpr bool value = get<E_>(nullptr); };
template <class S_> struct sched_halves { template <class X> static constexpr bool get(decltype(X::HALVES)*) { return X::HALVES; } template <class X> static constexpr bool get(...) { return false; } static constexpr bool value = get<S_>(nullptr); };
template <class Epi, class Sched, bool GATHER>
__device__ __forceinline__ void gemm_run(LAS unsigned char* lds, LAS unsigned char* listbuf, const Sched& S, const Epi& E, const int nt, const int jt, const unsigned lda2, const unsigned ldb2, const int wv) {
    int tid = (wv << 6) | hw_lane(); asm volatile("" : "+v"(tid));
    const int wid = __builtin_amdgcn_readfirstlane(tid >> 6), lane = tid & 63, wr = wid >> 2, wc = wid & 3, fr = lane & 15, fq = lane >> 4;
    int Rr[2]; unsigned Cc[2], voffB[2];
#pragma unroll
    for (int i = 0; i < 2; ++i) { int R, C; stage_rc(tid * 16 + i * 8192, R, C); const int Rb = (R & ~31) + perm32(R & 31); Rr[i] = R; Cc[i] = (unsigned)C * 2u; voffB[i] = (unsigned)Rb * ldb2 + (unsigned)C * 2u; }
    const size_t kstep = (size_t)(BK * 2);
    const size_t hstepB = (size_t)HALF * ldb2;
    const size_t hstepA = GATHER ? (size_t)0 : (size_t)HALF * lda2;
    const unsigned ldsw = (unsigned)wid * 1024u;
    const int aoff = lds_byte(wr * 64 + fr, fq * 8), boff = lds_byte(wc * 32 + fr, fq * 8);
#define PG8_SB(b, h) (((b) * 2 + (h)) * HTB)
#define PG8_AB (4 * HTB)
#define PG8_STAGE(bufoff, gbase, voff) do { _Pragma("unroll") for (int _i = 0; _i < 2; ++_i) \
        __builtin_amdgcn_global_load_lds((const unsigned*)((const char*)(gbase) + (voff)[_i]), (LAS unsigned*)(lds + (bufoff) + ldsw + _i * 8192), 16, 0, 0); } while (0)
#define PG8_STAGE_A(gbase, voff) PG8_STAGE(PG8_AB + (rs == 0 ? 4 : rs - 1) * HTB, gbase, voff)
#define PG8_LDA(dst) do { const LAS unsigned char* ap_ = lds + PG8_AB + rs * HTB + aoff; _Pragma("unroll") for (int m = 0; m < 4; ++m) _Pragma("unroll") for (int k = 0; k < 2; ++k) dst[m][k] = *(const LAS bf16x8*)(ap_ + m * 2048 + k * 1024); } while (0)
#define PG8_NEXT_RS() do { rs = (rs == 4) ? 0 : rs + 1; } while (0)
#define PG8_LDB(dst, b, h) do { _Pragma("unroll") for (int n = 0; n < 2; ++n) _Pragma("unroll") for (int k = 0; k < 2; ++k) dst[n][k] = *(const LAS bf16x8*)(lds + PG8_SB(b, h) + boff + n * 2048 + k * 1024); } while (0)
#define PG8_MMA(ai, bj, At, Bt) do { __builtin_amdgcn_s_setprio(1); _Pragma("unroll") for (int m = 0; m < 4; ++m) _Pragma("unroll") for (int n = 0; n < 2; ++n) _Pragma("unroll") for (int k = 0; k < 2; ++k) \
        acc[ai][bj][m][n] = __builtin_amdgcn_mfma_f32_16x16x32_bf16(Bt[n][k], At[m][k], acc[ai][bj][m][n], 0, 0, 0); __builtin_amdgcn_s_setprio(0); } while (0)
#define PG8_WAIT_V(n) asm volatile("s_waitcnt vmcnt(" #n ")" ::: "memory")
#define PG8_WAIT_L(n) asm volatile("s_waitcnt lgkmcnt(" #n ")" ::: "memory")
#define PG8_BAR __builtin_amdgcn_s_barrier()
#define PG8_SCHED __builtin_amdgcn_sched_barrier(0)
#define PG8_BPTR(X, tt) ((X).B + (size_t)(tt) * kstep + (((tt) >= jt) ? (X).bjump : 0))
    Unit cur, nxt; int ui = 0; cur.ll = 0u; nxt.ll = 0u; cur.half = 0; nxt.half = 0;
    { const bool ok0_ = S.next(0, cur); if (!Sched::FULL && !ok0_) return; }
    unsigned offA[2][2];
#pragma unroll
    for (int h = 0; h < 2; ++h)
#pragma unroll
        for (int i = 0; i < 2; ++i) {
            const int row = h * HALF + Rr[i];
            if constexpr (GATHER) { int idx = cur.list[row]; if (row >= cur.nvalid) idx = 0; offA[h][i] = (unsigned)idx * lda2 + Cc[i]; }
            else offA[h][i] = (unsigned)Rr[i] * lda2 + Cc[i];
        }
    f32x4 acc[2][2][4][2];
#pragma unroll
    for (int a = 0; a < 2; ++a)
#pragma unroll
        for (int b = 0; b < 2; ++b)
#pragma unroll
            for (int m = 0; m < 4; ++m)
#pragma unroll
                for (int n = 0; n < 2; ++n) acc[a][b][m][n] = (f32x4){0.f, 0.f, 0.f, 0.f};
    bf16x8 At[4][2], B0[2][2], B1[2][2];
    int rs = 0;
    constexpr bool LLIST = epi_wants_list<Epi>::value;
    if constexpr (LLIST) __builtin_amdgcn_global_load_lds((const unsigned*)((const char*)cur.list + lane * 16), (LAS unsigned*)listbuf, 16, 0, 0);
    {
        const char* cA = cur.A; const char* cB = cur.B;
        PG8_STAGE(PG8_SB(0, 0), cB, voffB); PG8_STAGE(PG8_SB(0, 1), cB + hstepB, voffB); PG8_STAGE(PG8_AB, cA, offA[0]); PG8_STAGE(PG8_AB + HTB, cA + hstepA, offA[1]);
        if (wr == 1) PG8_BAR;
        PG8_WAIT_V(2); PG8_BAR;
        const char* cB1 = PG8_BPTR(cur, 1);
        PG8_STAGE(PG8_SB(1, 0), cB1, voffB); PG8_STAGE(PG8_AB + 2 * HTB, cA + kstep, offA[0]); PG8_STAGE(PG8_SB(1, 1), cB1 + hstepB, voffB); PG8_STAGE(PG8_AB + 3 * HTB, cA + kstep + hstepA, offA[1]);
        PG8_WAIT_V(8); PG8_BAR;
    }
    for (;;) {
        const bool has_next = S.next(ui + 1, nxt);
        const bool chalf = sched_halves<Sched>::value && cur.half != 0;
        const char* cA = cur.A;
        const char* nA = has_next ? nxt.A : cur.A;
        const char* nB0 = has_next ? nxt.B : cur.B;
        const char* nB1 = has_next ? PG8_BPTR(nxt, 1) : PG8_BPTR(cur, 1);
#pragma unroll 1
        for (int t = 0; t < nt; t += 2) {
            const bool last = (t == nt - 2);
            const bool thalf = sched_halves<Sched>::value && (last ? (has_next ? nxt.half != 0 : chalf) : chalf);
            const bool w6 = sched_halves<Sched>::value && (chalf || thalf);
            if constexpr (GATHER) {
                if (last && has_next) {
                    const LAS int* lb = (const LAS int*)(listbuf + ((ui + 1) & 1) * 1024);
#pragma unroll
                    for (int h = 0; h < 2; ++h)
#pragma unroll
                        for (int i = 0; i < 2; ++i) { const int row = h * HALF + Rr[i]; int idx = lb[row]; if (row >= nxt.nvalid) idx = 0; offA[h][i] = (unsigned)idx * lda2 + Cc[i]; }
                }
            }
            const char* a2 = last ? nA : cA + (size_t)(t + 2) * kstep; const char* b2 = last ? nB0 : PG8_BPTR(cur, t + 2);
            const char* a3 = a2 + kstep;                              const char* b3 = last ? nB1 : PG8_BPTR(cur, t + 3);
            PG8_LDB(B0, 0, 0); PG8_LDB(B1, 0, 1); PG8_SCHED; PG8_LDA(At); PG8_STAGE_A(a2, offA[0]);
            if (w6) PG8_WAIT_V(6); else PG8_WAIT_V(10); PG8_WAIT_L(0); PG8_BAR; PG8_MMA(0, 0, At, B0); PG8_MMA(0, 1, At, B1); PG8_BAR; PG8_SCHED; PG8_NEXT_RS();
            if constexpr (LLIST || GATHER) {
                if (t == 0 && has_next) __builtin_amdgcn_global_load_lds((const unsigned*)((const char*)nxt.list + lane * 16), (LAS unsigned*)(listbuf + ((ui + 1) & 1) * 1024), 16, 0, 0);
            }
            if (!chalf) PG8_LDA(At); PG8_STAGE(PG8_SB(0, 0), b2, voffB); PG8_STAGE(PG8_SB(0, 1), b2 + hstepB, voffB); if (!thalf) PG8_STAGE_A(a2 + hstepA, offA[1]);
            if (w6) PG8_WAIT_V(6); else PG8_WAIT_V(10); PG8_WAIT_L(0); PG8_BAR; if (!chalf) { PG8_MMA(1, 0, At, B0); PG8_MMA(1, 1, At, B1); } PG8_BAR; PG8_SCHED; PG8_NEXT_RS();
            PG8_LDB(B0, 1, 0); PG8_LDB(B1, 1, 1); PG8_SCHED; PG8_LDA(At); PG8_STAGE_A(a3, offA[0]);
            if (w6) PG8_WAIT_V(6); else PG8_WAIT_V(10); PG8_WAIT_L(0); PG8_BAR; PG8_MMA(0, 0, At, B0); PG8_MMA(0, 1, At, B1); PG8_BAR; PG8_SCHED; PG8_NEXT_RS();
            if (!chalf) PG8_LDA(At); PG8_STAGE(PG8_SB(1, 0), b3, voffB); PG8_STAGE(PG8_SB(1, 1), b3 + hstepB, voffB); if (!thalf) PG8_STAGE_A(a3 + hstepA, offA[1]);
            if (w6) PG8_WAIT_V(6); else PG8_WAIT_V(10); PG8_WAIT_L(0); PG8_BAR; if (!chalf) { PG8_MMA(1, 0, At, B0); PG8_MMA(1, 1, At, B1); } PG8_BAR; PG8_SCHED; PG8_NEXT_RS();
        }
        if (wr == 0) PG8_BAR;
        if constexpr (!Epi::AFTER_DRAIN) { int fr_ = fr, fq_ = fq; asm volatile("" : "+v"(fr_), "+v"(fq_));
            if constexpr (LLIST) cur.ll = (unsigned)(uintptr_t)(listbuf + (ui & 1) * 1024);
            E(acc, cur, wr, wc, fr_, fq_); }
        if (!has_next) break;
#pragma unroll
        for (int a = 0; a < 2; ++a)
#pragma unroll
            for (int b = 0; b < 2; ++b)
#pragma unroll
                for (int m = 0; m < 4; ++m)
#pragma unroll
                    for (int n = 0; n < 2; ++n) acc[a][b][m][n] = (f32x4){0.f, 0.f, 0.f, 0.f};
        cur = nxt; ++ui;
        if (wr == 1) PG8_BAR;
    }
    PG8_WAIT_V(0);
    PG8_BAR;
    if constexpr (Epi::AFTER_DRAIN) E.fused(acc, cur, wr, wc, fr, fq, lds);
#undef PG8_AB
#undef PG8_STAGE_A
#undef PG8_NEXT_RS
#undef PG8_SB
#undef PG8_STAGE
#undef PG8_LDA
#undef PG8_LDB
#undef PG8_MMA
#undef PG8_WAIT_V
#undef PG8_WAIT_L
#undef PG8_BAR
#undef PG8_SCHED
#undef PG8_BPTR
}
}
using pg8::Unit;

template <bool FULL_> struct SchedPlainT {
    static constexpr bool FULL = FULL_;
    pg8::TileOrder o; const char* A; const char* B; size_t a_tile, b_tile;
    __device__ __forceinline__ bool next(int i, Unit& u) const { int pm, pn; if (!o.get(i, pm, pn)) return false;
        u.A = A + (size_t)pm * a_tile; u.B = B + (size_t)pn * b_tile; u.bjump = 0; u.nvalid = 256; u.list = nullptr; u.pm = pm; u.pn = pn; u.aux = 0; return true; }
};
typedef SchedPlainT<true> SchedPlain;
typedef SchedPlainT<false> SchedPlainPart;
struct SchedOne {
    static constexpr bool FULL = true;
    const char* A; const char* B; int pm;
    __device__ __forceinline__ bool next(int i, Unit& u) const { if (i != 0) return false;
        u.A = A + (size_t)pm * (256 * 2048); u.B = B; u.bjump = 0; u.nvalid = 256; u.list = nullptr; u.pm = pm; u.pn = 0; u.aux = 0; return true; }
};
struct SchedQKV {
    static constexpr bool FULL = true;
    pg8::TileOrder o; const char* Aq; const char* Akv; const char* B;
    __device__ __forceinline__ bool next(int i, Unit& u) const { int pm, pn; if (!o.get(i, pm, pn)) return false;
        u.A = (pn < 5 ? Aq : Akv) + (size_t)pm * (256 * 512); u.B = B + (size_t)pn * (256 * 512); u.bjump = 0; u.nvalid = 256; u.list = nullptr; u.pm = pm; u.pn = pn; u.aux = 0; return true; }
};
__device__ __forceinline__ void pair_decode(int p, int& lo, int& hi) { int l = 0, rem = p; while (rem >= 7 - l) { rem -= 7 - l; ++l; } lo = l; hi = l + 1 + rem; }
template <bool DOWN> struct SchedMoe {
    static constexpr bool FULL = false;
    static constexpr bool HALVES = true;
    const LAS int* tab; int G, c; const char* A; const char* W; const int* list;
    __device__ __forceinline__ bool next(int i, Unit& u) const {
        const int nitems = tab[120]; const long L = (long)i * G + c; if (L >= (long)nitems * 4) return false;
        const int it = (int)((const LAS unsigned short*)(tab + 240))[L >> 2], tile = it & 4095, kind = it >> 12, pn = (int)(L & 3);
        int lo_ = 0, hi_ = NBUCKET - 1;
        while (lo_ < hi_) { const int mid = (lo_ + hi_ + 1) >> 1; if (tab[mid] <= tile) lo_ = mid; else hi_ = mid - 1; }
        const int b = __builtin_amdgcn_readfirstlane(lo_);
        const int tib = tile - __builtin_amdgcn_readfirstlane(tab[b]), cnt = __builtin_amdgcn_readfirstlane(tab[128 + b]);
        int elo, ehi; pair_decode(b % 28, elo, ehi); const int g = b / 28;
        int nv = min(256, cnt - tib * 256), roff = 0;
        if (kind == 2) { roff = 128; nv -= 128; }
        if (kind != 0) nv = min(nv, 128);
        u.nvalid = nv; u.list = list + (size_t)b * CAP + tib * 256 + roff; u.pm = tile; u.pn = pn; u.aux = tile * 256 + roff; u.half = kind != 0 ? 1 : 0;
        if (!DOWN) { u.A = A; u.B = W + ((size_t)(g * 8 + (pn < 2 ? elo : ehi)) * 512 + (pn & 1) * 256) * 2048; u.bjump = 0; }
        else { u.A = A + (size_t)(tile * 256 + roff) * 1024; u.B = W + (size_t)g * (1024 * 4096) + (size_t)pn * (256 * 4096) + elo * 512; u.bjump = (ehi - elo - 1) * 512; }
        return true;
    }
};

#define EPI_ROWS(ai, m) (128 * (ai) + 64 * wr + 16 * (m) + fr)
#define EPI_COL(bj) (128 * (bj) + 32 * wc + 8 * fq)
#define EPI_FENCE asm volatile("" ::: "memory")
typedef f32x4 acc_t[2][2][4][2];

struct EpiRowScale {
    static constexpr bool AFTER_DRAIN = false;
    bf16_t* O; int ldc; const float* rs;
    __device__ __forceinline__ void operator()(const acc_t& acc, const Unit& u, int wr, int wc, int fr, int fq) const {
        float sv[2][4];
#pragma unroll
        for (int ai = 0; ai < 2; ++ai)
#pragma unroll
            for (int m = 0; m < 4; ++m) sv[ai][m] = rs[u.pm * 256 + EPI_ROWS(ai, m)];
        EPI_FENCE;
#pragma unroll
        for (int ai = 0; ai < 2; ++ai)
#pragma unroll
            for (int m = 0; m < 4; ++m) { const int r = u.pm * 256 + EPI_ROWS(ai, m); const float s = sv[ai][m];
#pragma unroll
                for (int bj = 0; bj < 2; ++bj) *(u32x4*)(O + (size_t)r * ldc + u.pn * 256 + EPI_COL(bj)) = pack8(acc[ai][bj][m][0] * s, acc[ai][bj][m][1] * s); }
    }
};
__device__ __forceinline__ void rope8(f32x4& v0, f32x4& v1, f32x4 c0, f32x4 c1, f32x4 s0, f32x4 s1, int fq) {
    f32x4 p0, p1;
#pragma unroll
    for (int j = 0; j < 4; ++j) { p0[j] = __shfl_xor(v0[j], 32); p1[j] = __shfl_xor(v1[j], 32); }
    const float sg = (fq < 2) ? -1.f : 1.f;
    v0 = v0 * c0 + (p0 * s0) * sg; v1 = v1 * c1 + (p1 * s1) * sg;
}
struct EpiInA {
    static constexpr bool AFTER_DRAIN = false;
    const float* rstd0; bf16_t* qlat; bf16_t* qc; bf16_t* kvlat; bf16_t* krope; float* ssqq; float* ssqkv; const float* cs; const float* sn; float qcscale;
    __device__ __forceinline__ void operator()(const acc_t& acc, const Unit& u, int wr, int wc, int fr, int fq) const {
        float sv[2][4];
#pragma unroll
        for (int ai = 0; ai < 2; ++ai)
#pragma unroll
            for (int m = 0; m < 4; ++m) sv[ai][m] = rstd0[u.pm * 256 + EPI_ROWS(ai, m)];
        EPI_FENCE;
        const bool roper = (u.pn == 2) && (wc == 0);
#pragma unroll
        for (int ai = 0; ai < 2; ++ai)
#pragma unroll
          for (int mh = 0; mh < 2; ++mh) {
            f32x4 tc[2][4];
            if (roper) {
#pragma unroll
                for (int mm = 0; mm < 2; ++mm) { const size_t o = (size_t)(u.pm * 256 + EPI_ROWS(ai, 2 * mh + mm)) * 16 + 8 * (fq & 1);
                    tc[mm][0] = *(const f32x4*)(cs + o); tc[mm][1] = *(const f32x4*)(cs + o + 4); tc[mm][2] = *(const f32x4*)(sn + o); tc[mm][3] = *(const f32x4*)(sn + o + 4); }
            }
            EPI_FENCE;
#pragma unroll
            for (int mm = 0; mm < 2; ++mm) { const int m = 2 * mh + mm; const int r = u.pm * 256 + EPI_ROWS(ai, m); const float s = sv[ai][m];
                f32x4 v[2][2];
#pragma unroll
                for (int bj = 0; bj < 2; ++bj) { v[bj][0] = acc[ai][bj][m][0] * s; v[bj][1] = acc[ai][bj][m][1] * s; }
                if (u.pn == 0) {
                    float ss = 0.f;
#pragma unroll
                    for (int bj = 0; bj < 2; ++bj) { *(u32x4*)(qlat + (size_t)r * 256 + EPI_COL(bj)) = pack8(v[bj][0], v[bj][1]);
#pragma unroll
                        for (int n = 0; n < 2; ++n) ss += (v[bj][n][0] * v[bj][n][0] + v[bj][n][1] * v[bj][n][1]) + (v[bj][n][2] * v[bj][n][2] + v[bj][n][3] * v[bj][n][3]); }
                    ss += __shfl_xor(ss, 16); ss += __shfl_xor(ss, 32);
                    if (fq == 0) ssqq[(size_t)r * 4 + wc] = ss;
                } else if (u.pn == 1) {
#pragma unroll
                    for (int bj = 0; bj < 2; ++bj) *(u32x4*)(qc + (size_t)r * 256 + EPI_COL(bj)) = pack8(v[bj][0] * qcscale, v[bj][1] * qcscale);
                } else {
                    float ss = 0.f;
#pragma unroll
                    for (int n = 0; n < 2; ++n) ss += (v[0][n][0] * v[0][n][0] + v[0][n][1] * v[0][n][1]) + (v[0][n][2] * v[0][n][2] + v[0][n][3] * v[0][n][3]);
                    ss += __shfl_xor(ss, 16); ss += __shfl_xor(ss, 32);
                    if (fq == 0) ssqkv[(size_t)r * 4 + wc] = ss;
                    *(u32x4*)(kvlat + (size_t)r * 256 + EPI_COL(0)) = pack8(v[0][0], v[0][1]);
                    *(u32x4*)(kvlat + (size_t)r * 256 + EPI_COL(1)) = (u32x4){0u, 0u, 0u, 0u};
                    if (wc == 0) { f32x4 a = v[1][0], b = v[1][1]; rope8(a, b, tc[mm][0], tc[mm][1], tc[mm][2], tc[mm][3], fq); *(u32x4*)(krope + (size_t)r * 32 + 8 * fq) = pack8(a, b); }
                }
            }
          }
    }
};
struct EpiQKV {
    static constexpr bool AFTER_DRAIN = false;
    const float* ssqq; const float* ssqkv; bf16_t* Q; bf16_t* KN; bf16_t* V; float qscale;
    __device__ __forceinline__ void operator()(const acc_t& acc, const Unit& u, int wr, int wc, int fr, int fq) const {
        const bool isq = u.pn < 5;
        const int g32a = isq ? u.pn * 8 + wc : (u.pn - 5) * 8 + wc, g32b = g32a + 4;
        f32x4 p4[2][4];
#pragma unroll
        for (int ai = 0; ai < 2; ++ai)
#pragma unroll
            for (int m = 0; m < 4; ++m) p4[ai][m] = *(const f32x4*)((isq ? ssqq : ssqkv) + (size_t)(u.pm * 256 + EPI_ROWS(ai, m)) * 4);
        EPI_FENCE;
#pragma unroll
        for (int ai = 0; ai < 2; ++ai)
#pragma unroll
            for (int m = 0; m < 4; ++m) { const int r = u.pm * 256 + EPI_ROWS(ai, m);
                const float rs = __builtin_amdgcn_rsqf(((p4[ai][m][0] + p4[ai][m][1]) + (p4[ai][m][2] + p4[ai][m][3])) * (isq ? (1.f / 256.f) : (1.f / 128.f)) + EPS) * (isq ? qscale : 1.0f);
#pragma unroll
                for (int bj = 0; bj < 2; ++bj) {
                    const f32x4 v0 = acc[ai][bj][m][0] * rs, v1 = acc[ai][bj][m][1] * rs;
                    const int g32 = bj ? g32b : g32a;
                    if (isq) { if (g32 < 36) *(u32x4*)(Q + (size_t)r * QW + g32 * 32 + 8 * fq) = pack8(v0, v1); }
                    else { const int h = g32 >> 2, part = g32 & 3;
                        bf16_t* dst = (part < 2 ? KN : V) + (size_t)r * KVW + h * 64 + (part & 1) * 32 + 8 * fq;
                        *(u32x4*)dst = pack8(v0, v1); }
                }
            }
    }
};
struct EpiWo {
    static constexpr bool AFTER_DRAIN = false;
    bf16_t* XS; float* ssq;
    __device__ __forceinline__ void operator()(const acc_t& acc, const Unit& u, int wr, int wc, int fr, int fq) const {
#pragma unroll
        for (int ai = 0; ai < 2; ++ai)
#pragma unroll
          for (int mh = 0; mh < 2; ++mh) {
            u32x4 w[2][2];
#pragma unroll
            for (int mm = 0; mm < 2; ++mm)
#pragma unroll
                for (int bj = 0; bj < 2; ++bj) w[mm][bj] = *(const u32x4*)(XS + (size_t)(u.pm * 256 + EPI_ROWS(ai, 2 * mh + mm)) * DM + u.pn * 256 + EPI_COL(bj));
            EPI_FENCE;
#pragma unroll
            for (int mm = 0; mm < 2; ++mm) { const int m = 2 * mh + mm; const int r = u.pm * 256 + EPI_ROWS(ai, m); float ss = 0.f;
#pragma unroll
                for (int bj = 0; bj < 2; ++bj) { const u32x4 x = w[mm][bj]; const size_t off = (size_t)r * DM + u.pn * 256 + EPI_COL(bj);
                    const f32x4 a = acc[ai][bj][m][0] + (f32x4){bflo(x.x), bfhi(x.x), bflo(x.y), bfhi(x.y)}, b = acc[ai][bj][m][1] + (f32x4){bflo(x.z), bfhi(x.z), bflo(x.w), bfhi(x.w)};
                    ss += (a[0] * a[0] + a[1] * a[1]) + (a[2] * a[2] + a[3] * a[3]) + (b[0] * b[0] + b[1] * b[1]) + (b[2] * b[2] + b[3] * b[3]);
                    *(u32x4*)(XS + off) = pack8(a, b); }
                ss += __shfl_xor(ss, 16); ss += __shfl_xor(ss, 32);
                if (fq == 0) ssq[(size_t)r * 16 + u.pn * 4 + wc] = ss; }
            EPI_FENCE;
          }
    }
};
struct EpiRouter {
    static constexpr bool AFTER_DRAIN = true;
    const float* ssq; const float* brg; const float* bre; float* tokw; float* tokr; int* list; unsigned* cnt;
    __device__ __forceinline__ void operator()(const acc_t&, const Unit&, int, int, int, int) const {}
    __device__ __forceinline__ void fused(const acc_t& acc, const Unit& u, int wr, int wc, int fr, int fq, LAS unsigned char* lds) const {
        LAS float* LG = (LAS float*)lds;
        int tid = ((wr * 4 + wc) << 6) | (fq * 16 + fr); asm volatile("" : "+v"(tid));
        f32x4 pq[4] = {};
        if (tid < 256) { const f32x4* pp = (const f32x4*)(ssq + (size_t)(u.pm * 256 + tid) * 16); pq[0] = pp[0]; pq[1] = pp[1]; pq[2] = pp[2]; pq[3] = pp[3]; }
        if (wc < 3) {
#pragma unroll
            for (int ai = 0; ai < 2; ++ai)
#pragma unroll
                for (int m = 0; m < 4; ++m) { const int row = EPI_ROWS(ai, m); const f32x4 v = acc[ai][0][m][0] + acc[ai][0][m][1];
#pragma unroll
                    for (int j = 0; j < 4; ++j) LG[row * 49 + 4 * (4 * wc + fq) + j] = v[j]; }
        }
        LAS unsigned* lc = (LAS unsigned*)(lds + 256 * 49 * 4);
        if (tid < 128) lc[tid] = 0u;
        LDS_WAIT(); __builtin_amdgcn_s_barrier(); asm volatile("" ::: "memory");
        int b = 0, tok = 0; unsigned rank = 0u;
        if (tid < 256) { tok = u.pm * 256 + tid; const LAS float* lg = LG + tid * 49;
            const f32x4 s4 = (pq[0] + pq[1]) + (pq[2] + pq[3]);
            const float rs = 1.0f / sqrtf(((s4[0] + s4[1]) + (s4[2] + s4[3])) * (1.f / DM) + EPS);
            float g[4]; int gs = 0; float gm;
#pragma unroll
            for (int j = 0; j < 4; ++j) g[j] = lg[j] * rs + brg[j];
            gm = g[0];
#pragma unroll
            for (int j = 1; j < 4; ++j) if (g[j] > gm) { gm = g[j]; gs = j; }
            float den = 0.f;
#pragma unroll
            for (int j = 0; j < 4; ++j) den += __expf(g[j] - gm);
            const float gate = 1.0f / den;
            float e[8];
#pragma unroll
            for (int j = 0; j < 8; ++j) e[j] = lg[16 + gs * 8 + j] * rs + bre[gs * 8 + j];
            int i1 = 0; float m1 = e[0];
#pragma unroll
            for (int j = 1; j < 8; ++j) if (e[j] > m1) { m1 = e[j]; i1 = j; }
            int i2 = -1; float m2 = -INFINITY;
#pragma unroll
            for (int j = 0; j < 8; ++j) if (j != i1 && e[j] > m2) { m2 = e[j]; i2 = j; }
            const float w1 = gate / (1.0f + __expf(m2 - m1)), w2 = gate - w1;
            const int elo = i1 < i2 ? i1 : i2, ehi = i1 < i2 ? i2 : i1; const float wlo = i1 < i2 ? w1 : w2, whi = i1 < i2 ? w2 : w1;
            const int pidx = elo * 7 - (elo * (elo - 1)) / 2 + (ehi - elo - 1);
            b = gs * 28 + pidx;
            tokw[(size_t)tok * 2] = wlo; tokw[(size_t)tok * 2 + 1] = whi; tokr[tok] = rs;
            rank = __hip_atomic_fetch_add(lc + b, 1u, __ATOMIC_RELAXED, __HIP_MEMORY_SCOPE_WORKGROUP);
        }
        LDS_WAIT(); __builtin_amdgcn_s_barrier(); asm volatile("" ::: "memory");
        if (tid < NBUCKET) { const unsigned c = lc[tid]; lc[128 + tid] = c ? atomicAdd(cnt + tid, c) : 0u; }
        LDS_WAIT(); __builtin_amdgcn_s_barrier(); asm volatile("" ::: "memory");
        if (tid < 256) list[(size_t)b * CAP + lc[128 + b] + rank] = tok;
    }
};
struct EpiMoeUp {
    static constexpr bool AFTER_DRAIN = false;
    static constexpr bool LDS_LIST = true;
    const float* tokr; const float* tokw; bf16_t* ACT;
    __device__ __forceinline__ void operator()(const acc_t& acc, const Unit& u, int wr, int wc, int fr, int fq) const {
        int tok[2][4]; float rsv[2][4], wv[2][4];
#pragma unroll
        for (int ai = 0; ai < 2; ++ai)
#pragma unroll
            for (int m = 0; m < 4; ++m) { const int lr = EPI_ROWS(ai, m); tok[ai][m] = ((const LAS int*)u.ll)[lr < u.nvalid ? lr : 0]; }
        LDS_WAIT(); EPI_FENCE;
#pragma unroll
        for (int ai = 0; ai < 2; ++ai)
#pragma unroll
            for (int m = 0; m < 4; ++m) { rsv[ai][m] = tokr[tok[ai][m]]; wv[ai][m] = tokw[(size_t)tok[ai][m] * 2 + (u.pn >> 1)]; }
        EPI_FENCE;
#pragma unroll
        for (int ai = 0; ai < 2; ++ai) { if (ai == 1 && u.half) break;
#pragma unroll
            for (int m = 0; m < 4; ++m) { const int lr = EPI_ROWS(ai, m); const float rs = rsv[ai][m], w = wv[ai][m];
                const float c1 = -rs * LOG2E, c2 = rs * rs * w;
#pragma unroll
                for (int bj = 0; bj < 2; ++bj) { const f32x4 ag = acc[ai][bj][m][0], au = acc[ai][bj][m][1]; const f32x4 t = ag * c1; f32x4 r;
#pragma unroll
                    for (int j = 0; j < 4; ++j) r[j] = __builtin_amdgcn_rcpf(1.0f + __builtin_amdgcn_exp2f(t[j]));
                    const f32x4 a = (ag * au) * (r * c2);
                    u32x2 o; o.x = pk2(a[0], a[1]); o.y = pk2(a[2], a[3]);
                    *(u32x2*)(ACT + (size_t)(u.aux + lr) * 512 + (u.pn >> 1) * 256 + (u.pn & 1) * 128 + bj * 64 + 16 * wc + 4 * fq) = o; }
            } }
    }
};
struct EpiMoeDown {
    static constexpr bool AFTER_DRAIN = false;
    static constexpr bool LDS_LIST = true;
    bf16_t* XS; float* ssq;
    __device__ __forceinline__ void operator()(const acc_t& acc, const Unit& u, int wr, int wc, int fr, int fq) const {
        int tok[2][4];
#pragma unroll
        for (int ai = 0; ai < 2; ++ai)
#pragma unroll
            for (int m = 0; m < 4; ++m) { const int lr = EPI_ROWS(ai, m); tok[ai][m] = ((const LAS int*)u.ll)[lr < u.nvalid ? lr : 0]; }
        LDS_WAIT(); EPI_FENCE;
#pragma unroll
        for (int ai = 0; ai < 2; ++ai) { if (ai == 1 && u.half) break;
            u32x4 w[4][2];
#pragma unroll
            for (int m = 0; m < 4; ++m)
#pragma unroll
                for (int bj = 0; bj < 2; ++bj) w[m][bj] = *(const u32x4*)(XS + (size_t)tok[ai][m] * DM + u.pn * 256 + EPI_COL(bj));
            EPI_FENCE;
#pragma unroll
            for (int m = 0; m < 4; ++m) { const int lr = EPI_ROWS(ai, m); const bool ok = lr < u.nvalid; float ss = 0.f;
#pragma unroll
                for (int bj = 0; bj < 2; ++bj) { const size_t off = (size_t)tok[ai][m] * DM + u.pn * 256 + EPI_COL(bj); const u32x4 x = w[m][bj];
                    const f32x4 a = acc[ai][bj][m][0] + (f32x4){bflo(x.x), bfhi(x.x), bflo(x.y), bfhi(x.y)}, b = acc[ai][bj][m][1] + (f32x4){bflo(x.z), bfhi(x.z), bflo(x.w), bfhi(x.w)};
                    ss += (a[0] * a[0] + a[1] * a[1]) + (a[2] * a[2] + a[3] * a[3]) + (b[0] * b[0] + b[1] * b[1]) + (b[2] * b[2] + b[3] * b[3]);
                    if (ok) *(u32x4*)(XS + off) = pack8(a, b); }
                ss += __shfl_xor(ss, 16); ss += __shfl_xor(ss, 32);
                if (ok && fq == 0) ssq[(size_t)tok[ai][m] * 16 + u.pn * 4 + wc] = ss;
            }
        }
    }
};
struct EpiInP {
    static constexpr bool AFTER_DRAIN = false;
    const float* ssq; bf16_t* Z; float qcscale;
    __device__ __forceinline__ void operator()(const acc_t& acc, const Unit& u, int wr, int wc, int fr, int fq) const {
        const float cscale = (u.pn == 3) ? qcscale : 1.0f;
#pragma unroll
        for (int ai = 0; ai < 2; ++ai) {
            f32x4 p[4][4];
#pragma unroll
            for (int m = 0; m < 4; ++m) { const f32x4* pp = (const f32x4*)(ssq + (size_t)(u.pm * 256 + EPI_ROWS(ai, m)) * 16);
#pragma unroll
                for (int q = 0; q < 4; ++q) p[m][q] = pp[q]; }
            EPI_FENCE;
#pragma unroll
            for (int m = 0; m < 4; ++m) { const int r = u.pm * 256 + EPI_ROWS(ai, m);
                const f32x4 s4 = (p[m][0] + p[m][1]) + (p[m][2] + p[m][3]); const float rs = cscale * __builtin_amdgcn_rsqf(((s4[0] + s4[1]) + (s4[2] + s4[3])) * (1.f / 1024.f) + EPS);
#pragma unroll
                for (int bj = 0; bj < 2; ++bj) *(u32x4*)(Z + (size_t)r * DM + u.pn * 256 + EPI_COL(bj)) = pack8(acc[ai][bj][m][0] * rs, acc[ai][bj][m][1] * rs); }
        }
    }
};

namespace att {
__device__ __forceinline__ int crow(int r, int hi) { return (r & 3) + 8 * (r >> 2) + 4 * hi; }
__device__ __forceinline__ void glds16(const void* gsrc, unsigned lds_dst) { unsigned keep;
    asm volatile("s_mov_b32 %0, m0\n\ts_mov_b32 m0, %2\n\ts_nop 0\n\tglobal_load_lds_dwordx4 %1, off\n\ts_mov_b32 m0, %0" : "=&s"(keep) : "v"(gsrc), "s"(lds_dst) : "memory"); }
__device__ __forceinline__ void glds16s(const void* sbase, unsigned voff, unsigned lds_dst) { unsigned keep;
    asm volatile("s_mov_b32 %0, m0\n\ts_mov_b32 m0, %3\n\ts_nop 0\n\tglobal_load_lds_dwordx4 %1, %2\n\ts_mov_b32 m0, %0" : "=&s"(keep) : "v"(voff), "s"(sbase), "s"(lds_dst) : "memory"); }
__device__ __forceinline__ float max3f(float a, float b, float c) { float r; asm("v_max3_f32 %0, %1, %2, %3" : "=v"(r) : "v"(a), "v"(b), "v"(c)); return r; }
__device__ __forceinline__ float max2f(float a, float b) { float r; asm("v_max_f32_e32 %0, %1, %2" : "=v"(r) : "v"(a), "v"(b)); return r; }
struct AttU { const bf16_t* Q; const bf16_t* Kn; const bf16_t* Kr; const bf16_t* V; bf16_t* O; const float* cs; const float* sn; int NT; };
template <int DQ, bool CAUSAL>
__device__ __forceinline__ void attn_unit(LAS unsigned char* L, const AttU& U, const AttU& N, const bool first, const bool hn, const int ldq, const int ldk, const int ldkr, const int ldv, const int ldo, const int wid, u32x4 (&qr)[DQ / 16]) {
    constexpr int ND = DQ / 16, NCH = DQ / 8, KSL = NCH * 1024, LV = 4 * KSL, LWS = LV + 4 * 8192, LOST = LWS + 2048, NG = 2 * ND;
    constexpr float THR = 8.0f;
    const int NT = U.NT; const bf16_t* Kn = U.Kn; const bf16_t* Kr = U.Kr; const bf16_t* Vp = U.V; bf16_t* Ow = U.O;
    int lane = hw_lane(); asm volatile("" : "+v"(lane));
    const int r32 = lane & 31, hi = lane >> 5;
    LAS float* wsf = (LAS float*)(L + LWS) + wid * 64;
    const unsigned lds0 = (unsigned)(uintptr_t)L;
    const unsigned koff = (unsigned)(lane * ldk + wid * 8) * 2u, kroff = (unsigned)(lane * ldkr + wid * 8) * 2u, voff = (unsigned)((16 * (wid & 3) + (lane >> 2)) * ldv + (wid >> 2) * 32 + (lane & 3) * 8) * 2u;
#define ATT_DMA_KX(KB, RB, t, slot) do { \
        glds16s((KB) + (size_t)(t) * 64 * ldk, koff, (unsigned)__builtin_amdgcn_readfirstlane(lds0 + (slot) * KSL + wid * 1024)); \
        if (NCH > 8 && wid < NCH - 8) glds16s((RB) + (size_t)(t) * 64 * ldkr, kroff, (unsigned)__builtin_amdgcn_readfirstlane(lds0 + (slot) * KSL + (8 + wid) * 1024)); } while (0)
#define ATT_DMA_K(t, slot) ATT_DMA_KX(Kn, Kr, t, slot)
#define ATT_DMA_KN(t, slot) ATT_DMA_KX(N.Kn, N.Kr, t, slot)
#define ATT_DMA_VX(VB, t, slot) glds16s((VB) + (size_t)(t) * 64 * ldv, voff, (unsigned)__builtin_amdgcn_readfirstlane(lds0 + LV + (slot) * 8192 + wid * 1024))
#define ATT_DMA_V(t, slot) ATT_DMA_VX(Vp, t, slot)
#define ATT_DMA_VN(t, slot) ATT_DMA_VX(N.V, t, slot)
#define ATT_SB() __builtin_amdgcn_sched_barrier(0)
#define ATT_VFRAG(dst, vp_, i_) do { const s16x4 lo_ = __builtin_bit_cast(s16x4, __builtin_amdgcn_ds_read_tr16_b64_v4i16((LAS s16x4*)((vp_) + (((i_) >> 1) & 3) * 1024 + ((i_) & 1) * 4096))); \
        const s16x4 hh_ = __builtin_bit_cast(s16x4, __builtin_amdgcn_ds_read_tr16_b64_v4i16((LAS s16x4*)((vp_) + (((i_) >> 1) & 3) * 1024 + ((i_) & 1) * 4096 + 512))); \
        dst = (bf16x8){lo_[0], lo_[1], lo_[2], lo_[3], hh_[0], hh_[1], hh_[2], hh_[3]}; } while (0)
#define ATT_KFRAG(g, slot) (*(const LAS bf16x8*)(L + (slot) * KSL + hi * 1024 + r32 * 16 + ((g) >> 1) * 2048 + ((g) & 1) * 512))
#define ATT_Q(i) __builtin_bit_cast(bf16x8, qr[i])
#define ATT_QLOAD(X, c0, c1, s0, s1) do { \
        _Pragma("unroll") for (int d0 = 0; d0 < ND; ++d0) qr[d0] = *(const u32x4*)((X).Q + (size_t)(wid * 32 + r32) * ldq + d0 * 16 + hi * 8); \
        if constexpr (DQ == 96) { const float* cp = (X).cs + (size_t)(wid * 32 + r32) * 16 + 8 * hi; const float* sp = (X).sn + (size_t)(wid * 32 + r32) * 16 + 8 * hi; \
            c0 = *(const f32x4*)cp; c1 = *(const f32x4*)(cp + 4); s0 = *(const f32x4*)sp; s1 = *(const f32x4*)(sp + 4); } } while (0)
#define ATT_QROPE(c0, c1, s0, s1) do { if constexpr (DQ == 96) { u32x4 a = qr[4], b = qr[5]; \
        _Pragma("unroll") for (int w = 0; w < 4; ++w) { const float xa0 = bflo(a[w]), xa1 = bfhi(a[w]), xb0 = bflo(b[w]), xb1 = bfhi(b[w]); \
            const float ca = w < 2 ? c0[2 * w] : c1[2 * w - 4], cb = w < 2 ? c0[2 * w + 1] : c1[2 * w - 3], sa = w < 2 ? s0[2 * w] : s1[2 * w - 4], sb = w < 2 ? s0[2 * w + 1] : s1[2 * w - 3]; \
            a[w] = pk2(xa0 * ca - xb0 * sa, xa1 * cb - xb1 * sb); b[w] = pk2(xb0 * ca + xa0 * sa, xb1 * cb + xa1 * sb); } \
        qr[4] = a; qr[5] = b; } } while (0)
    if (first) {
        ATT_DMA_K(0, 0); ATT_DMA_V(0, 0); ATT_DMA_K(1, 1); ATT_DMA_V(1, 1); ATT_DMA_K(2, 2); ATT_DMA_K(3, 3);
        f32x4 c0 = {}, c1 = {}, s0 = {}, s1 = {}; ATT_QLOAD(U, c0, c1, s0, s1); ATT_QROPE(c0, c1, s0, s1);
    }
    f32x16 o0 = {}, o1 = {};
    float mrun = -1e30f, lrun = 0.f;
    const int vb0 = ((lane >> 4) & 1) * 32 + (lane & 3) * 8 + (4 * hi + ((lane & 15) >> 2)) * 64;
    const int qrel = wid * 32 + r32;
    const int NTw = CAUSAL ? NT - 3 + (wid >> 1) : NT;
    const int kcnt = (NCH > 8 && wid < NCH - 8) ? 2 : 1;
    if (first) asm volatile("s_waitcnt vmcnt(0) lgkmcnt(0)" ::: "memory"); else asm volatile("s_waitcnt vmcnt(4) lgkmcnt(0)" ::: "memory");
    __builtin_amdgcn_s_barrier(); asm volatile("" ::: "memory");
    bf16x8 kf[NG];
#pragma unroll
    for (int g = 0; g < NG; ++g) kf[g] = ATT_KFRAG(g, 0);
    f32x16 sA0, sA1, sB0, sB1;
    bool resc = false;
#define ATT_DECIDE(C0, C1, t, MASK) do { \
        asm volatile("s_nop 15\n\ts_nop 7" : "+v"(C0), "+v"(C1));     \
        if (MASK && (t) == NTw - 1) {                                   \
            int dq_ = qrel - (64 * ((t) - (NT - 4)) + 4 * hi); asm volatile("" : "+v"(dq_));     \
            _Pragma("unroll") for (int r = 0; r < 16; ++r) { const int kr_ = (r & 3) + 8 * (r >> 2); if (kr_ > dq_) C0[r] = -INFINITY; if (kr_ + 32 > dq_) C1[r] = -INFINITY; } } \
        float ra_ = max3f(C0[0], C0[1], C1[0]), rb_ = max3f(C0[2], C0[3], C1[1]); ra_ = max3f(ra_, C1[2], C1[3]); \
        _Pragma("unroll") for (int r = 4; r < 16; r += 4) { ra_ = max3f(ra_, C0[r], C0[r + 1]); rb_ = max3f(rb_, C0[r + 2], C0[r + 3]); ra_ = max3f(ra_, C1[r], C1[r + 1]); rb_ = max3f(rb_, C1[r + 2], C1[r + 3]); } \
        float rm_ = max2f(ra_, rb_); \
        { auto rr_ = __builtin_amdgcn_permlane32_swap(__float_as_uint(rm_), __float_as_uint(rm_), false, false); rm_ = max2f(__uint_as_float(rr_[0]), __uint_as_float(rr_[1])); } \
        resc = false; \
        if (__any(rm_ > mrun + THR)) { const float mnew_ = max2f(mrun, rm_), f_ = __builtin_amdgcn_exp2f(mrun - mnew_); mrun = mnew_; lrun *= f_; if (hi == 0) wsf[r32] = f_; resc = true; } } while (0)
#define ATT_RESC() do { if (resc) { LDS_WAIT(); _Pragma("unroll") for (int r = 0; r < 16; ++r) { const float ff_ = wsf[crow(r, hi)]; o0[r] *= ff_; o1[r] *= ff_; } } } while (0)
#define ATT_PHASE_A(C0, C1, P0, P1, vslot) do { \
        float sacc_ = 0.f; \
        _Pragma("unroll") for (int g_ = 0; g_ < NG; ++g_) { \
            if (g_ == 0) C0 = __builtin_amdgcn_mfma_f32_32x32x16_bf16(kf[0], ATT_Q(0), f32x16{}, 0, 0, 0); \
            else if (g_ == 1) C1 = __builtin_amdgcn_mfma_f32_32x32x16_bf16(kf[1], ATT_Q(0), f32x16{}, 0, 0, 0); \
            else if (g_ & 1) C1 = __builtin_amdgcn_mfma_f32_32x32x16_bf16(kf[g_], ATT_Q(g_ >> 1), C1, 0, 0, 0); else C0 = __builtin_amdgcn_mfma_f32_32x32x16_bf16(kf[g_], ATT_Q(g_ >> 1), C0, 0, 0, 0); \
            _Pragma("unroll") for (int e_ = (g_ * 32) / NG; e_ < ((g_ + 1) * 32) / NG; ++e_) { \
                sacc_ += (e_ < 16) ? P0[e_] : P1[e_ - 16]; \
                if (e_ & 1) { const int j_ = e_ >> 1; pw[j_ >> 2][j_ & 3] = (j_ < 8) ? pk2(P0[2 * j_], P0[2 * j_ + 1]) : pk2(P1[2 * j_ - 16], P1[2 * j_ - 15]); } } \
            ATT_SB(); } \
        lrun += sacc_; \
        { const LAS unsigned char* vp_ = L + LV + (vslot) * 8192 + vb0; ATT_VFRAG(vf[0], vp_, 0); ATT_VFRAG(vf[1], vp_, 1); ATT_VFRAG(vf[2], vp_, 2); ATT_VFRAG(vf[3], vp_, 3); } } while (0)
#define ATT_PHASE_B(C0, C1, kslot, vslot) do { \
        const LAS unsigned char* vp_ = L + LV + (vslot) * 8192 + vb0; \
        _Pragma("unroll") for (int i_ = 0; i_ < 8; ++i_) { \
            _Pragma("unroll") for (int g_ = (i_ * NG) / 8; g_ < ((i_ + 1) * NG) / 8; ++g_) kf[g_] = ATT_KFRAG(g_, kslot); \
            if (i_ & 1) o1 = __builtin_amdgcn_mfma_f32_32x32x16_bf16(__builtin_bit_cast(bf16x8, pw[i_ >> 1]), vf[i_ & 3], o1, 0, 0, 0); \
            else        o0 = __builtin_amdgcn_mfma_f32_32x32x16_bf16(__builtin_bit_cast(bf16x8, pw[i_ >> 1]), vf[i_ & 3], o0, 0, 0, 0); \
            if (i_ + 4 < 8) ATT_VFRAG(vf[i_ & 3], vp_, i_ + 4);        \
            _Pragma("unroll") for (int e_ = 4 * i_; e_ < 4 * i_ + 4; ++e_) { if (e_ < 16) C0[e_] = __builtin_amdgcn_exp2f(C0[e_] - mrun); else C1[e_ - 16] = __builtin_amdgcn_exp2f(C1[e_ - 16] - mrun); } \
            if (i_ < 4) asm volatile("" : "+v"(C0)); else asm volatile("" : "+v"(C1));        \
            ATT_SB(); } } while (0)
#define ATT_NDMA(t) ((((t) + 4 < NT || hn) ? kcnt : 0) + (((t) + 2 < NT || hn) ? 1 : 0))
#define ATT_END(t) do { const int nw_ = ATT_NDMA(t) + (((t) > 0) ? ATT_NDMA((t) - 1) : 0); \
        if (nw_ == 0) asm volatile("s_waitcnt vmcnt(0) lgkmcnt(0)" ::: "memory"); else if (nw_ == 1) asm volatile("s_waitcnt vmcnt(1) lgkmcnt(0)" ::: "memory"); \
        else if (nw_ == 2) asm volatile("s_waitcnt vmcnt(2) lgkmcnt(0)" ::: "memory"); else if (nw_ == 3) asm volatile("s_waitcnt vmcnt(3) lgkmcnt(0)" ::: "memory"); \
        else if (nw_ == 4) asm volatile("s_waitcnt vmcnt(4) lgkmcnt(0)" ::: "memory"); else if (nw_ == 5) asm volatile("s_waitcnt vmcnt(5) lgkmcnt(0)" ::: "memory"); \
        else asm volatile("s_waitcnt vmcnt(6) lgkmcnt(0)" ::: "memory"); \
        __builtin_amdgcn_s_barrier(); asm volatile("" ::: "memory"); } while (0)
    u32x4 pw[4]; bf16x8 vf[4];
    { asm volatile("s_waitcnt lgkmcnt(0)" ::: "memory"); __builtin_amdgcn_s_barrier(); asm volatile("" ::: "memory");
      if (4 < NT) ATT_DMA_K(4, 0); else if (hn) ATT_DMA_KN(0, 0);
      ATT_DMA_V(2, 2);
      sA0 = f32x16{}; sA1 = f32x16{};
#pragma unroll
      for (int g = 0; g < NG; ++g) { if (g & 1) sA1 = __builtin_amdgcn_mfma_f32_32x32x16_bf16(kf[g], ATT_Q(g >> 1), sA1, 0, 0, 0); else sA0 = __builtin_amdgcn_mfma_f32_32x32x16_bf16(kf[g], ATT_Q(g >> 1), sA0, 0, 0, 0); }
      if (CAUSAL && NT == 4) ATT_DECIDE(sA0, sA1, 0, 1); else ATT_DECIDE(sA0, sA1, 0, 0);
#pragma unroll
      for (int g = 0; g < NG; ++g) kf[g] = ATT_KFRAG(g, 1);
#pragma unroll
      for (int r = 0; r < 16; ++r) { sA0[r] = __builtin_amdgcn_exp2f(sA0[r] - mrun); sA1[r] = __builtin_amdgcn_exp2f(sA1[r] - mrun); }
      ATT_END(0); }
#define ATT_STEPM(C0, C1, P0, P1, t) do {         \
        ATT_DMA_K((t) + 4, (t) & 3); ATT_DMA_V((t) + 2, ((t) + 2) & 3); \
        ATT_PHASE_A(C0, C1, P0, P1, ((t) - 1) & 3); \
        ATT_DECIDE(C0, C1, t, 0); ATT_SB(); \
        ATT_PHASE_B(C0, C1, ((t) + 1) & 3, ((t) - 1) & 3); \
        if (kcnt == 2) asm volatile("s_waitcnt vmcnt(6) lgkmcnt(0)" ::: "memory"); else asm volatile("s_waitcnt vmcnt(4) lgkmcnt(0)" ::: "memory"); \
        __builtin_amdgcn_s_barrier(); asm volatile("" ::: "memory"); \
        ATT_RESC(); } while (0)
#define ATT_SDMA(t) do { if ((t) + 4 < NT) ATT_DMA_K((t) + 4, (t) & 3); else if (hn) ATT_DMA_KN((t) + 4 - NT, (t) & 3); \
        if ((t) + 2 < NT) ATT_DMA_V((t) + 2, ((t) + 2) & 3); else if (hn) ATT_DMA_VN((t) + 2 - NT, ((t) + 2) & 3); } while (0)
#define ATT_ENDT() do { if (hn) { if (kcnt == 2) asm volatile("s_waitcnt vmcnt(6) lgkmcnt(0)" ::: "memory"); else asm volatile("s_waitcnt vmcnt(4) lgkmcnt(0)" ::: "memory"); } \
        else asm volatile("s_waitcnt vmcnt(0) lgkmcnt(0)" ::: "memory");        \
        __builtin_amdgcn_s_barrier(); asm volatile("" ::: "memory"); } while (0)
#define ATT_STEPT(C0, C1, P0, P1, t) do {         \
        ATT_SDMA(t); \
        ATT_PHASE_A(C0, C1, P0, P1, ((t) - 1) & 3); \
        ATT_DECIDE(C0, C1, t, CAUSAL); ATT_SB(); \
        ATT_PHASE_B(C0, C1, ((t) + 1) & 3, ((t) - 1) & 3); \
        ATT_ENDT(); \
        ATT_RESC(); } while (0)
#define ATT_DRAIN(P0, P1, vslot) do { \
        float sacc_ = 0.f; \
        _Pragma("unroll") for (int r = 0; r < 16; ++r) sacc_ += P0[r] + P1[r]; \
        lrun += sacc_; \
        _Pragma("unroll") for (int k = 0; k < 2; ++k) { pw[k] = (u32x4){pk2(P0[8 * k], P0[8 * k + 1]), pk2(P0[8 * k + 2], P0[8 * k + 3]), pk2(P0[8 * k + 4], P0[8 * k + 5]), pk2(P0[8 * k + 6], P0[8 * k + 7])}; \
                                                  pw[2 + k] = (u32x4){pk2(P1[8 * k], P1[8 * k + 1]), pk2(P1[8 * k + 2], P1[8 * k + 3]), pk2(P1[8 * k + 4], P1[8 * k + 5]), pk2(P1[8 * k + 6], P1[8 * k + 7])}; } \
        const LAS unsigned char* vp_ = L + LV + (vslot) * 8192 + vb0; \
        _Pragma("unroll") for (int i_ = 0; i_ < 8; ++i_) { bf16x8 vv_; ATT_VFRAG(vv_, vp_, i_); \
            if (i_ & 1) o1 = __builtin_amdgcn_mfma_f32_32x32x16_bf16(__builtin_bit_cast(bf16x8, pw[i_ >> 1]), vv_, o1, 0, 0, 0); \
            else        o0 = __builtin_amdgcn_mfma_f32_32x32x16_bf16(__builtin_bit_cast(bf16x8, pw[i_ >> 1]), vv_, o0, 0, 0, 0); } } while (0)
    const int tail0 = (NT - 5 > 1) ? NT - 5 : 1;
#pragma unroll 1
    for (int t = 1; t < tail0; t += 2) {
        ATT_STEPM(sB0, sB1, sA0, sA1, t);
        ATT_STEPM(sA0, sA1, sB0, sB1, t + 1);
    }
    int t = tail0;
#pragma unroll 1
    for (; t + 1 < NTw; t += 2) {
        ATT_STEPT(sB0, sB1, sA0, sA1, t);
        ATT_STEPT(sA0, sA1, sB0, sB1, t + 1);
    }
    if (t < NTw) { ATT_STEPT(sB0, sB1, sA0, sA1, t); ++t; }
    if (CAUSAL && NTw < NT) {
        ATT_SDMA(t);
        if ((NTw - 1) & 1) ATT_DRAIN(sB0, sB1, (t - 1) & 3); else ATT_DRAIN(sA0, sA1, (t - 1) & 3);
        ATT_ENDT();
#pragma unroll 1
        for (++t; t < NT; ++t) { ATT_SDMA(t); ATT_ENDT(); }
    }
    f32x4 nc0 = {}, nc1 = {}, ns0 = {}, ns1 = {};
    if (hn) ATT_QLOAD(N, nc0, nc1, ns0, ns1);
    if (NTw == NT) ATT_DRAIN(sB0, sB1, (NT - 1) & 3);
    { int le = hw_lane(); asm volatile("" : "+v"(le)); const int r32e = le & 31, hie = le >> 5;
      LAS float* wse = (LAS float*)(L + LWS) + wid * 64;
      lrun += __shfl_xor(lrun, 32);
      if (hie == 0) wse[32 + r32e] = lrun;
      LDS_WAIT();
      bf16_t LAS* stg = (bf16_t LAS*)(L + LOST) + wid * 2048;
#pragma unroll
      for (int r = 0; r < 16; ++r) { const int orow = crow(r, hie); const float rl = __builtin_amdgcn_rcpf(wse[32 + orow]);
          stg[orow * 64 + r32e] = (bf16_t)(pk2(o0[r] * rl, 0.f) & 0xffffu); stg[orow * 64 + 32 + r32e] = (bf16_t)(pk2(o1[r] * rl, 0.f) & 0xffffu); }
      LDS_WAIT();
#pragma unroll
      for (int i = 0; i < 4; ++i) { const int row = i * 8 + (le >> 3), ch = le & 7; const u32x4 v = *(const LAS u32x4*)(stg + row * 64 + ch * 8); *(u32x4*)(Ow + (size_t)(wid * 32 + row) * ldo + ch * 8) = v; }
      asm volatile("s_waitcnt lgkmcnt(0)" ::: "memory"); __builtin_amdgcn_s_barrier(); asm volatile("" ::: "memory"); }
    if (hn) ATT_QROPE(nc0, nc1, ns0, ns1);
#undef ATT_DMA_KX
#undef ATT_DMA_KN
#undef ATT_DMA_VX
#undef ATT_DMA_VN
#undef ATT_QLOAD
#undef ATT_Q
#undef ATT_QROPE
#undef ATT_DMA_K
#undef ATT_DMA_V
#undef ATT_SB
#undef ATT_KFRAG
#undef ATT_VFRAG
#undef ATT_DECIDE
#undef ATT_RESC
#undef ATT_PHASE_A
#undef ATT_PHASE_B
#undef ATT_END
#undef ATT_NDMA
#undef ATT_STEPM
#undef ATT_SDMA
#undef ATT_ENDT
#undef ATT_STEPT
#undef ATT_DRAIN
}
}

struct Args { const float* in[24]; float* out; unsigned char* ws; };
struct Frame { LAS unsigned char* lds; unsigned* ctl; int tid, lane, wave, vcu, G; };
__device__ __forceinline__ Frame phase_frame(const Frame& F0) { Frame F = F0; int t = (F0.wave << 6) | hw_lane(); asm volatile("" : "+v"(t)); F.tid = t; F.lane = t & 63; F.wave = __builtin_amdgcn_readfirstlane(t >> 6);
    asm volatile("" : "+s"(F.vcu), "+s"(F.G));
    return F; }

struct TrD { const float* W; const float* gain; bf16_t* WT; int ldw, ldt, dcol0, rmk, rmo, k0, n0; };
__device__ __forceinline__ int tr_row(const TrD& d, int n) {
    if (d.rmk == 0) return n + d.rmo;
    if (d.rmk == 1) return n < 256 ? n : (n < 416 ? n + 256 : n - 160);
    return (n >> 2) * 8 + (n & 3) + 4 * d.rmo; }
__device__ __forceinline__ void tr_load(const TrD& d, f32x4 (&v)[8], float (&g)[8], int lane) {
    const int c4 = lane & 7, r0 = lane >> 3;
#pragma unroll
    for (int j = 0; j < 8; ++j) { const int kk = r0 + 8 * j; v[j] = *(const f32x4*)(d.W + (size_t)(d.k0 + kk) * d.ldw + d.n0 + 4 * c4); g[j] = d.gain ? d.gain[d.k0 + kk] : 1.0f; } }
__device__ __forceinline__ void tr_store(const TrD& d, const f32x4 (&v)[8], const float (&g)[8], LAS float* scr, int lane) {
    const int c4 = lane & 7, r0 = lane >> 3;
#pragma unroll
    for (int j = 0; j < 8; ++j) { const int kk = r0 + 8 * j; LAS float* p = scr + kk * 33 + 4 * c4; p[0] = v[j][0] * g[j]; p[1] = v[j][1] * g[j]; p[2] = v[j][2] * g[j]; p[3] = v[j][3] * g[j]; }
    LDS_WAIT(); asm volatile("" ::: "memory");
    const int c = lane & 7;
#pragma unroll
    for (int j = 0; j < 4; ++j) { const int n = (lane >> 3) + 8 * j; const LAS float* q = scr + (8 * c) * 33 + n;
        u32x4 o; o.x = pk2(q[0 * 33], q[1 * 33]); o.y = pk2(q[2 * 33], q[3 * 33]); o.z = pk2(q[4 * 33], q[5 * 33]); o.w = pk2(q[6 * 33], q[7 * 33]);
        *(u32x4*)(d.WT + (size_t)tr_row(d, d.n0 + n) * d.ldt + d.dcol0 + d.k0 + 8 * c) = o; }
    LDS_WAIT(); asm volatile("" ::: "memory");
}
__device__ __forceinline__ void zero16(bf16_t* p) { *(u32x4*)p = (u32x4){0u, 0u, 0u, 0u}; }

__device__ __forceinline__ TrD moe_item(const Args& a, unsigned char* ws, int r, int layer) {
    bf16_t* Wgu = (bf16_t*)(ws + WS_WGU); bf16_t* Wd = (bf16_t*)(ws + WS_WD);
    TrD d; d.gain = nullptr; d.dcol0 = 0; d.rmk = 0; d.rmo = 0;
    const int kind = r >> 12, rr = r & 4095, le = layer * 32 + (rr >> 7), q = rr & 127;
    if (kind < 2) { d.W = (kind ? a.in[21] : a.in[20]) + (size_t)le * 262144; d.ldw = 256; d.gain = a.in[15] + layer * 1024; d.WT = Wgu + (size_t)le * 524288; d.ldt = 1024; d.rmk = 2; d.rmo = kind; d.k0 = 64 * (q / 8); d.n0 = 32 * (q % 8); }
    else { const int e = le & 31;
        d.W = a.in[22] + (size_t)le * 262144; d.ldw = 1024; d.WT = Wd + ((size_t)layer * 4 + (e >> 3)) * (1024 * 2048); d.ldt = 2048; d.dcol0 = (e & 7) * 256; d.k0 = 64 * (q / 32); d.n0 = 32 * (q % 32); }
    return d; }
template <class Dec>
__device__ __forceinline__ void tr_run(int first, int count, int stride, Dec decode, LAS float* scr, int lane) {
    if (first < count) { f32x4 va[8], vb[8]; float ga[8], gb[8]; int it = first; TrD d0 = decode(it), d1 = d0; tr_load(d0, va, ga, lane);
#pragma unroll 1
        for (;;) { const int it1 = it + stride; const bool h1 = it1 < count; if (h1) { d1 = decode(it1); tr_load(d1, vb, gb, lane); }
            tr_store(d0, va, ga, scr, lane); if (!h1) break;
            it = it1 + stride; const bool h2 = it < count; if (h2) { d0 = decode(it); tr_load(d0, va, ga, lane); }
            tr_store(d1, vb, gb, scr, lane); if (!h2) break; } } }
__device__ __forceinline__ void p1_fill(const Frame& F0, const Args& a) {
    const Frame F = phase_frame(F0);
    int fb = (int)blockIdx.x, fn = F.G;
    if (F.G > 64) { if (fb < 64) return; fb -= 64; fn -= 64; }
    unsigned char* ws = a.ws;
    tr_run(fb * 8 + F.wave, 3 * 4096, fn * 8, [&](int it) -> TrD { return moe_item(a, ws, it, 1); }, (LAS float*)(F.lds + F.wave * 16384), F.lane);
    __syncthreads();
}

__device__ __forceinline__ void p0_prologue(const Frame& F0, const Args& a) {
    const Frame F = phase_frame(F0);
    unsigned char* ws = a.ws;
    LAS float* scr = (LAS float*)(F.lds + F.wave * 16384);
    const int gw = F.vcu * 8 + F.wave, NGW = F.G * 8, lane = F.lane;
    bf16_t* WinA = (bf16_t*)(ws + WS_WINA); bf16_t* Wqkv = (bf16_t*)(ws + WS_WQKV); bf16_t* WinP = (bf16_t*)(ws + WS_WINP);
    bf16_t* Wmem = (bf16_t*)(ws + WS_WMEM); bf16_t* Wo = (bf16_t*)(ws + WS_WO); bf16_t* Wgu = (bf16_t*)(ws + WS_WGU); bf16_t* Wd = (bf16_t*)(ws + WS_WD);
    constexpr int I_INA = 16 * 21, I_UQ = 4 * 36, I_UKV = 2 * 48, I_INP = 16 * 32, I_MEM = 16 * 16, I_WO = 512 + 128, I_MOE = 3 * 4096;
    constexpr int NITEMS = I_INA + I_UQ + I_UKV + I_INP + I_MEM + I_WO + I_MOE;
    auto decode = [&](int it) -> TrD { int r = it; TrD d; d.gain = nullptr; d.dcol0 = 0; d.rmk = 0; d.rmo = 0;
        if (r < I_INA) { d.W = a.in[4]; d.ldw = 672; d.gain = a.in[3]; d.WT = WinA; d.ldt = 1024; d.rmk = 1; d.k0 = 64 * (r / 21); d.n0 = 32 * (r % 21); return d; } r -= I_INA;
        if (r < I_UQ) { d.W = a.in[6]; d.ldw = 1152; d.gain = a.in[5]; d.WT = Wqkv; d.ldt = 256; d.k0 = 64 * (r / 36); d.n0 = 32 * (r % 36); return d; } r -= I_UQ;
        if (r < I_UKV) { d.W = a.in[8]; d.ldw = 1536; d.gain = a.in[7]; d.WT = Wqkv; d.ldt = 256; d.rmo = 1280; d.k0 = 64 * (r / 48); d.n0 = 32 * (r % 48); return d; } r -= I_UKV;
        if (r < I_INP) { d.W = a.in[9]; d.ldw = 1024; d.gain = a.in[3] + 1024; d.WT = WinP; d.ldt = 1024; d.k0 = 64 * (r / 32); d.n0 = 32 * (r % 32); return d; } r -= I_INP;
        if (r < I_MEM) { d.W = a.in[13]; d.ldw = 512; d.gain = a.in[12]; d.WT = Wmem; d.ldt = 1024; d.k0 = 64 * (r / 16); d.n0 = 32 * (r % 16); return d; } r -= I_MEM;
        if (r < I_WO) { const int l = r < 512 ? 0 : 1, q = r < 512 ? r : r - 512 + 12 * 32;
            d.W = a.in[14] + (size_t)l * 1048576; d.ldw = 1024; d.WT = Wo + (size_t)l * 1048576; d.ldt = 1024; d.k0 = 64 * (q / 32); d.n0 = 32 * (q % 32); return d; } r -= I_WO;
        return moe_item(a, ws, r, 0); };
    tr_run(gw, NITEMS, NGW, decode, scr, lane);
    const int gt = (F.vcu * 8 + F.wave) * 64 + lane, NGT = NGW * 64;
    for (int c = gt; c < 96 * 128; c += NGT) zero16(WinA + (size_t)672 * 1024 + (size_t)c * 8);
    for (int c = gt; c < 128 * 32; c += NGT) zero16(Wqkv + (size_t)1152 * 256 + (size_t)c * 8);
    for (int c = gt; c < 1536 * 16; c += NGT) zero16(Wqkv + (size_t)(1280 + c / 16) * 256 + 128 + (c % 16) * 8);
    for (int it = gw; it < 4 * 24 * 16; it += NGW) { const int g = it / 384, q = it % 384, c0 = 8 * (q / 16), n = 64 * (q % 16) + lane;
        const float* wg = a.in[10] + ((size_t)g * 192 + c0) * 192; const float* sc = a.in[11] + g * 192; const float* wo = a.in[14] + 1048576 + (size_t)g * 192 * 1024 + n;
        for (int e = lane; e < 384; e += 64) *(LAS f32x4*)(scr + 4 * e) = *(const f32x4*)(wg + 4 * e);
        if (lane < 48) *(LAS f32x4*)(scr + 1536 + 4 * lane) = *(const f32x4*)(sc + 4 * lane);
        LDS_WAIT(); asm volatile("" ::: "memory");
        float acc[8] = {0.f, 0.f, 0.f, 0.f, 0.f, 0.f, 0.f, 0.f};
#pragma unroll 4
        for (int d = 0; d < 192; d += 4) { const f32x4 s4 = *(const LAS f32x4*)(scr + 1536 + d);
            const f32x4 w4 = (f32x4){wo[(size_t)d * 1024] * s4[0], wo[(size_t)(d + 1) * 1024] * s4[1], wo[(size_t)(d + 2) * 1024] * s4[2], wo[(size_t)(d + 3) * 1024] * s4[3]};
#pragma unroll
            for (int i = 0; i < 8; ++i) { const f32x4 m4 = *(const LAS f32x4*)(scr + i * 192 + d); acc[i] += (m4[0] * w4[0] + m4[1] * w4[1]) + (m4[2] * w4[2] + m4[3] * w4[3]); } }
        *(u32x4*)(Wo + 1048576 + (size_t)n * 1024 + g * 192 + c0) = (u32x4){pk2(acc[0], acc[1]), pk2(acc[2], acc[3]), pk2(acc[4], acc[5]), pk2(acc[6], acc[7])};
        LDS_WAIT(); asm volatile("" ::: "memory"); }
    { bf16_t* Wr = (bf16_t*)(ws + WS_WR);
      for (int c = gt; c < 2 * 256 * 1024; c += NGT) { const int l = c >> 18, q = c & 262143, row = q >> 10, k = q & 1023; unsigned o = 0u;
          if (row < 96) { const int L = 4 * (row >> 3) + (row & 3); float w = 0.f;
              if (L < 4) w = a.in[16][((size_t)l * 1024 + k) * 4 + L]; else if (L >= 16) w = a.in[18][((size_t)l * 1024 + k) * 32 + (L - 16)];
              w *= a.in[15][l * 1024 + k]; const unsigned hi = pk2(w, 0.f) & 0xffffu; const float rem = w - __uint_as_float(hi << 16);
              o = (row & 4) ? (pk2(rem, 0.f) & 0xffffu) : hi; }
          Wr[c] = (bf16_t)o; } }
    { float* cs = (float*)(ws + WS_CS); float* sn = (float*)(ws + WS_SN); const int* pos = (const int*)a.in[2];
      for (int c = gt; c < T * 16; c += NGT) { const int t = c >> 4, i = c & 15; const float inv = powf(10000.0f, -(float)(2 * i) / 32.0f); const float ang = (float)pos[t] * inv; cs[c] = cosf(ang); sn[c] = sinf(ang); } }
    { bf16_t* XS = (bf16_t*)(ws + WS_XS); float* rstd0 = (float*)(ws + WS_RSTD0); bf16_t* MB = (bf16_t*)(ws + WS_MEMB); float* rstdm = (float*)(ws + WS_RSTDM);
      auto xload = [&](int m, f32x4 (&v)[4]) { if (m < T + TMEM) { const bool ism = m >= T; const int row = ism ? m - T : m; const f32x4* xr = (const f32x4*)((ism ? a.in[1] : a.in[0]) + (size_t)row * DM) + lane;
#pragma unroll
              for (int j = 0; j < 4; ++j) v[j] = xr[64 * j]; } };
      auto xdone = [&](int m, const f32x4 (&v)[4]) { if (m < T + TMEM) { const bool ism = m >= T; const int row = ism ? m - T : m; float s2 = 0.f;
#pragma unroll
              for (int j = 0; j < 4; ++j) s2 += (v[j][0] * v[j][0] + v[j][1] * v[j][1]) + (v[j][2] * v[j][2] + v[j][3] * v[j][3]);
              s2 = wave_sum(s2); const float rs = 1.0f / sqrtf(s2 * (1.f / DM) + EPS);
              u32x2* o8 = (u32x2*)((ism ? MB : XS) + (size_t)row * DM) + lane;
#pragma unroll
              for (int j = 0; j < 4; ++j) o8[64 * j] = (u32x2){pk2(v[j][0], v[j][1]), pk2(v[j][2], v[j][3])};
              if (lane == 0) (ism ? rstdm : rstd0)[row] = rs; } };
      f32x4 v0[4], v1[4], v2[4], v3[4];
      xload(gw, v0); xload(gw + NGW, v1); xload(gw + 2 * NGW, v2);
#pragma unroll 1
      for (int m = gw; m < T + TMEM; m += 4 * NGW) {
          xload(m + 3 * NGW, v3); xdone(m, v0);
          xload(m + 4 * NGW, v0); xdone(m + NGW, v1);
          xload(m + 5 * NGW, v1); xdone(m + 2 * NGW, v2);
          xload(m + 6 * NGW, v2); xdone(m + 3 * NGW, v3); } }
}

__device__ __forceinline__ void attn_phase(const Frame& F0, unsigned char* ws, bool mla, const bf16_t* QC, int ldqc) {
    const Frame F = phase_frame(F0);
    const bf16_t* Q = (const bf16_t*)(ws + WS_Q); const bf16_t* KN = (const bf16_t*)(ws + WS_KN); const bf16_t* KR = (const bf16_t*)(ws + WS_KROPE); const bf16_t* V = (const bf16_t*)(ws + WS_V);
    const bf16_t* MKV = (const bf16_t*)(ws + WS_MEMKV); bf16_t* CC = (bf16_t*)(ws + WS_CONCAT);
    if (mla) {
        const float* CS = (const float*)(ws + WS_CS); const float* SN = (const float*)(ws + WS_SN);
        auto mk = [&](int j) -> att::AttU { const int pidx = F.vcu + (j >> 1) * F.G, bh = pidx >> 2, pr = pidx & 3, b = bh / NHEAD, h = bh % NHEAD, qb = (j & 1) ? pr : 7 - pr;
            const size_t row0 = (size_t)b * SEQ, q0 = row0 + (size_t)qb * 256;
            return att::AttU{Q + q0 * QW + h * DQK, KN + row0 * KVW + h * 64, KR + row0 * 32, V + row0 * KVW + h * 64, CC + q0 * DM + h * 64, CS + q0 * 16, SN + q0 * 16, 4 * (qb + 1)}; };
        const int nu = 2 * ((NB * NHEAD * 4 - F.vcu + F.G - 1) / F.G);
        u32x4 qr[6]; att::AttU cur = mk(0); int j = 0;
#pragma unroll 1
        do { const bool hn = j + 1 < nu; const att::AttU nxt = hn ? mk(j + 1) : cur;
            att::attn_unit<96, true>(F.lds, cur, nxt, j == 0, hn, QW, KVW, 32, KVW, DM, F.wave, qr);
            cur = nxt; ++j; } while (j < nu);
    }
    {   auto mx = [&](int j) -> att::AttU { const int uidx = F.vcu + j * F.G, qb = uidx & 7, h = (uidx >> 3) & 3, b = uidx >> 5; const size_t q0 = (size_t)b * SEQ + (size_t)qb * 256;
            return att::AttU{QC + q0 * ldqc + h * 64, MKV + (size_t)b * MEML * 512 + h * 64, nullptr, MKV + (size_t)b * MEML * 512 + 256 + h * 64, CC + q0 * DM + 768 + h * 64, nullptr, nullptr, 4}; };
        const int nx = (NB * 4 * 8 - F.vcu + F.G - 1) / F.G;
        u32x4 qx[4]; att::AttU cur = mx(0); int j = 0;
#pragma unroll 1
        do { const bool hn = j + 1 < nx; const att::AttU nxt = hn ? mx(j + 1) : cur;
            att::attn_unit<64, false>(F.lds, cur, nxt, j == 0, hn, ldqc, 512, 0, 512, DM, F.wave, qx);
            cur = nxt; ++j; } while (j < nx); }
}

__device__ __forceinline__ void router_phase(const Frame& F, const Args& a, int layer, LAS unsigned char* listbuf) {
    unsigned char* ws = a.ws;
    for (int blk = F.vcu; blk < T / 256; blk += F.G) {
        SchedOne S{(const char*)(ws + WS_XS), (const char*)(ws + WS_WR) + (size_t)layer * (256 * 2048), blk};
        EpiRouter E{(const float*)(ws + WS_SSQX), a.in[17] + layer * 4, a.in[19] + layer * 32, (float*)(ws + WS_TOKW), (float*)(ws + WS_TOKR), (int*)(ws + WS_LIST), F.ctl + CW_CNT + layer * 128};
        pg8::gemm_run<EpiRouter, SchedOne, false>(F.lds, listbuf, S, E, 16, 1 << 30, 2048u, 2048u, F.wave);
        __syncthreads();
    }
}
__device__ __forceinline__ void moe_table(const Frame& F0, int layer) {
    const Frame F = phase_frame(F0);
    LAS int* tab = (LAS int*)(F.lds + L_TAB); const unsigned* cnt = F.ctl + CW_CNT + layer * 128;
    LAS unsigned short* items = (LAS unsigned short*)(tab + 240);
    int c = 0, v = 0, f = 0, x = 0, xf = 0;
    if (F.tid < 128) { if (F.tid < NBUCKET) { c = (int)__hip_atomic_load(cnt + F.tid, __ATOMIC_RELAXED, __HIP_MEMORY_SCOPE_AGENT); tab[128 + F.tid] = c; v = (c + 255) >> 8; f = (c >> 8) + ((c & 255) > 128 ? 1 : 0); }
        x = v; xf = f;
#pragma unroll
        for (int o = 1; o < 64; o <<= 1) { const int y = __shfl_up(x, o), yf = __shfl_up(xf, o); if (F.lane >= o) { x += y; xf += yf; } }
        if (F.tid == 63) { tab[127] = x; tab[126] = xf; } }
    __syncthreads();
    int tile0 = 0, fpos = 0;
    if (F.tid <= NBUCKET) { tile0 = x - v + (F.tid >= 64 ? tab[127] : 0); fpos = xf - f + (F.tid >= 64 ? tab[126] : 0); tab[F.tid] = tile0;
        if (F.tid == NBUCKET) { tab[121] = fpos; } }
    __syncthreads();
    { const int ntile = tab[NBUCKET], NF = tab[121], NH = ntile - NF;
      int sp = NF - 256; if (sp < 0) sp = 0; { int room = (64 - NH) / 2; if (room < 0) room = 0; if (sp > room) sp = room; }
      const int NFk = NF - sp;
      if (F.tid == 0) tab[120] = NFk + NH + 2 * sp;
      if (F.tid < NBUCKET) {
          for (int k = 0; k < f; ++k) { const int p = fpos + k, tile = tile0 + k;
              if (p < NFk) items[p] = (unsigned short)tile;
              else { const int q = NFk + NH + 2 * (p - NFk); items[q] = (unsigned short)(tile | (1 << 12)); items[q + 1] = (unsigned short)(tile | (2 << 12)); } }
          if (v > f) items[NFk + (tile0 - fpos)] = (unsigned short)((tile0 + f) | (1 << 12)); } }
    __syncthreads();
}

__device__ __forceinline__ void pool_diff_phase(const Frame& F0, unsigned char* ws) {
    const Frame F = phase_frame(F0);
    const bf16_t* Z = (const bf16_t*)(ws + WS_Z); bf16_t* CC = (bf16_t*)(ws + WS_CONCAT);
    constexpr int SR = 32, RR = 96, PITCH = 1536, NS = 256 / SR;
    const unsigned lds0 = (unsigned)(uintptr_t)F.lds;
    const int lane = F.lane, wave = F.wave;
    for (int blk = F.vcu; blk < T / 256; blk += F.G) {
        const int t0 = blk * 256, s0 = t0 & (SEQ - 1);
#define POOL_DMA(trow0, ringrow0, npc) do { _Pragma("unroll") for (int i_ = 0; i_ < (npc); ++i_) { const int p_ = wave * (npc) + i_, k_ = p_ * 64 + lane, r_ = k_ / 96, ch_ = k_ - r_ * 96; \
            att::glds16(Z + (size_t)((trow0) + r_) * DM + ch_ * 8, (unsigned)__builtin_amdgcn_readfirstlane(lds0 + (ringrow0) * PITCH + p_ * 1024)); } } while (0)
        __syncthreads();
        if (s0 != 0) POOL_DMA(t0 - 16, RR - 16, 3);
        POOL_DMA(t0, 0, 6);
#pragma unroll 1
        for (int s = 0; s < NS; ++s) {
            if (s == 0 || wave >= 6) asm volatile("s_waitcnt vmcnt(0)" ::: "memory"); else asm volatile("s_waitcnt vmcnt(8)" ::: "memory");
            __builtin_amdgcn_s_barrier(); asm volatile("" ::: "memory");
            if (s + 1 < NS) POOL_DMA(t0 + (s + 1) * SR, ((s + 1) % 3) * SR, 6);
            if (wave < 6) {
                const int run = F.tid / 96, q = F.tid - run * 96, g = q / 24, w = 2 << g, r0 = s * SR + run * 8;
                int pos = s0 + r0;
                const LAS unsigned char* col = F.lds + q * 16;
#define POOL_ROW(dst, r) do { const int rr_ = ((r) + RR) % RR; const u32x4 w_ = *(const LAS u32x4*)(col + rr_ * PITCH); \
                    dst[0] = bflo(w_.x); dst[1] = bfhi(w_.x); dst[2] = bflo(w_.y); dst[3] = bfhi(w_.y); dst[4] = bflo(w_.z); dst[5] = bfhi(w_.z); dst[6] = bflo(w_.w); dst[7] = bfhi(w_.w); } while (0)
                float S[8] = {0.f, 0.f, 0.f, 0.f, 0.f, 0.f, 0.f, 0.f};
                const int m = min(pos, w - 1);
                for (int j = 1; j <= m; ++j) { float y[8]; POOL_ROW(y, r0 - j);
#pragma unroll
                    for (int k = 0; k < 8; ++k) S[k] += y[k]; }
#pragma unroll 2
                for (int i = 0; i < 8; ++i) { float x[8]; POOL_ROW(x, r0 + i);
#pragma unroll
                    for (int k = 0; k < 8; ++k) S[k] += x[k];
                    const float inv = 1.0f / (float)min(pos + 1, w);
                    *(u32x4*)(CC + (size_t)(t0 + r0 + i) * DM + q * 8) = (u32x4){pk2(S[0] * inv - x[0], S[1] * inv - x[1]), pk2(S[2] * inv - x[2], S[3] * inv - x[3]), pk2(S[4] * inv - x[4], S[5] * inv - x[5]), pk2(S[6] * inv - x[6], S[7] * inv - x[7])};
                    if (pos + 1 >= w) { float y[8]; POOL_ROW(y, r0 + i - (w - 1));
#pragma unroll
                        for (int k = 0; k < 8; ++k) S[k] -= y[k]; }
                    ++pos; }
#undef POOL_ROW
            }
        }
#undef POOL_DMA
    }
    __syncthreads();
}
__device__ __forceinline__ void final_phase(const Frame& F0, const Args& a) {
    const Frame F = phase_frame(F0);
    const bf16_t* XS = (const bf16_t*)(a.ws + WS_XS); const float* gf = a.in[23];
    const int gw = F.vcu * 8 + F.wave, NGW = F.G * 8, lane = F.lane;
    f32x4 gv[4];
#pragma unroll
    for (int j = 0; j < 4; ++j) gv[j] = *((const f32x4*)gf + lane + 64 * j);
    auto fload = [&](int m, u32x2 (&w)[4]) { if (m < T) { const u32x2* xr = (const u32x2*)(XS + (size_t)m * DM) + lane;
#pragma unroll
            for (int j = 0; j < 4; ++j) w[j] = xr[64 * j]; } };
    auto fdone = [&](int m, const u32x2 (&w)[4]) { if (m < T) { f32x4 v[4]; float s2 = 0.f;
#pragma unroll
            for (int j = 0; j < 4; ++j) { v[j] = (f32x4){bflo(w[j].x), bfhi(w[j].x), bflo(w[j].y), bfhi(w[j].y)}; s2 += (v[j][0] * v[j][0] + v[j][1] * v[j][1]) + (v[j][2] * v[j][2] + v[j][3] * v[j][3]); }
            s2 = wave_sum(s2); const float rs = 1.0f / sqrtf(s2 * (1.f / DM) + EPS);
            f32x4* o = (f32x4*)(a.out + (size_t)m * DM) + lane;
#pragma unroll
            for (int j = 0; j < 4; ++j) o[64 * j] = v[j] * rs * gv[j]; } };
    u32x2 w0[4], w1[4], w2[4], w3[4];
    fload(gw, w0); fload(gw + NGW, w1); fload(gw + 2 * NGW, w2);
#pragma unroll 1
    for (int m = gw; m < T; m += 4 * NGW) {
        fload(m + 3 * NGW, w3); fdone(m, w0);
        fload(m + 4 * NGW, w0); fdone(m + NGW, w1);
        fload(m + 5 * NGW, w1); fdone(m + 2 * NGW, w2);
        fload(m + 6 * NGW, w2); fdone(m + 3 * NGW, w3); }
}

#ifndef PHASE_MASK
#define PHASE_MASK 0xFFFFFFFFu
#endif
#define PH(n) ((PHASE_MASK >> (n)) & 1u)
__global__ void __launch_bounds__(512, 2) fwd_kernel(Args args) {
    extern __shared__ __attribute__((aligned(16))) unsigned char lds_raw[];
    Frame F; F.lds = (LAS unsigned char*)lds_raw; F.tid = threadIdx.x; F.lane = F.tid & 63; F.wave = __builtin_amdgcn_readfirstlane(F.tid >> 6);
    __builtin_assume(gridDim.x <= 256u); __builtin_assume(blockIdx.x < gridDim.x);
    F.G = gridDim.x; { const int bx = blockIdx.x; F.vcu = (F.G % 8 == 0) ? (bx % 8) * (F.G / 8) + bx / 8 : bx; }
    unsigned char* ws = args.ws; F.ctl = (unsigned*)(ws + WS_CTL);
    for (int u = F.tid; u < (LDS_BYTES - RING_BYTES) / 4; u += 512) ((LAS unsigned*)(F.lds + RING_BYTES))[u] = 0u;
    __syncthreads();
    XcdBarrier bar = xcd_barrier_post(F.ctl + CW_BAR, (volatile LAS unsigned*)(F.lds + L_MISC) + 8, F.wave);
    LAS unsigned char* listbuf = F.lds + L_LIST;
    const float qcscale = 0.125f * LOG2E;
    const float qscale = 0.10206207261596577f * LOG2E;

    if (PH(0)) p0_prologue(F, args);
    xcd_barrier(bar);
    if (PH(1)) p1_fill(F, args);
    if (PH(1)) {   SchedPlainPart S; S.o.init(TMEM / 256, 2, F.G, (int)blockIdx.x); S.A = (const char*)(ws + WS_MEMB); S.B = (const char*)(ws + WS_WMEM); S.a_tile = 256 * 2048; S.b_tile = 256 * 2048;
        EpiRowScale E{(bf16_t*)(ws + WS_MEMKV), 512, (const float*)(ws + WS_RSTDM)};
        pg8::gemm_run<EpiRowScale, SchedPlainPart, false>(F.lds, listbuf, S, E, 16, 1 << 30, 2048u, 2048u, F.wave); }
    if (PH(2)) {   SchedPlain S; S.o.init(T / 256, 3, F.G, (int)blockIdx.x); S.A = (const char*)(ws + WS_XS); S.B = (const char*)(ws + WS_WINA); S.a_tile = 256 * 2048; S.b_tile = 256 * 2048;
        EpiInA E{(const float*)(ws + WS_RSTD0), (bf16_t*)(ws + WS_QLAT), (bf16_t*)(ws + WS_QC), (bf16_t*)(ws + WS_KVLAT), (bf16_t*)(ws + WS_KROPE), (float*)(ws + WS_SSQQ), (float*)(ws + WS_SSQKV),
                 (const float*)(ws + WS_CS), (const float*)(ws + WS_SN), qcscale};
        pg8::gemm_run<EpiInA, SchedPlain, false>(F.lds, listbuf, S, E, 16, 1 << 30, 2048u, 2048u, F.wave); }
    xcd_barrier(bar);
    if (PH(3)) {   SchedQKV S; S.o.init(T / 256, 11, F.G, (int)blockIdx.x); S.Aq = (const char*)(ws + WS_QLAT); S.Akv = (const char*)(ws + WS_KVLAT); S.B = (const char*)(ws + WS_WQKV);
        EpiQKV E{(const float*)(ws + WS_SSQQ), (const float*)(ws + WS_SSQKV), (bf16_t*)(ws + WS_Q), (bf16_t*)(ws + WS_KN), (bf16_t*)(ws + WS_V), qscale};
        pg8::gemm_run<EpiQKV, SchedQKV, false>(F.lds, listbuf, S, E, 4, 1 << 30, 512u, 512u, F.wave); }
    xcd_barrier(bar);
#pragma unroll 1
    for (int layer = 0; layer < 2; ++layer) {
        int gG = F.G, gB = (int)blockIdx.x, gV = F.vcu; asm volatile("" : "+s"(gG), "+s"(gB), "+s"(gV));
        { size_t zoff = 0; asm volatile("" : "+s"(zoff)); ws = args.ws + zoff; }
        if (layer == 0) {
            if (PH(4)) attn_phase(F, ws, true, (const bf16_t*)(ws + WS_QC), 256);
            xcd_barrier(bar);
        } else {
            if (PH(5)) {   SchedPlain S; S.o.init(T / 256, 4, gG, gB); S.A = (const char*)(ws + WS_XS); S.B = (const char*)(ws + WS_WINP); S.a_tile = 256 * 2048; S.b_tile = 256 * 2048;
                EpiInP E{(const float*)(ws + WS_SSQX), (bf16_t*)(ws + WS_Z), qcscale};
                pg8::gemm_run<EpiInP, SchedPlain, false>(F.lds, listbuf, S, E, 16, 1 << 30, 2048u, 2048u, F.wave); }
            xcd_barrier(bar);
            if (PH(6)) pool_diff_phase(F, ws);
            if (PH(7)) attn_phase(F, ws, false, (const bf16_t*)(ws + WS_Z) + 768, 1024);
            xcd_barrier(bar);
        }
        if (PH(9)) {   SchedPlain S; S.o.init(T / 256, 4, gG, gB); S.A = (const char*)(ws + WS_CONCAT); S.B = (const char*)(ws + WS_WO) + (size_t)layer * 2097152; S.a_tile = 256 * 2048; S.b_tile = 256 * 2048;
            EpiWo E{(bf16_t*)(ws + WS_XS), (float*)(ws + WS_SSQX)};
            pg8::gemm_run<EpiWo, SchedPlain, false>(F.lds, listbuf, S, E, 16, 1 << 30, 2048u, 2048u, F.wave); }
        xcd_barrier(bar);
        if (PH(10)) router_phase(F, args, layer, listbuf);
        xcd_barrier(bar);
        moe_table(F, layer);
        if (PH(11)) {   SchedMoe<false> S{(const LAS int*)(F.lds + L_TAB), gG, gV, (const char*)(ws + WS_XS), (const char*)(ws + WS_WGU) + (size_t)layer * (32u * 512u * 2048u), (const int*)(ws + WS_LIST)};
            EpiMoeUp E{(const float*)(ws + WS_TOKR), (const float*)(ws + WS_TOKW), (bf16_t*)(ws + WS_ACT)};
            pg8::gemm_run<EpiMoeUp, SchedMoe<false>, true>(F.lds, listbuf, S, E, 16, 1 << 30, 2048u, 2048u, F.wave); }
        xcd_barrier(bar);
        if (PH(12)) {   SchedMoe<true> S{(const LAS int*)(F.lds + L_TAB), gG, gV, (const char*)(ws + WS_ACT), (const char*)(ws + WS_WD) + (size_t)layer * (4u * 1024u * 4096u), (const int*)(ws + WS_LIST)};
            EpiMoeDown E{(bf16_t*)(ws + WS_XS), (float*)(ws + WS_SSQX)};
            pg8::gemm_run<EpiMoeDown, SchedMoe<true>, false>(F.lds, listbuf, S, E, 8, 4, 1024u, 4096u, F.wave); }
        xcd_barrier(bar);
    }
    if (PH(13)) final_phase(F, args);
}

extern "C" void kernel_launch(void* const* d_in, const int* in_sizes, int n_in, void* d_out, int out_size, void* d_ws, size_t ws_size, hipStream_t stream) {
    static int grid = 0;
    if (grid == 0) {
        if (n_in != 24 || in_sizes[0] != T * DM || out_size != T * DM || ws_size < WS_END) { fprintf(stderr, "kernel_launch: unexpected shapes (n_in %d, in0 %d, out %d, ws %zu); nothing launched\n", n_in, n_in > 0 ? in_sizes[0] : -1, out_size, ws_size); grid = -1; return; }
        int dev = 0, cus = 0, per_cu = 0;
        if (hipGetDevice(&dev) != hipSuccess || hipDeviceGetAttribute(&cus, hipDeviceAttributeMultiprocessorCount, dev) != hipSuccess) { grid = -1; return; }
        if (hipFuncSetAttribute((const void*)fwd_kernel, hipFuncAttributeMaxDynamicSharedMemorySize, LDS_BYTES) != hipSuccess) { fprintf(stderr, "kernel_launch: hipFuncSetAttribute failed\n"); grid = -1; return; }
        if (hipOccupancyMaxActiveBlocksPerMultiprocessor(&per_cu, (const void*)fwd_kernel, 512, LDS_BYTES) != hipSuccess || per_cu < 1) fprintf(stderr, "kernel_launch: occupancy query reports %d\n", per_cu);
        (void)hipGetLastError();
        grid = cus < 256 ? cus : 256;
    }
    if (grid < 0) return;
    if (hipMemsetAsync((char*)d_ws + WS_CTL, 0, CTL_ZERO_BYTES, stream) != hipSuccess) return;
    Args a{};
    for (int i = 0; i < 24; ++i) a.in[i] = (const float*)d_in[i];
    a.out = (float*)d_out; a.ws = (unsigned char*)d_ws;
    hipLaunchKernelGGL(fwd_kernel, dim3(grid), dim3(512), LDS_BYTES, stream, a);
}
```

```cpp
#include <hip/hip_runtime.h>
#include <cstdio>
#include <cstdint>

#define LAS __attribute__((address_space(3)))
#define GAS __attribute__((address_space(1)))
typedef unsigned short bf16_t;
typedef short bf16x8 __attribute__((ext_vector_type(8)));
typedef short s16x4 __attribute__((ext_vector_type(4)));
typedef float f32x2 __attribute__((ext_vector_type(2)));
typedef float f32x4 __attribute__((ext_vector_type(4)));
typedef float f32x16 __attribute__((ext_vector_type(16)));
typedef unsigned u32x2 __attribute__((ext_vector_type(2)));
typedef unsigned u32x4 __attribute__((ext_vector_type(4)));
typedef __bf16 bf16x2_t __attribute__((ext_vector_type(2)));

constexpr int T = 65536, DM = 1024, SEQ = 2048, NB = 32, MEML = 256, TMEM = NB * MEML;
constexpr int NHEAD = 12, DQK = 96, DV = 64, QW = NHEAD * DQK  , KVW = NHEAD * DV  ;
constexpr float EPS = 1e-6f;
constexpr int NBUCKET = 112, CAP = 65536;
constexpr float LOG2E = 1.4426950408889634f;

constexpr size_t MiB = 1u << 20;
constexpr size_t WS_CTL = 0, CTL_ZERO_BYTES = 64 * 1024;
constexpr size_t WS_WINA = 1 * MiB;
constexpr size_t WS_WQKV = 3 * MiB;
constexpr size_t WS_WINP = 5 * MiB;
constexpr size_t WS_WMEM = 8 * MiB;
constexpr size_t WS_WO = 9 * MiB;
constexpr size_t WS_WR = 13 * MiB;
constexpr size_t WS_WGU = 14 * MiB;
constexpr size_t WS_WD = 78 * MiB;
constexpr size_t WS_XS = 110 * MiB;
constexpr size_t WS_RSTD0 = 238 * MiB;
constexpr size_t WS_RSTDM = 238 * MiB + 512 * 1024;
constexpr size_t WS_CS = 239 * MiB, WS_SN = 243 * MiB;
constexpr size_t WS_MEMB = 247 * MiB;
constexpr size_t WS_MEMKV = 263 * MiB;
constexpr size_t WS_SSQQ = 271 * MiB, WS_SSQKV = 272 * MiB, WS_SSQX = 273 * MiB;
constexpr size_t WS_TOKW = 277 * MiB;
constexpr size_t WS_TOKR = 278 * MiB;
constexpr size_t WS_KROPE = 279 * MiB;
constexpr size_t WS_LIST = 283 * MiB;
constexpr size_t WS_QLAT = 311 * MiB, WS_QC = 343 * MiB, WS_KVLAT = 375 * MiB;
constexpr size_t WS_ACT = 311 * MiB;
constexpr size_t WS_Q = 407 * MiB, WS_KN = 551 * MiB, WS_V = 647 * MiB;
constexpr size_t WS_Z = 407 * MiB;
constexpr size_t WS_CONCAT = 743 * MiB;
constexpr size_t WS_END = 871 * MiB;
constexpr int CW_BAR = 4096, CW_CNT = 8192;

constexpr int RING_BYTES = 147456;
constexpr int L_MISC = RING_BYTES, L_LIST = RING_BYTES + 256, L_TAB = RING_BYTES + 256 + 2048, LDS_BYTES = RING_BYTES + 4096;

__device__ __forceinline__ unsigned pk2(float lo, float hi) { f32x2 v = {lo, hi}; bf16x2_t b = __builtin_convertvector(v, bf16x2_t); return __builtin_bit_cast(unsigned, b); }
__device__ __forceinline__ float bflo(unsigned w) { return __uint_as_float(w << 16); }
__device__ __forceinline__ float bfhi(unsigned w) { return __uint_as_float(w & 0xffff0000u); }
__device__ __forceinline__ u32x4 pack8(f32x4 a, f32x4 b) { u32x4 w; w.x = pk2(a[0], a[1]); w.y = pk2(a[2], a[3]); w.z = pk2(b[0], b[1]); w.w = pk2(b[2], b[3]); return w; }
__device__ __forceinline__ float wave_sum(float v) {
#pragma unroll
    for (int o = 1; o < 64; o <<= 1) v += __shfl_xor(v, o);
    return v;
}
#define LDS_WAIT() asm volatile("s_waitcnt lgkmcnt(0)" ::: "memory")
__device__ __forceinline__ int hw_lane() { int l; asm volatile("v_mbcnt_lo_u32_b32 %0, -1, 0\n\tv_mbcnt_hi_u32_b32 %0, -1, %0" : "=v"(l)); return l; }
#define VM_WAIT() asm volatile("s_waitcnt vmcnt(0)" ::: "memory")

#define XB_TMO      128
#define XB_XCNT(j)  (256  + 64 * (j))
#define XB_XSUB(j)  (1280 + 64 * (j))
#define XB_XGEN(j)  (2304 + 64 * (j))
#define XB_TOP      3328
#define XB_TOPGEN   3392
#define XCD_BAR_WORDS 3456
#define XB_SPIN_CAP (1u << 18)
__device__ __forceinline__ unsigned xb_ld(unsigned* p)              { return __hip_atomic_load(p, __ATOMIC_RELAXED, __HIP_MEMORY_SCOPE_AGENT); }
__device__ __forceinline__ unsigned xb_add(unsigned* p, unsigned v) { return __hip_atomic_fetch_add(p, v, __ATOMIC_RELAXED, __HIP_MEMORY_SCOPE_AGENT); }
__device__ __forceinline__ unsigned xb_xcc_id() { return (unsigned)__builtin_amdgcn_s_getreg((3 << 11) | 20) & 0xFu; }
#define XB_SPIN(cond, bar) do { unsigned _sp = 0; while (cond) { __builtin_amdgcn_s_sleep(1); \
    if ((++_sp & 255u) == 0u) { if (xb_ld(&(bar)[XB_TMO])) break; if (_sp > XB_SPIN_CAP) { atomicAdd(&(bar)[XB_TMO], 1u); break; } } } } while (0)
struct XcdBarrier { unsigned* bar; unsigned x; volatile LAS unsigned* st; int w; };
__device__ __forceinline__ XcdBarrier xcd_barrier_post(unsigned* bar, volatile LAS unsigned* st, int wave) {
    XcdBarrier b; b.bar = bar; b.x = xb_xcc_id(); b.st = st; b.w = wave;
    if (threadIdx.x == 0) (void)xb_add(&bar[XB_XCNT(b.x)], 1u);
    return b;
}
__device__ __forceinline__ void xcd_barrier_complete(unsigned* bar, unsigned x, unsigned& nloc, unsigned& nx) {
    const unsigned G = gridDim.x * gridDim.y * gridDim.z;
    unsigned sum, cnt, mine, sp = 0u;
    for (;;) {
        sum = 0u; cnt = 0u; mine = 0u;
#pragma unroll
        for (unsigned j = 0; j < 16; ++j) { const unsigned c = xb_ld(&bar[XB_XCNT(j)]); sum += c; cnt += (c > 0u) ? 1u : 0u; mine = (j == x) ? c : mine; }
        if (sum == G) break;
        __builtin_amdgcn_s_sleep(1);
        if ((++sp & 255u) == 0u) { if (xb_ld(&bar[XB_TMO])) break; if (sp > XB_SPIN_CAP) { atomicAdd(&bar[XB_TMO], 1u); break; } }
    }
    nloc = mine > 0u ? mine : 1u; nx = cnt > 0u ? cnt : 1u;
}
__device__ __forceinline__ void xcd_barrier(const XcdBarrier& b) {
    asm volatile("s_waitcnt vmcnt(0)" ::: "memory");
    __syncthreads();
    if (b.w == 0 && hw_lane() == 0) {
        unsigned zoff = 0u; asm volatile("" : "+s"(zoff));
        unsigned* bar = b.bar + zoff;
        __builtin_amdgcn_s_waitcnt(0);
        const unsigned bx = xb_xcc_id();
        unsigned nloc = b.st[0], nx = b.st[1];
        if (nloc == 0u) { xcd_barrier_complete(bar, bx, nloc, nx); b.st[0] = nloc; b.st[1] = nx; }
        const unsigned old = xb_add(&bar[XB_XSUB(bx)], 1u);
        const unsigned gen = old / nloc;
        if (old + 1u == (gen + 1u) * nloc) {
            __builtin_amdgcn_fence(__ATOMIC_RELEASE, "agent");
            asm volatile("s_waitcnt vmcnt(0)" ::: "memory");
            const unsigned og = xb_add(&bar[XB_TOP], 1u);
            const unsigned tg = og / nx;
            if (og + 1u == (tg + 1u) * nx) xb_add(&bar[XB_TOPGEN], 1u);
            else XB_SPIN(xb_ld(&bar[XB_TOPGEN]) == tg, bar);
            __builtin_amdgcn_fence(__ATOMIC_ACQUIRE, "agent");
            xb_add(&bar[XB_XGEN(bx)], 1u);
            asm volatile("s_waitcnt vmcnt(0)" ::: "memory");
        } else {
            XB_SPIN(xb_ld(&bar[XB_XGEN(bx)]) == gen, bar);
            __builtin_amdgcn_fence(__ATOMIC_ACQUIRE, "agent");
            asm volatile("s_waitcnt vmcnt(0)" ::: "memory");
        }
    }
    __syncthreads();
}

namespace pg8 {
constexpr int BM = 256, BK = 64, HALF = 128, HTB = HALF * BK * 2, NXCD = 8, WGM = 8;
__host__ __device__ __forceinline__ int lds_byte(int r, int c) { const int st = (r >> 4) * 2 + (c >> 5), rr = r & 15, cc = c & 31, ob = rr * 64 + cc * 2; return st * 1024 + (ob ^ (((ob >> 9) & 1) << 5)); }
__host__ __device__ __forceinline__ void stage_rc(int b, int& R, int& C) { const int st = b / 1024, sb = b % 1024, swz = sb ^ (((sb >> 9) & 1) << 5); R = (st >> 1) * 16 + swz / 64; C = (st & 1) * 32 + (swz % 64) / 2; }
__host__ __device__ __forceinline__ int perm32(int rho) { const int n = rho >> 4, i = rho & 15; return 8 * (i >> 2) + 4 * n + (i & 3); }

struct Unit { const char* A; const char* B; int bjump; int nvalid; const int* list; int pm, pn, aux; unsigned ll; int half; int nt; };

struct TileOrder {
    int nM, nN, nwg, G, c;
    __device__ __forceinline__ void init(int nM_, int nN_, int G_, int c_) { nM = nM_; nN = nN_; nwg = nM * nN; G = G_; c = c_; }
    __device__ __forceinline__ bool get(int i, int& pm, int& pn) const {
        const long L = (long)i * G + c; if (L >= nwg) return false;
        int wgid = (int)L; { const int q = nwg / NXCD, r = nwg % NXCD, xcd = wgid % NXCD, off = wgid / NXCD; wgid = (xcd < r ? xcd * (q + 1) : r * (q + 1) + (xcd - r) * q) + off; }
        const int nig = WGM * nN, gid = wgid / nig, fm = gid * WGM, gsz = (nM - fm) < WGM ? (nM - fm) : WGM;
        pm = fm + ((wgid % nig) % gsz); pn = (wgid % nig) / gsz; return true;
    }
};

template <class E_> struct epi_wants_list { template <class X> static constexpr bool get(decltype(X::LDS_LIST)*) { return X::LDS_LIST; } template <class X> static constexpr bool get(...) { return false; } static constexpr bool value = get<E_>(nullptr); };
template <class S_> struct sched_halves { template <class X> static constexpr bool get(decltype(X::HALVES)*) { return X::HALVES; } template <class X> static constexpr bool get(...) { return false; } static constexpr bool value = get<S_>(nullptr); };
template <class S_> struct sched_pernt { template <class X> static constexpr bool get(decltype(X::PERUNIT_NT)*) { return X::PERUNIT_NT; } template <class X> static constexpr bool get(...) { return false; } static constexpr bool value = get<S_>(nullptr); };
template <class Epi, class Sched, bool GATHER>
__device__ __forceinline__ void gemm_run(LAS unsigned char* lds, LAS unsigned char* listbuf, const Sched& S, const Epi& E, const int nt, const int jt, const unsigned lda2, const unsigned ldb2, const int wv) {
    int tid = (wv << 6) | hw_lane(); asm volatile("" : "+v"(tid));
    const int wid = __builtin_amdgcn_readfirstlane(tid >> 6), lane = tid & 63, wr = wid >> 2, wc = wid & 3, fr = lane & 15, fq = lane >> 4;
    int Rr[2]; unsigned Cc[2], voffB[2];
#pragma unroll
    for (int i = 0; i < 2; ++i) { int R, C; stage_rc(tid * 16 + i * 8192, R, C); const int Rb = (R & ~31) + perm32(R & 31); Rr[i] = R; Cc[i] = (unsigned)C * 2u; voffB[i] = (unsigned)Rb * ldb2 + (unsigned)C * 2u; }
    const size_t kstep = (size_t)(BK * 2);
    const size_t hstepB = (size_t)HALF * ldb2;
    const size_t hstepA = GATHER ? (size_t)0 : (size_t)HALF * lda2;
    const unsigned ldsw = (unsigned)wid * 1024u;
    const int aoff = lds_byte(wr * 64 + fr, fq * 8), boff = lds_byte(wc * 32 + fr, fq * 8);
#define PG8_SB(b, h) (((b) * 2 + (h)) * HTB)
#define PG8_AB (4 * HTB)
#define PG8_STAGE(bufoff, gbase, voff) do { _Pragma("unroll") for (int _i = 0; _i < 2; ++_i) \
        __builtin_amdgcn_global_load_lds((const unsigned*)((const char*)(gbase) + (voff)[_i]), (LAS unsigned*)(lds + (bufoff) + ldsw + _i * 8192), 16, 0, 0); } while (0)
#define PG8_STAGE_A(gbase, voff) PG8_STAGE(PG8_AB + (rs == 0 ? 4 : rs - 1) * HTB, gbase, voff)
#define PG8_LDA(dst) do { const LAS unsigned char* ap_ = lds + PG8_AB + rs * HTB + aoff; _Pragma("unroll") for (int m = 0; m < 4; ++m) _Pragma("unroll") for (int k = 0; k < 2; ++k) dst[m][k] = *(const LAS bf16x8*)(ap_ + m * 2048 + k * 1024); } while (0)
#define PG8_NEXT_RS() do { rs = (rs == 4) ? 0 : rs + 1; } while (0)
#define PG8_LDB(dst, b, h) do { _Pragma("unroll") for (int n = 0; n < 2; ++n) _Pragma("unroll") for (int k = 0; k < 2; ++k) dst[n][k] = *(const LAS bf16x8*)(lds + PG8_SB(b, h) + boff + n * 2048 + k * 1024); } while (0)
#define PG8_MMA(ai, bj, At, Bt) do { __builtin_amdgcn_s_setprio(1); _Pragma("unroll") for (int m = 0; m < 4; ++m) _Pragma("unroll") for (int n = 0; n < 2; ++n) _Pragma("unroll") for (int k = 0; k < 2; ++k) \
        acc[ai][bj][m][n] = __builtin_amdgcn_mfma_f32_16x16x32_bf16(Bt[n][k], At[m][k], acc[ai][bj][m][n], 0, 0, 0); __builtin_amdgcn_s_setprio(0); } while (0)
#define PG8_WAIT_V(n) asm volatile("s_waitcnt vmcnt(" #n ")" ::: "memory")
#define PG8_WAIT_L(n) asm volatile("s_waitcnt lgkmcnt(" #n ")" ::: "memory")
#define PG8_BAR __builtin_amdgcn_s_barrier()
#define PG8_SCHED __builtin_amdgcn_sched_barrier(0)
#define PG8_BPTR(X, tt) ((X).B + (size_t)(tt) * kstep + (((tt) >= jt) ? (X).bjump : 0))
    Unit cur, nxt; int ui = 0; cur.ll = 0u; nxt.ll = 0u; cur.half = 0; nxt.half = 0; cur.nt = 0; nxt.nt = 0;
    { const bool ok0_ = S.next(0, cur); if (!Sched::FULL && !ok0_) return; }
    unsigned offA[2][2];
#pragma unroll
    for (int h = 0; h < 2; ++h)
#pragma unroll
        for (int i = 0; i < 2; ++i) {
            const int row = h * HALF + Rr[i];
            if constexpr (GATHER) { int idx = cur.list[row]; if (row >= cur.nvalid) idx = 0; offA[h][i] = (unsigned)idx * lda2 + Cc[i]; }
            else offA[h][i] = (unsigned)Rr[i] * lda2 + Cc[i];
        }
    f32x4 acc[2][2][4][2];
#pragma unroll
    for (int a = 0; a < 2; ++a)
#pragma unroll
        for (int b = 0; b < 2; ++b)
#pragma unroll
            for (int m = 0; m < 4; ++m)
#pragma unroll
                for (int n = 0; n < 2; ++n) acc[a][b][m][n] = (f32x4){0.f, 0.f, 0.f, 0.f};
    bf16x8 At[4][2], B0[2][2], B1[2][2];
    int rs = 0;
    constexpr bool LLIST = epi_wants_list<Epi>::value;
    if constexpr (LLIST) __builtin_amdgcn_global_load_lds((const unsigned*)((const char*)cur.list + lane * 16), (LAS unsigned*)listbuf, 16, 0, 0);
    {
        const char* cA = cur.A; const char* cB = cur.B;
        PG8_STAGE(PG8_SB(0, 0), cB, voffB); PG8_STAGE(PG8_SB(0, 1), cB + hstepB, voffB); PG8_STAGE(PG8_AB, cA, offA[0]); PG8_STAGE(PG8_AB + HTB, cA + hstepA, offA[1]);
        if (wr == 1) PG8_BAR;
        PG8_WAIT_V(2); PG8_BAR;
        const char* cB1 = PG8_BPTR(cur, 1);
        PG8_STAGE(PG8_SB(1, 0), cB1, voffB); PG8_STAGE(PG8_AB + 2 * HTB, cA + kstep, offA[0]); PG8_STAGE(PG8_SB(1, 1), cB1 + hstepB, voffB); PG8_STAGE(PG8_AB + 3 * HTB, cA + kstep + hstepA, offA[1]);
        PG8_WAIT_V(8); PG8_BAR;
    }
    for (;;) {
        const bool has_next = S.next(ui + 1, nxt);
        const int unt = sched_pernt<Sched>::value ? cur.nt : nt;
        const bool chalf = sched_halves<Sched>::value && cur.half != 0;
        const char* cA = cur.A;
        const char* nA = has_next ? nxt.A : cur.A;
        const char* nB0 = has_next ? nxt.B : cur.B;
        const char* nB1 = has_next ? PG8_BPTR(nxt, 1) : PG8_BPTR(cur, 1);
#pragma unroll 1
        for (int t = 0; t < unt; t += 2) {
            const bool last = (t == unt - 2);
            const bool thalf = sched_halves<Sched>::value && (last ? (has_next ? nxt.half != 0 : chalf) : chalf);
            const bool w6 = sched_halves<Sched>::value && (chalf || thalf);
            if constexpr (GATHER) {
                if (last && has_next) {
                    const LAS int* lb = (const LAS int*)(listbuf + ((ui + 1) & 1) * 1024);
#pragma unroll
                    for (int h = 0; h < 2; ++h)
#pragma unroll
                        for (int i = 0; i < 2; ++i) { const int row = h * HALF + Rr[i]; int idx = lb[row]; if (row >= nxt.nvalid) idx = 0; offA[h][i] = (unsigned)idx * lda2 + Cc[i]; }
                }
            }
            const char* a2 = last ? nA : cA + (size_t)(t + 2) * kstep; const char* b2 = last ? nB0 : PG8_BPTR(cur, t + 2);
            const char* a3 = a2 + kstep;                              const char* b3 = last ? nB1 : PG8_BPTR(cur, t + 3);
            PG8_LDB(B0, 0, 0); PG8_LDB(B1, 0, 1); PG8_SCHED; PG8_LDA(At); PG8_STAGE_A(a2, offA[0]);
            if (w6) PG8_WAIT_V(6); else PG8_WAIT_V(10); PG8_WAIT_L(0); PG8_BAR; PG8_MMA(0, 0, At, B0); PG8_MMA(0, 1, At, B1); PG8_BAR; PG8_SCHED; PG8_NEXT_RS();
            if constexpr (LLIST || GATHER) {
                if (t == 0 && has_next) __builtin_amdgcn_global_load_lds((const unsigned*)((const char*)nxt.list + lane * 16), (LAS unsigned*)(listbuf + ((ui + 1) & 1) * 1024), 16, 0, 0);
            }
            if (!chalf) PG8_LDA(At); PG8_STAGE(PG8_SB(0, 0), b2, voffB); PG8_STAGE(PG8_SB(0, 1), b2 + hstepB, voffB); if (!thalf) PG8_STAGE_A(a2 + hstepA, offA[1]);
            if (w6) PG8_WAIT_V(6); else PG8_WAIT_V(10); PG8_WAIT_L(0); PG8_BAR; if (!chalf) { PG8_MMA(1, 0, At, B0); PG8_MMA(1, 1, At, B1); } PG8_BAR; PG8_SCHED; PG8_NEXT_RS();
            PG8_LDB(B0, 1, 0); PG8_LDB(B1, 1, 1); PG8_SCHED; PG8_LDA(At); PG8_STAGE_A(a3, offA[0]);
            if (w6) PG8_WAIT_V(6); else PG8_WAIT_V(10); PG8_WAIT_L(0); PG8_BAR; PG8_MMA(0, 0, At, B0); PG8_MMA(0, 1, At, B1); PG8_BAR; PG8_SCHED; PG8_NEXT_RS();
            if (!chalf) PG8_LDA(At); PG8_STAGE(PG8_SB(1, 0), b3, voffB); PG8_STAGE(PG8_SB(1, 1), b3 + hstepB, voffB); if (!thalf) PG8_STAGE_A(a3 + hstepA, offA[1]);
            if (w6) PG8_WAIT_V(6); else PG8_WAIT_V(10); PG8_WAIT_L(0); PG8_BAR; if (!chalf) { PG8_MMA(1, 0, At, B0); PG8_MMA(1, 1, At, B1); } PG8_BAR; PG8_SCHED; PG8_NEXT_RS();
        }
        if (wr == 0) PG8_BAR;
        if constexpr (!Epi::AFTER_DRAIN) { int fr_ = fr, fq_ = fq; asm volatile("" : "+v"(fr_), "+v"(fq_));
            if constexpr (LLIST) cur.ll = (unsigned)(uintptr_t)(listbuf + (ui & 1) * 1024);
            E(acc, cur, wr, wc, fr_, fq_); }
        if (!has_next) break;
#pragma unroll
        for (int a = 0; a < 2; ++a)
#pragma unroll
            for (int b = 0; b < 2; ++b)
#pragma unroll
                for (int m = 0; m < 4; ++m)
#pragma unroll
                    for (int n = 0; n < 2; ++n) acc[a][b][m][n] = (f32x4){0.f, 0.f, 0.f, 0.f};
        cur = nxt; ++ui;
        if (wr == 1) PG8_BAR;
    }
    PG8_WAIT_V(0);
    PG8_BAR;
    if constexpr (Epi::AFTER_DRAIN) E.fused(acc, cur, wr, wc, fr, fq, lds);
#undef PG8_AB
#undef PG8_STAGE_A
#undef PG8_NEXT_RS
#undef PG8_SB
#undef PG8_STAGE
#undef PG8_LDA
#undef PG8_LDB
#undef PG8_MMA
#undef PG8_WAIT_V
#undef PG8_WAIT_L
#undef PG8_BAR
#undef PG8_SCHED
#undef PG8_BPTR
}
}
using pg8::Unit;

template <bool FULL_> struct SchedPlainT {
    static constexpr bool FULL = FULL_;
    pg8::TileOrder o; const char* A; const char* B; size_t a_tile, b_tile;
    __device__ __forceinline__ bool next(int i, Unit& u) const { int pm, pn; if (!o.get(i, pm, pn)) return false;
        u.A = A + (size_t)pm * a_tile; u.B = B + (size_t)pn * b_tile; u.bjump = 0; u.nvalid = 256; u.list = nullptr; u.pm = pm; u.pn = pn; u.aux = 0; return true; }
};
typedef SchedPlainT<true> SchedPlain;
typedef SchedPlainT<false> SchedPlainPart;
struct SchedOne {
    static constexpr bool FULL = true;
    const char* A; const char* B; int pm;
    __device__ __forceinline__ bool next(int i, Unit& u) const { if (i != 0) return false;
        u.A = A + (size_t)pm * (256 * 2048); u.B = B; u.bjump = 0; u.nvalid = 256; u.list = nullptr; u.pm = pm; u.pn = 0; u.aux = 0; return true; }
};
struct SchedQKV {
    static constexpr bool FULL = true;
    static constexpr bool PERUNIT_NT = true;
    pg8::TileOrder o; const char* Aq; const char* Akv; const char* B;
    __device__ __forceinline__ bool next(int i, Unit& u) const { int pm, pn; if (!o.get(i, pm, pn)) return false;
        u.A = (pn < 5 ? Aq : Akv) + (size_t)pm * (256 * 512); u.B = B + (size_t)pn * (256 * 512); u.bjump = 0; u.nvalid = 256; u.list = nullptr; u.pm = pm; u.pn = pn; u.aux = 0; u.nt = pn < 5 ? 4 : 2; return true; }
};
__device__ __forceinline__ void pair_decode(int p, int& lo, int& hi) { int l = 0, rem = p; while (rem >= 7 - l) { rem -= 7 - l; ++l; } lo = l; hi = l + 1 + rem; }
template <bool DOWN> struct SchedMoe {
    static constexpr bool FULL = false;
    static constexpr bool HALVES = true;
    const LAS int* tab; int G, c; const char* A; const char* W; const int* list;
    __device__ __forceinline__ bool next(int i, Unit& u) const {
        const int nitems = tab[120]; const long L = (long)i * G + c; if (L >= (long)nitems * 4) return false;
        const int it = (int)((const LAS unsigned short*)(tab + 240))[L >> 2], tile = it & 4095, kind = it >> 12, pn = (int)(L & 3);
        int lo_ = 0, hi_ = NBUCKET - 1;
        while (lo_ < hi_) { const int mid = (lo_ + hi_ + 1) >> 1; if (tab[mid] <= tile) lo_ = mid; else hi_ = mid - 1; }
        const int b = __builtin_amdgcn_readfirstlane(lo_);
        const int tib = tile - __builtin_amdgcn_readfirstlane(tab[b]), cnt = __builtin_amdgcn_readfirstlane(tab[128 + b]);
        int elo, ehi; pair_decode(b % 28, elo, ehi); const int g = b / 28;
        int nv = min(256, cnt - tib * 256), roff = 0;
        if (kind == 2) { roff = 128; nv -= 128; }
        if (kind != 0) nv = min(nv, 128);
        u.nvalid = nv; u.list = list + (size_t)b * CAP + tib * 256 + roff; u.pm = tile; u.pn = pn; u.aux = tile * 256 + roff; u.half = kind != 0 ? 1 : 0;
        if (!DOWN) { u.A = A; u.B = W + ((size_t)(g * 8 + (pn < 2 ? elo : ehi)) * 512 + (pn & 1) * 256) * 2048; u.bjump = 0; }
        else { u.A = A + (size_t)(tile * 256 + roff) * 1024; u.B = W + (size_t)g * (1024 * 4096) + (size_t)pn * (256 * 4096) + elo * 512; u.bjump = (ehi - elo - 1) * 512; }
        return true;
    }
};

#define EPI_ROWS(ai, m) (128 * (ai) + 64 * wr + 16 * (m) + fr)
#define EPI_COL(bj) (128 * (bj) + 32 * wc + 8 * fq)
#define EPI_FENCE asm volatile("" ::: "memory")
typedef f32x4 acc_t[2][2][4][2];

struct EpiRowScale {
    static constexpr bool AFTER_DRAIN = false;
    bf16_t* O; int ldc; const float* rs;
    __device__ __forceinline__ void operator()(const acc_t& acc, const Unit& u, int wr, int wc, int fr, int fq) const {
        float sv[2][4];
#pragma unroll
        for (int ai = 0; ai < 2; ++ai)
#pragma unroll
            for (int m = 0; m < 4; ++m) sv[ai][m] = rs[u.pm * 256 + EPI_ROWS(ai, m)];
        EPI_FENCE;
#pragma unroll
        for (int ai = 0; ai < 2; ++ai)
#pragma unroll
            for (int m = 0; m < 4; ++m) { const int r = u.pm * 256 + EPI_ROWS(ai, m); const float s = sv[ai][m];
#pragma unroll
                for (int bj = 0; bj < 2; ++bj) *(u32x4*)(O + (size_t)r * ldc + u.pn * 256 + EPI_COL(bj)) = pack8(acc[ai][bj][m][0] * s, acc[ai][bj][m][1] * s); }
    }
};
__device__ __forceinline__ void rope8(f32x4& v0, f32x4& v1, f32x4 c0, f32x4 c1, f32x4 s0, f32x4 s1, int fq) {
    f32x4 p0, p1;
#pragma unroll
    for (int j = 0; j < 4; ++j) { p0[j] = __shfl_xor(v0[j], 32); p1[j] = __shfl_xor(v1[j], 32); }
    const float sg = (fq < 2) ? -1.f : 1.f;
    v0 = v0 * c0 + (p0 * s0) * sg; v1 = v1 * c1 + (p1 * s1) * sg;
}
struct EpiInA {
    static constexpr bool AFTER_DRAIN = false;
    const float* rstd0; bf16_t* qlat; bf16_t* qc; bf16_t* kvlat; bf16_t* krope; float* ssqq; float* ssqkv; const float* cs; const float* sn; float qcscale;
    __device__ __forceinline__ void operator()(const acc_t& acc, const Unit& u, int wr, int wc, int fr, int fq) const {
        float sv[2][4];
#pragma unroll
        for (int ai = 0; ai < 2; ++ai)
#pragma unroll
            for (int m = 0; m < 4; ++m) sv[ai][m] = rstd0[u.pm * 256 + EPI_ROWS(ai, m)];
        EPI_FENCE;
        const bool roper = (u.pn == 2) && (wc == 0);
#pragma unroll
        for (int ai = 0; ai < 2; ++ai)
#pragma unroll
          for (int mh = 0; mh < 2; ++mh) {
            f32x4 tc[2][4];
            if (roper) {
#pragma unroll
                for (int mm = 0; mm < 2; ++mm) { const size_t o = (size_t)(u.pm * 256 + EPI_ROWS(ai, 2 * mh + mm)) * 16 + 8 * (fq & 1);
                    tc[mm][0] = *(const f32x4*)(cs + o); tc[mm][1] = *(const f32x4*)(cs + o + 4); tc[mm][2] = *(const f32x4*)(sn + o); tc[mm][3] = *(const f32x4*)(sn + o + 4); }
            }
            EPI_FENCE;
#pragma unroll
            for (int mm = 0; mm < 2; ++mm) { const int m = 2 * mh + mm; const int r = u.pm * 256 + EPI_ROWS(ai, m); const float s = sv[ai][m];
                f32x4 v[2][2];
#pragma unroll
                for (int bj = 0; bj < 2; ++bj) { v[bj][0] = acc[ai][bj][m][0] * s; v[bj][1] = acc[ai][bj][m][1] * s; }
                if (u.pn == 0) {
                    float ss = 0.f;
#pragma unroll
                    for (int bj = 0; bj < 2; ++bj) { *(u32x4*)(qlat + (size_t)r * 256 + EPI_COL(bj)) = pack8(v[bj][0], v[bj][1]);
#pragma unroll
                        for (int n = 0; n < 2; ++n) ss += (v[bj][n][0] * v[bj][n][0] + v[bj][n][1] * v[bj][n][1]) + (v[bj][n][2] * v[bj][n][2] + v[bj][n][3] * v[bj][n][3]); }
                    ss += __shfl_xor(ss, 16); ss += __shfl_xor(ss, 32);
                    if (fq == 0) ssqq[(size_t)r * 4 + wc] = ss;
                } else if (u.pn == 1) {
#pragma unroll
                    for (int bj = 0; bj < 2; ++bj) *(u32x4*)(qc + (size_t)r * 256 + EPI_COL(bj)) = pack8(v[bj][0] * qcscale, v[bj][1] * qcscale);
                } else {
                    float ss = 0.f;
#pragma unroll
                    for (int n = 0; n < 2; ++n) ss += (v[0][n][0] * v[0][n][0] + v[0][n][1] * v[0][n][1]) + (v[0][n][2] * v[0][n][2] + v[0][n][3] * v[0][n][3]);
                    ss += __shfl_xor(ss, 16); ss += __shfl_xor(ss, 32);
                    if (fq == 0) ssqkv[(size_t)r * 4 + wc] = ss;
                    *(u32x4*)(kvlat + (size_t)r * 256 + EPI_COL(0)) = pack8(v[0][0], v[0][1]);
                    *(u32x4*)(kvlat + (size_t)r * 256 + EPI_COL(1)) = (u32x4){0u, 0u, 0u, 0u};
                    if (wc == 0) { f32x4 a = v[1][0], b = v[1][1]; rope8(a, b, tc[mm][0], tc[mm][1], tc[mm][2], tc[mm][3], fq); *(u32x4*)(krope + (size_t)r * 32 + 8 * fq) = pack8(a, b); }
                }
            }
          }
    }
};
struct EpiQKV {
    static constexpr bool AFTER_DRAIN = false;
    const float* ssqq; const float* ssqkv; bf16_t* Q; bf16_t* KN; bf16_t* V; float qscale;
    __device__ __forceinline__ void operator()(const acc_t& acc, const Unit& u, int wr, int wc, int fr, int fq) const {
        const bool isq = u.pn < 5;
        const int g32a = isq ? u.pn * 8 + wc : (u.pn - 5) * 8 + wc, g32b = g32a + 4;
        f32x4 p4[2][4];
#pragma unroll
        for (int ai = 0; ai < 2; ++ai)
#pragma unroll
            for (int m = 0; m < 4; ++m) p4[ai][m] = *(const f32x4*)((isq ? ssqq : ssqkv) + (size_t)(u.pm * 256 + EPI_ROWS(ai, m)) * 4);
        EPI_FENCE;
#pragma unroll
        for (int ai = 0; ai < 2; ++ai)
#pragma unroll
            for (int m = 0; m < 4; ++m) { const int r = u.pm * 256 + EPI_ROWS(ai, m);
                const float rs = __builtin_amdgcn_rsqf(((p4[ai][m][0] + p4[ai][m][1]) + (p4[ai][m][2] + p4[ai][m][3])) * (isq ? (1.f / 256.f) : (1.f / 128.f)) + EPS) * (isq ? qscale : 1.0f);
#pragma unroll
                for (int bj = 0; bj < 2; ++bj) {
                    const f32x4 v0 = acc[ai][bj][m][0] * rs, v1 = acc[ai][bj][m][1] * rs;
                    const int g32 = bj ? g32b : g32a;
                    if (isq) { if (g32 < 36) *(u32x4*)(Q + (size_t)r * QW + g32 * 32 + 8 * fq) = pack8(v0, v1); }
                    else { const int h = g32 >> 2, part = g32 & 3;
                        bf16_t* dst = (part < 2 ? KN : V) + (size_t)r * KVW + h * 64 + (part & 1) * 32 + 8 * fq;
                        *(u32x4*)dst = pack8(v0, v1); }
                }
            }
    }
};
struct EpiWo {
    static constexpr bool AFTER_DRAIN = false;
    bf16_t* XS; float* ssq;
    __device__ __forceinline__ void operator()(const acc_t& acc, const Unit& u, int wr, int wc, int fr, int fq) const {
#pragma unroll
        for (int ai = 0; ai < 2; ++ai)
#pragma unroll
          for (int mh = 0; mh < 2; ++mh) {
            u32x4 w[2][2];
#pragma unroll
            for (int mm = 0; mm < 2; ++mm)
#pragma unroll
                for (int bj = 0; bj < 2; ++bj) w[mm][bj] = *(const u32x4*)(XS + (size_t)(u.pm * 256 + EPI_ROWS(ai, 2 * mh + mm)) * DM + u.pn * 256 + EPI_COL(bj));
            EPI_FENCE;
#pragma unroll
            for (int mm = 0; mm < 2; ++mm) { const int m = 2 * mh + mm; const int r = u.pm * 256 + EPI_ROWS(ai, m); float ss = 0.f;
#pragma unroll
                for (int bj = 0; bj < 2; ++bj) { const u32x4 x = w[mm][bj]; const size_t off = (size_t)r * DM + u.pn * 256 + EPI_COL(bj);
                    const f32x4 a = acc[ai][bj][m][0] + (f32x4){bflo(x.x), bfhi(x.x), bflo(x.y), bfhi(x.y)}, b = acc[ai][bj][m][1] + (f32x4){bflo(x.z), bfhi(x.z), bflo(x.w), bfhi(x.w)};
                    ss += (a[0] * a[0] + a[1] * a[1]) + (a[2] * a[2] + a[3] * a[3]) + (b[0] * b[0] + b[1] * b[1]) + (b[2] * b[2] + b[3] * b[3]);
                    *(u32x4*)(XS + off) = pack8(a, b); }
                ss += __shfl_xor(ss, 16); ss += __shfl_xor(ss, 32);
                if (fq == 0) ssq[(size_t)r * 16 + u.pn * 4 + wc] = ss; }
            EPI_FENCE;
          }
    }
};
struct EpiRouter {
    static constexpr bool AFTER_DRAIN = true;
    const float* ssq; const float* brg; const float* bre; float* tokw; float* tokr; int* list; unsigned* cnt;
    __device__ __forceinline__ void operator()(const acc_t&, const Unit&, int, int, int, int) const {}
    __device__ __forceinline__ void fused(const acc_t& acc, const Unit& u, int wr, int wc, int fr, int fq, LAS unsigned char* lds) const {
        LAS float* LG = (LAS float*)lds;
        int tid = ((wr * 4 + wc) << 6) | (fq * 16 + fr); asm volatile("" : "+v"(tid));
        f32x4 pq[4] = {};
        if (tid < 256) { const f32x4* pp = (const f32x4*)(ssq + (size_t)(u.pm * 256 + tid) * 16); pq[0] = pp[0]; pq[1] = pp[1]; pq[2] = pp[2]; pq[3] = pp[3]; }
        if (wc < 3) {
#pragma unroll
            for (int ai = 0; ai < 2; ++ai)
#pragma unroll
                for (int m = 0; m < 4; ++m) { const int row = EPI_ROWS(ai, m); const f32x4 v = acc[ai][0][m][0] + acc[ai][0][m][1];
#pragma unroll
                    for (int j = 0; j < 4; ++j) LG[row * 49 + 4 * (4 * wc + fq) + j] = v[j]; }
        }
        LAS unsigned* lc = (LAS unsigned*)(lds + 256 * 49 * 4);
        if (tid < 128) lc[tid] = 0u;
        LDS_WAIT(); __builtin_amdgcn_s_barrier(); asm volatile("" ::: "memory");
        int b = 0, tok = 0; unsigned rank = 0u;
        if (tid < 256) { tok = u.pm * 256 + tid; const LAS float* lg = LG + tid * 49;
            const f32x4 s4 = (pq[0] + pq[1]) + (pq[2] + pq[3]);
            const float rs = 1.0f / sqrtf(((s4[0] + s4[1]) + (s4[2] + s4[3])) * (1.f / DM) + EPS);
            float g[4]; int gs = 0; float gm;
#pragma unroll
            for (int j = 0; j < 4; ++j) g[j] = lg[j] * rs + brg[j];
            gm = g[0];
#pragma unroll
            for (int j = 1; j < 4; ++j) if (g[j] > gm) { gm = g[j]; gs = j; }
            float den = 0.f;
#pragma unroll
            for (int j = 0; j < 4; ++j) den += __expf(g[j] - gm);
            const float gate = 1.0f / den;
            float e[8];
#pragma unroll
            for (int j = 0; j < 8; ++j) e[j] = lg[16 + gs * 8 + j] * rs + bre[gs * 8 + j];
            int i1 = 0; float m1 = e[0];
#pragma unroll
            for (int j = 1; j < 8; ++j) if (e[j] > m1) { m1 = e[j]; i1 = j; }
            int i2 = -1; float m2 = -INFINITY;
#pragma unroll
            for (int j = 0; j < 8; ++j) if (j != i1 && e[j] > m2) { m2 = e[j]; i2 = j; }
            const float w1 = gate / (1.0f + __expf(m2 - m1)), w2 = gate - w1;
            const int elo = i1 < i2 ? i1 : i2, ehi = i1 < i2 ? i2 : i1; const float wlo = i1 < i2 ? w1 : w2, whi = i1 < i2 ? w2 : w1;
            const int pidx = elo * 7 - (elo * (elo - 1)) / 2 + (ehi - elo - 1);
            b = gs * 28 + pidx;
            tokw[(size_t)tok * 2] = wlo; tokw[(size_t)tok * 2 + 1] = whi; tokr[tok] = rs;
            rank = __hip_atomic_fetch_add(lc + b, 1u, __ATOMIC_RELAXED, __HIP_MEMORY_SCOPE_WORKGROUP);
        }
        LDS_WAIT(); __builtin_amdgcn_s_barrier(); asm volatile("" ::: "memory");
        if (tid < NBUCKET) { const unsigned c = lc[tid]; lc[128 + tid] = c ? atomicAdd(cnt + tid, c) : 0u; }
        LDS_WAIT(); __builtin_amdgcn_s_barrier(); asm volatile("" ::: "memory");
        if (tid < 256) list[(size_t)b * CAP + lc[128 + b] + rank] = tok;
    }
};
struct EpiMoeUp {
    static constexpr bool AFTER_DRAIN = false;
    static constexpr bool LDS_LIST = true;
    const float* tokr; const float* tokw; bf16_t* ACT;
    __device__ __forceinline__ void operator()(const acc_t& acc, const Unit& u, int wr, int wc, int fr, int fq) const {
        int tok[2][4]; float rsv[2][4], wv[2][4];
#pragma unroll
        for (int ai = 0; ai < 2; ++ai)
#pragma unroll
            for (int m = 0; m < 4; ++m) { const int lr = EPI_ROWS(ai, m); tok[ai][m] = ((const LAS int*)u.ll)[lr < u.nvalid ? lr : 0]; }
        LDS_WAIT(); EPI_FENCE;
#pragma unroll
        for (int ai = 0; ai < 2; ++ai)
#pragma unroll
            for (int m = 0; m < 4; ++m) { rsv[ai][m] = tokr[tok[ai][m]]; wv[ai][m] = tokw[(size_t)tok[ai][m] * 2 + (u.pn >> 1)]; }
        EPI_FENCE;
#pragma unroll
        for (int ai = 0; ai < 2; ++ai) { if (ai == 1 && u.half) break;
#pragma unroll
            for (int m = 0; m < 4; ++m) { const int lr = EPI_ROWS(ai, m); const float rs = rsv[ai][m], w = wv[ai][m];
                const float c1 = -rs * LOG2E, c2 = rs * rs * w;
#pragma unroll
                for (int bj = 0; bj < 2; ++bj) { const f32x4 ag = acc[ai][bj][m][0], au = acc[ai][bj][m][1]; const f32x4 t = ag * c1; f32x4 r;
#pragma unroll
                    for (int j = 0; j < 4; ++j) r[j] = __builtin_amdgcn_rcpf(1.0f + __builtin_amdgcn_exp2f(t[j]));
                    const f32x4 a = (ag * au) * (r * c2);
                    u32x2 o; o.x = pk2(a[0], a[1]); o.y = pk2(a[2], a[3]);
                    *(u32x2*)(ACT + (size_t)(u.aux + lr) * 512 + (u.pn >> 1) * 256 + (u.pn & 1) * 128 + bj * 64 + 16 * wc + 4 * fq) = o; }
            } }
    }
};
struct EpiMoeDown {
    static constexpr bool AFTER_DRAIN = false;
    static constexpr bool LDS_LIST = true;
    bf16_t* XS; float* ssq;
    __device__ __forceinline__ void operator()(const acc_t& acc, const Unit& u, int wr, int wc, int fr, int fq) const {
        int tok[2][4];
#pragma unroll
        for (int ai = 0; ai < 2; ++ai)
#pragma unroll
            for (int m = 0; m < 4; ++m) { const int lr = EPI_ROWS(ai, m); tok[ai][m] = ((const LAS int*)u.ll)[lr < u.nvalid ? lr : 0]; }
        LDS_WAIT(); EPI_FENCE;
#pragma unroll
        for (int ai = 0; ai < 2; ++ai) { if (ai == 1 && u.half) break;
            u32x4 w[4][2];
#pragma unroll
            for (int m = 0; m < 4; ++m)
#pragma unroll
                for (int bj = 0; bj < 2; ++bj) w[m][bj] = *(const u32x4*)(XS + (size_t)tok[ai][m] * DM + u.pn * 256 + EPI_COL(bj));
            EPI_FENCE;
#pragma unroll
            for (int m = 0; m < 4; ++m) { const int lr = EPI_ROWS(ai, m); const bool ok = lr < u.nvalid; float ss = 0.f;
#pragma unroll
                for (int bj = 0; bj < 2; ++bj) { const size_t off = (size_t)tok[ai][m] * DM + u.pn * 256 + EPI_COL(bj); const u32x4 x = w[m][bj];
                    const f32x4 a = acc[ai][bj][m][0] + (f32x4){bflo(x.x), bfhi(x.x), bflo(x.y), bfhi(x.y)}, b = acc[ai][bj][m][1] + (f32x4){bflo(x.z), bfhi(x.z), bflo(x.w), bfhi(x.w)};
                    ss += (a[0] * a[0] + a[1] * a[1]) + (a[2] * a[2] + a[3] * a[3]) + (b[0] * b[0] + b[1] * b[1]) + (b[2] * b[2] + b[3] * b[3]);
                    if (ok) *(u32x4*)(XS + off) = pack8(a, b); }
                ss += __shfl_xor(ss, 16); ss += __shfl_xor(ss, 32);
                if (ok && fq == 0) ssq[(size_t)tok[ai][m] * 16 + u.pn * 4 + wc] = ss;
            }
        }
    }
};
struct EpiInP {
    static constexpr bool AFTER_DRAIN = false;
    const float* ssq; bf16_t* Z; float qcscale;
    __device__ __forceinline__ void operator()(const acc_t& acc, const Unit& u, int wr, int wc, int fr, int fq) const {
        const float cscale = (u.pn == 3) ? qcscale : 1.0f;
#pragma unroll
        for (int ai = 0; ai < 2; ++ai) {
            f32x4 p[4][4];
#pragma unroll
            for (int m = 0; m < 4; ++m) { const f32x4* pp = (const f32x4*)(ssq + (size_t)(u.pm * 256 + EPI_ROWS(ai, m)) * 16);
#pragma unroll
                for (int q = 0; q < 4; ++q) p[m][q] = pp[q]; }
            EPI_FENCE;
#pragma unroll
            for (int m = 0; m < 4; ++m) { const int r = u.pm * 256 + EPI_ROWS(ai, m);
                const f32x4 s4 = (p[m][0] + p[m][1]) + (p[m][2] + p[m][3]); const float rs = cscale * __builtin_amdgcn_rsqf(((s4[0] + s4[1]) + (s4[2] + s4[3])) * (1.f / 1024.f) + EPS);
#pragma unroll
                for (int bj = 0; bj < 2; ++bj) *(u32x4*)(Z + (size_t)r * DM + u.pn * 256 + EPI_COL(bj)) = pack8(acc[ai][bj][m][0] * rs, acc[ai][bj][m][1] * rs); }
        }
    }
};

namespace att {
__device__ __forceinline__ int crow(int r, int hi) { return (r & 3) + 8 * (r >> 2) + 4 * hi; }
__device__ __forceinline__ void glds16(const void* gsrc, unsigned lds_dst) { unsigned keep;
    asm volatile("s_mov_b32 %0, m0\n\ts_mov_b32 m0, %2\n\ts_nop 0\n\tglobal_load_lds_dwordx4 %1, off\n\ts_mov_b32 m0, %0" : "=&s"(keep) : "v"(gsrc), "s"(lds_dst) : "memory"); }
__device__ __forceinline__ void glds16s(const void* sbase, unsigned voff, unsigned lds_dst) { unsigned keep;
    asm volatile("s_mov_b32 %0, m0\n\ts_mov_b32 m0, %3\n\ts_nop 0\n\tglobal_load_lds_dwordx4 %1, %2\n\ts_mov_b32 m0, %0" : "=&s"(keep) : "v"(voff), "s"(sbase), "s"(lds_dst) : "memory"); }
__device__ __forceinline__ float max3f(float a, float b, float c) { float r; asm("v_max3_f32 %0, %1, %2, %3" : "=v"(r) : "v"(a), "v"(b), "v"(c)); return r; }
__device__ __forceinline__ float max2f(float a, float b) { float r; asm("v_max_f32_e32 %0, %1, %2" : "=v"(r) : "v"(a), "v"(b)); return r; }
struct AttU { const bf16_t* Q; const bf16_t* Kn; const bf16_t* Kr; const bf16_t* V; bf16_t* O; const float* cs; const float* sn; int NT; };
template <int DQ, bool CAUSAL>
__device__ __forceinline__ void attn_unit(LAS unsigned char* L, const AttU& U, const AttU& N, const bool first, const bool hn, const int ldq, const int ldk, const int ldkr, const int ldv, const int ldo, const int wid, u32x4 (&qr)[DQ / 16]) {
    constexpr int ND = DQ / 16, NCH = DQ / 8, KSL = NCH * 1024, LV = 4 * KSL, LWS = LV + 4 * 8192, LOST = LWS + 2048, NG = 2 * ND;
    constexpr float THR = 8.0f;
    const int NT = U.NT; const bf16_t* Kn = U.Kn; const bf16_t* Kr = U.Kr; const bf16_t* Vp = U.V; bf16_t* Ow = U.O;
    int lane = hw_lane(); asm volatile("" : "+v"(lane));
    const int r32 = lane & 31, hi = lane >> 5;
    LAS float* wsf = (LAS float*)(L + LWS) + wid * 64;
    const unsigned lds0 = (unsigned)(uintptr_t)L;
    const unsigned koff = (unsigned)(lane * ldk + wid * 8) * 2u, kroff = (unsigned)(lane * ldkr + wid * 8) * 2u, voff = (unsigned)((16 * (wid & 3) + (lane >> 2)) * ldv + (wid >> 2) * 32 + (lane & 3) * 8) * 2u;
#define ATT_DMA_KX(KB, RB, t, slot) do { \
        glds16s((KB) + (size_t)(t) * 64 * ldk, koff, (unsigned)__builtin_amdgcn_readfirstlane(lds0 + (slot) * KSL + wid * 1024)); \
        if (NCH > 8 && wid < NCH - 8) glds16s((RB) + (size_t)(t) * 64 * ldkr, kroff, (unsigned)__builtin_amdgcn_readfirstlane(lds0 + (slot) * KSL + (8 + wid) * 1024)); } while (0)
#define ATT_DMA_K(t, slot) ATT_DMA_KX(Kn, Kr, t, slot)
#define ATT_DMA_KN(t, slot) ATT_DMA_KX(N.Kn, N.Kr, t, slot)
#define ATT_DMA_VX(VB, t, slot) glds16s((VB) + (size_t)(t) * 64 * ldv, voff, (unsigned)__builtin_amdgcn_readfirstlane(lds0 + LV + (slot) * 8192 + wid * 1024))
#define ATT_DMA_V(t, slot) ATT_DMA_VX(Vp, t, slot)
#define ATT_DMA_VN(t, slot) ATT_DMA_VX(N.V, t, slot)
#define ATT_SB() __builtin_amdgcn_sched_barrier(0)
#define ATT_VFRAG(dst, vp_, i_) do { const s16x4 lo_ = __builtin_bit_cast(s16x4, __builtin_amdgcn_ds_read_tr16_b64_v4i16((LAS s16x4*)((vp_) + (((i_) >> 1) & 3) * 1024 + ((i_) & 1) * 4096))); \
        const s16x4 hh_ = __builtin_bit_cast(s16x4, __builtin_amdgcn_ds_read_tr16_b64_v4i16((LAS s16x4*)((vp_) + (((i_) >> 1) & 3) * 1024 + ((i_) & 1) * 4096 + 512))); \
        dst = (bf16x8){lo_[0], lo_[1], lo_[2], lo_[3], hh_[0], hh_[1], hh_[2], hh_[3]}; } while (0)
#define ATT_KFRAG(g, slot) (*(const LAS bf16x8*)(L + (slot) * KSL + hi * 1024 + r32 * 16 + ((g) >> 1) * 2048 + ((g) & 1) * 512))
#define ATT_Q(i) __builtin_bit_cast(bf16x8, qr[i])
#define ATT_QLOAD(X, c0, c1, s0, s1) do { \
        _Pragma("unroll") for (int d0 = 0; d0 < ND; ++d0) qr[d0] = *(const u32x4*)((X).Q + (size_t)(wid * 32 + r32) * ldq + d0 * 16 + hi * 8); \
        if constexpr (DQ == 96) { const float* cp = (X).cs + (size_t)(wid * 32 + r32) * 16 + 8 * hi; const float* sp = (X).sn + (size_t)(wid * 32 + r32) * 16 + 8 * hi; \
            c0 = *(const f32x4*)cp; c1 = *(const f32x4*)(cp + 4); s0 = *(const f32x4*)sp; s1 = *(const f32x4*)(sp + 4); } } while (0)
#define ATT_QROPE(c0, c1, s0, s1) do { if constexpr (DQ == 96) { u32x4 a = qr[4], b = qr[5]; \
        _Pragma("unroll") for (int w = 0; w < 4; ++w) { const float xa0 = bflo(a[w]), xa1 = bfhi(a[w]), xb0 = bflo(b[w]), xb1 = bfhi(b[w]); \
            const float ca = w < 2 ? c0[2 * w] : c1[2 * w - 4], cb = w < 2 ? c0[2 * w + 1] : c1[2 * w - 3], sa = w < 2 ? s0[2 * w] : s1[2 * w - 4], sb = w < 2 ? s0[2 * w + 1] : s1[2 * w - 3]; \
            a[w] = pk2(xa0 * ca - xb0 * sa, xa1 * cb - xb1 * sb); b[w] = pk2(xb0 * ca + xa0 * sa, xb1 * cb + xa1 * sb); } \
        qr[4] = a; qr[5] = b; } } while (0)
    if (first) {
        ATT_DMA_K(0, 0); ATT_DMA_V(0, 0); ATT_DMA_K(1, 1); ATT_DMA_V(1, 1); ATT_DMA_K(2, 2); ATT_DMA_K(3, 3);
        f32x4 c0 = {}, c1 = {}, s0 = {}, s1 = {}; ATT_QLOAD(U, c0, c1, s0, s1); ATT_QROPE(c0, c1, s0, s1);
    }
    f32x16 o0 = {}, o1 = {};
    float mrun = -1e30f, lrun = 0.f;
    const int vb0 = ((lane >> 4) & 1) * 32 + (lane & 3) * 8 + (4 * hi + ((lane & 15) >> 2)) * 64;
    const int qrel = wid * 32 + r32;
    const int NTw = CAUSAL ? NT - 3 + (wid >> 1) : NT;
    const int kcnt = (NCH > 8 && wid < NCH - 8) ? 2 : 1;
    if (first) asm volatile("s_waitcnt vmcnt(0) lgkmcnt(0)" ::: "memory"); else asm volatile("s_waitcnt vmcnt(4) lgkmcnt(0)" ::: "memory");
    __builtin_amdgcn_s_barrier(); asm volatile("" ::: "memory");
    bf16x8 kf[NG];
#pragma unroll
    for (int g = 0; g < NG; ++g) kf[g] = ATT_KFRAG(g, 0);
    f32x16 sA0, sA1, sB0, sB1;
    bool resc = false;
#define ATT_DECIDE(C0, C1, t, MASK) do { \
        asm volatile("s_nop 15\n\ts_nop 7" : "+v"(C0), "+v"(C1));     \
        if (MASK) { int dq_ = qrel - (64 * ((t) - (NT - 4)) + 4 * hi); asm volatile("" : "+v"(dq_));     \
            _Pragma("unroll") for (int r = 0; r < 16; ++r) { const int kr_ = (r & 3) + 8 * (r >> 2); if (kr_ > dq_) C0[r] = -INFINITY; if (kr_ + 32 > dq_) C1[r] = -INFINITY; } } \
        float ra_ = max3f(C0[0], C0[1], C1[0]), rb_ = max3f(C0[2], C0[3], C1[1]); ra_ = max3f(ra_, C1[2], C1[3]); \
        _Pragma("unroll") for (int r = 4; r < 16; r += 4) { ra_ = max3f(ra_, C0[r], C0[r + 1]); rb_ = max3f(rb_, C0[r + 2], C0[r + 3]); ra_ = max3f(ra_, C1[r], C1[r + 1]); rb_ = max3f(rb_, C1[r + 2], C1[r + 3]); } \
        float rm_ = max2f(ra_, rb_); \
        { auto rr_ = __builtin_amdgcn_permlane32_swap(__float_as_uint(rm_), __float_as_uint(rm_), false, false); rm_ = max2f(__uint_as_float(rr_[0]), __uint_as_float(rr_[1])); } \
        resc = false; \
        if (__any(rm_ > mrun + THR)) { const float mnew_ = max2f(mrun, rm_), f_ = __builtin_amdgcn_exp2f(mrun - mnew_); mrun = mnew_; lrun *= f_; if (hi == 0) wsf[r32] = f_; resc = true; } } while (0)
#define ATT_RESC() do { if (resc) { LDS_WAIT(); _Pragma("unroll") for (int r = 0; r < 16; ++r) { const float ff_ = wsf[crow(r, hi)]; o0[r] *= ff_; o1[r] *= ff_; } } } while (0)
#define ATT_PHASE_A(C0, C1, P0, P1, vslot) do { \
        float sacc_ = 0.f; \
        _Pragma("unroll") for (int g_ = 0; g_ < NG; ++g_) { \
            if (g_ == 0) C0 = __builtin_amdgcn_mfma_f32_32x32x16_bf16(kf[0], ATT_Q(0), f32x16{}, 0, 0, 0); \
            else if (g_ == 1) C1 = __builtin_amdgcn_mfma_f32_32x32x16_bf16(kf[1], ATT_Q(0), f32x16{}, 0, 0, 0); \
            else if (g_ & 1) C1 = __builtin_amdgcn_mfma_f32_32x32x16_bf16(kf[g_], ATT_Q(g_ >> 1), C1, 0, 0, 0); else C0 = __builtin_amdgcn_mfma_f32_32x32x16_bf16(kf[g_], ATT_Q(g_ >> 1), C0, 0, 0, 0); \
            _Pragma("unroll") for (int e_ = (g_ * 32) / NG; e_ < ((g_ + 1) * 32) / NG; ++e_) { \
                sacc_ += (e_ < 16) ? P0[e_] : P1[e_ - 16]; \
                if (e_ & 1) { const int j_ = e_ >> 1; pw[j_ >> 2][j_ & 3] = (j_ < 8) ? pk2(P0[2 * j_], P0[2 * j_ + 1]) : pk2(P1[2 * j_ - 16], P1[2 * j_ - 15]); } } \
            ATT_SB(); } \
        lrun += sacc_; \
        { const LAS unsigned char* vp_ = L + LV + (vslot) * 8192 + vb0; ATT_VFRAG(vf[0], vp_, 0); ATT_VFRAG(vf[1], vp_, 1); ATT_VFRAG(vf[2], vp_, 2); ATT_VFRAG(vf[3], vp_, 3); } } while (0)
#define ATT_PHASE_B(C0, C1, kslot, vslot) do { \
        const LAS unsigned char* vp_ = L + LV + (vslot) * 8192 + vb0; \
        _Pragma("unroll") for (int i_ = 0; i_ < 8; ++i_) { \
            _Pragma("unroll") for (int g_ = (i_ * NG) / 8; g_ < ((i_ + 1) * NG) / 8; ++g_) kf[g_] = ATT_KFRAG(g_, kslot); \
            if (i_ & 1) o1 = __builtin_amdgcn_mfma_f32_32x32x16_bf16(__builtin_bit_cast(bf16x8, pw[i_ >> 1]), vf[i_ & 3], o1, 0, 0, 0); \
            else        o0 = __builtin_amdgcn_mfma_f32_32x32x16_bf16(__builtin_bit_cast(bf16x8, pw[i_ >> 1]), vf[i_ & 3], o0, 0, 0, 0); \
            if (i_ + 4 < 8) ATT_VFRAG(vf[i_ & 3], vp_, i_ + 4);        \
            _Pragma("unroll") for (int e_ = 4 * i_; e_ < 4 * i_ + 4; ++e_) { if (e_ < 16) C0[e_] = __builtin_amdgcn_exp2f(C0[e_] - mrun); else C1[e_ - 16] = __builtin_amdgcn_exp2f(C1[e_ - 16] - mrun); } \
            if (i_ < 4) asm volatile("" : "+v"(C0)); else asm volatile("" : "+v"(C1));        \
            ATT_SB(); } } while (0)
#define ATT_NDMA(t) ((((t) + 4 < NT || hn) ? kcnt : 0) + (((t) + 2 < NT || hn) ? 1 : 0))
#define ATT_END(t) do { const int nw_ = ATT_NDMA(t) + (((t) > 0) ? ATT_NDMA((t) - 1) : 0); \
        if (nw_ == 0) asm volatile("s_waitcnt vmcnt(0) lgkmcnt(0)" ::: "memory"); else if (nw_ == 1) asm volatile("s_waitcnt vmcnt(1) lgkmcnt(0)" ::: "memory"); \
        else if (nw_ == 2) asm volatile("s_waitcnt vmcnt(2) lgkmcnt(0)" ::: "memory"); else if (nw_ == 3) asm volatile("s_waitcnt vmcnt(3) lgkmcnt(0)" ::: "memory"); \
        else if (nw_ == 4) asm volatile("s_waitcnt vmcnt(4) lgkmcnt(0)" ::: "memory"); else if (nw_ == 5) asm volatile("s_waitcnt vmcnt(5) lgkmcnt(0)" ::: "memory"); \
        else asm volatile("s_waitcnt vmcnt(6) lgkmcnt(0)" ::: "memory"); \
        __builtin_amdgcn_s_barrier(); asm volatile("" ::: "memory"); } while (0)
    u32x4 pw[4]; bf16x8 vf[4];
    { asm volatile("s_waitcnt lgkmcnt(0)" ::: "memory"); __builtin_amdgcn_s_barrier(); asm volatile("" ::: "memory");
      if (4 < NT) ATT_DMA_K(4, 0); else if (hn) ATT_DMA_KN(0, 0);
      ATT_DMA_V(2, 2);
      sA0 = f32x16{}; sA1 = f32x16{};
#pragma unroll
      for (int g = 0; g < NG; ++g) { if (g & 1) sA1 = __builtin_amdgcn_mfma_f32_32x32x16_bf16(kf[g], ATT_Q(g >> 1), sA1, 0, 0, 0); else sA0 = __builtin_amdgcn_mfma_f32_32x32x16_bf16(kf[g], ATT_Q(g >> 1), sA0, 0, 0, 0); }
      if (CAUSAL && NT == 4) ATT_DECIDE(sA0, sA1, 0, 1); else ATT_DECIDE(sA0, sA1, 0, 0);
#pragma unroll
      for (int g = 0; g < NG; ++g) kf[g] = ATT_KFRAG(g, 1);
#pragma unroll
      for (int r = 0; r < 16; ++r) { sA0[r] = __builtin_amdgcn_exp2f(sA0[r] - mrun); sA1[r] = __builtin_amdgcn_exp2f(sA1[r] - mrun); }
      ATT_END(0); }
#define ATT_STEPM(C0, C1, P0, P1, t) do {         \
        ATT_DMA_K((t) + 4, (t) & 3); ATT_DMA_V((t) + 2, ((t) + 2) & 3); \
        ATT_PHASE_A(C0, C1, P0, P1, ((t) - 1) & 3); \
        ATT_DECIDE(C0, C1, t, 0); ATT_SB(); \
        ATT_PHASE_B(C0, C1, ((t) + 1) & 3, ((t) - 1) & 3); \
        if (kcnt == 2) asm volatile("s_waitcnt vmcnt(6) lgkmcnt(0)" ::: "memory"); else asm volatile("s_waitcnt vmcnt(4) lgkmcnt(0)" ::: "memory"); \
        __builtin_amdgcn_s_barrier(); asm volatile("" ::: "memory"); \
        ATT_RESC(); } while (0)
#define ATT_SDMA(t) do { if ((t) + 4 < NT) ATT_DMA_K((t) + 4, (t) & 3); else if (hn) ATT_DMA_KN((t) + 4 - NT, (t) & 3); \
        if ((t) + 2 < NT) ATT_DMA_V((t) + 2, ((t) + 2) & 3); else if (hn) ATT_DMA_VN((t) + 2 - NT, ((t) + 2) & 3); } while (0)
#define ATT_ENDT() do { if (hn) { if (kcnt == 2) asm volatile("s_waitcnt vmcnt(6) lgkmcnt(0)" ::: "memory"); else asm volatile("s_waitcnt vmcnt(4) lgkmcnt(0)" ::: "memory"); } \
        else asm volatile("s_waitcnt vmcnt(0) lgkmcnt(0)" ::: "memory");        \
        __builtin_amdgcn_s_barrier(); asm volatile("" ::: "memory"); } while (0)
#define ATT_STEPT(C0, C1, P0, P1, t) do {         \
        ATT_SDMA(t); \
        ATT_PHASE_A(C0, C1, P0, P1, ((t) - 1) & 3); \
        ATT_DECIDE(C0, C1, t, CAUSAL); ATT_SB(); \
        ATT_PHASE_B(C0, C1, ((t) + 1) & 3, ((t) - 1) & 3); \
        ATT_ENDT(); \
        ATT_RESC(); } while (0)
#define ATT_DRAIN(P0, P1, vslot) do { \
        float sacc_ = 0.f; \
        _Pragma("unroll") for (int r = 0; r < 16; ++r) sacc_ += P0[r] + P1[r]; \
        lrun += sacc_; \
        _Pragma("unroll") for (int k = 0; k < 2; ++k) { pw[k] = (u32x4){pk2(P0[8 * k], P0[8 * k + 1]), pk2(P0[8 * k + 2], P0[8 * k + 3]), pk2(P0[8 * k + 4], P0[8 * k + 5]), pk2(P0[8 * k + 6], P0[8 * k + 7])}; \
                                                  pw[2 + k] = (u32x4){pk2(P1[8 * k], P1[8 * k + 1]), pk2(P1[8 * k + 2], P1[8 * k + 3]), pk2(P1[8 * k + 4], P1[8 * k + 5]), pk2(P1[8 * k + 6], P1[8 * k + 7])}; } \
        const LAS unsigned char* vp_ = L + LV + (vslot) * 8192 + vb0; \
        _Pragma("unroll") for (int i_ = 0; i_ < 8; ++i_) { bf16x8 vv_; ATT_VFRAG(vv_, vp_, i_); \
            if (i_ & 1) o1 = __builtin_amdgcn_mfma_f32_32x32x16_bf16(__builtin_bit_cast(bf16x8, pw[i_ >> 1]), vv_, o1, 0, 0, 0); \
            else        o0 = __builtin_amdgcn_mfma_f32_32x32x16_bf16(__builtin_bit_cast(bf16x8, pw[i_ >> 1]), vv_, o0, 0, 0, 0); } } while (0)
    const int tail0 = (NT - 5 > 1) ? NT - 5 : 1;
#pragma unroll 1
    for (int t = 1; t < tail0; t += 2) {
        ATT_STEPM(sB0, sB1, sA0, sA1, t);
        ATT_STEPM(sA0, sA1, sB0, sB1, t + 1);
    }
    int t = tail0;
#pragma unroll 1
    for (; t + 1 < NTw; t += 2) {
        ATT_STEPT(sB0, sB1, sA0, sA1, t);
        ATT_STEPT(sA0, sA1, sB0, sB1, t + 1);
    }
    if (t < NTw) { ATT_STEPT(sB0, sB1, sA0, sA1, t); ++t; }
    if (CAUSAL && NTw < NT) {
        ATT_SDMA(t);
        if ((NTw - 1) & 1) ATT_DRAIN(sB0, sB1, (t - 1) & 3); else ATT_DRAIN(sA0, sA1, (t - 1) & 3);
        ATT_ENDT();
#pragma unroll 1
        for (++t; t < NT; ++t) { ATT_SDMA(t); ATT_ENDT(); }
    }
    f32x4 nc0 = {}, nc1 = {}, ns0 = {}, ns1 = {};
    if (hn) ATT_QLOAD(N, nc0, nc1, ns0, ns1);
    if (NTw == NT) ATT_DRAIN(sB0, sB1, (NT - 1) & 3);
    { int le = hw_lane(); asm volatile("" : "+v"(le)); const int r32e = le & 31, hie = le >> 5;
      LAS float* wse = (LAS float*)(L + LWS) + wid * 64;
      lrun += __shfl_xor(lrun, 32);
      if (hie == 0) wse[32 + r32e] = lrun;
      LDS_WAIT();
      bf16_t LAS* stg = (bf16_t LAS*)(L + LOST) + wid * 2048;
#pragma unroll
      for (int r = 0; r < 16; ++r) { const int orow = crow(r, hie); const float rl = __builtin_amdgcn_rcpf(wse[32 + orow]);
          stg[orow * 64 + r32e] = (bf16_t)(pk2(o0[r] * rl, 0.f) & 0xffffu); stg[orow * 64 + 32 + r32e] = (bf16_t)(pk2(o1[r] * rl, 0.f) & 0xffffu); }
      LDS_WAIT();
#pragma unroll
      for (int i = 0; i < 4; ++i) { const int row = i * 8 + (le >> 3), ch = le & 7; const u32x4 v = *(const LAS u32x4*)(stg + row * 64 + ch * 8); *(u32x4*)(Ow + (size_t)(wid * 32 + row) * ldo + ch * 8) = v; }
      asm volatile("s_waitcnt lgkmcnt(0)" ::: "memory"); __builtin_amdgcn_s_barrier(); asm volatile("" ::: "memory"); }
    if (hn) ATT_QROPE(nc0, nc1, ns0, ns1);
#undef ATT_DMA_KX
#undef ATT_DMA_KN
#undef ATT_DMA_VX
#undef ATT_DMA_VN
#undef ATT_QLOAD
#undef ATT_Q
#undef ATT_QROPE
#undef ATT_DMA_K
#undef ATT_DMA_V
#undef ATT_SB
#undef ATT_KFRAG
#undef ATT_VFRAG
#undef ATT_DECIDE
#undef ATT_RESC
#undef ATT_PHASE_A
#undef ATT_PHASE_B
#undef ATT_END
#undef ATT_NDMA
#undef ATT_STEPM
#undef ATT_SDMA
#undef ATT_ENDT
#undef ATT_STEPT
#undef ATT_DRAIN
}
}

struct Args { const float* in[24]; float* out; unsigned char* ws; };
struct Frame { LAS unsigned char* lds; unsigned* ctl; int tid, lane, wave, vcu, G; };
__device__ __forceinline__ Frame phase_frame(const Frame& F0) { Frame F = F0; int t = (F0.wave << 6) | hw_lane(); asm volatile("" : "+v"(t)); F.tid = t; F.lane = t & 63; F.wave = __builtin_amdgcn_readfirstlane(t >> 6);
    asm volatile("" : "+s"(F.vcu), "+s"(F.G));
    return F; }

struct TrD { const float* W; const float* gain; bf16_t* WT; int ldw, ldt, dcol0, rmk, rmo, k0, n0; };
__device__ __forceinline__ int tr_row(const TrD& d, int n) {
    if (d.rmk == 0) return n + d.rmo;
    if (d.rmk == 1) return n < 256 ? n : (n < 416 ? n + 256 : n - 160);
    return (n >> 2) * 8 + (n & 3) + 4 * d.rmo; }
__device__ __forceinline__ void tr_load(const TrD& d, f32x4 (&v)[8], float (&g)[8], int lane) {
    const int c4 = lane & 7, r0 = lane >> 3;
#pragma unroll
    for (int j = 0; j < 8; ++j) { const int kk = r0 + 8 * j; v[j] = *(const f32x4*)(d.W + (size_t)(d.k0 + kk) * d.ldw + d.n0 + 4 * c4); g[j] = d.gain ? d.gain[d.k0 + kk] : 1.0f; } }
__device__ __forceinline__ void tr_store(const TrD& d, const f32x4 (&v)[8], const float (&g)[8], LAS float* scr, int lane) {
    const int c4 = lane & 7, r0 = lane >> 3;
#pragma unroll
    for (int j = 0; j < 8; ++j) { const int kk = r0 + 8 * j; LAS float* p = scr + kk * 33 + 4 * c4; p[0] = v[j][0] * g[j]; p[1] = v[j][1] * g[j]; p[2] = v[j][2] * g[j]; p[3] = v[j][3] * g[j]; }
    LDS_WAIT(); asm volatile("" ::: "memory");
    const int c = lane & 7;
#pragma unroll
    for (int j = 0; j < 4; ++j) { const int n = (lane >> 3) + 8 * j; const LAS float* q = scr + (8 * c) * 33 + n;
        u32x4 o; o.x = pk2(q[0 * 33], q[1 * 33]); o.y = pk2(q[2 * 33], q[3 * 33]); o.z = pk2(q[4 * 33], q[5 * 33]); o.w = pk2(q[6 * 33], q[7 * 33]);
        *(u32x4*)(d.WT + (size_t)tr_row(d, d.n0 + n) * d.ldt + d.dcol0 + d.k0 + 8 * c) = o; }
    LDS_WAIT(); asm volatile("" ::: "memory");
}
__device__ __forceinline__ void zero16(bf16_t* p) { *(u32x4*)p = (u32x4){0u, 0u, 0u, 0u}; }

__device__ __forceinline__ TrD moe_item(const Args& a, unsigned char* ws, int r, int layer) {
    bf16_t* Wgu = (bf16_t*)(ws + WS_WGU); bf16_t* Wd = (bf16_t*)(ws + WS_WD);
    TrD d; d.gain = nullptr; d.dcol0 = 0; d.rmk = 0; d.rmo = 0;
    const int kind = r >> 12, rr = r & 4095, le = layer * 32 + (rr >> 7), q = rr & 127;
    if (kind < 2) { d.W = (kind ? a.in[21] : a.in[20]) + (size_t)le * 262144; d.ldw = 256; d.gain = a.in[15] + layer * 1024; d.WT = Wgu + (size_t)le * 524288; d.ldt = 1024; d.rmk = 2; d.rmo = kind; d.k0 = 64 * (q / 8); d.n0 = 32 * (q % 8); }
    else { const int e = le & 31;
        d.W = a.in[22] + (size_t)le * 262144; d.ldw = 1024; d.WT = Wd + ((size_t)layer * 4 + (e >> 3)) * (1024 * 2048); d.ldt = 2048; d.dcol0 = (e & 7) * 256; d.k0 = 64 * (q / 32); d.n0 = 32 * (q % 32); }
    return d; }
template <class Dec>
__device__ __forceinline__ void tr_run(int first, int count, int stride, Dec decode, LAS float* scr, int lane) {
    if (first < count) { f32x4 va[8], vb[8]; float ga[8], gb[8]; int it = first; TrD d0 = decode(it), d1 = d0; tr_load(d0, va, ga, lane);
#pragma unroll 1
        for (;;) { const int it1 = it + stride; const bool h1 = it1 < count; if (h1) { d1 = decode(it1); tr_load(d1, vb, gb, lane); }
            tr_store(d0, va, ga, scr, lane); if (!h1) break;
            it = it1 + stride; const bool h2 = it < count; if (h2) { d0 = decode(it); tr_load(d0, va, ga, lane); }
            tr_store(d1, vb, gb, scr, lane); if (!h2) break; } } }
__device__ __forceinline__ void p1_fill(const Frame& F0, const Args& a) {
    const Frame F = phase_frame(F0);
    int fb = (int)blockIdx.x, fn = F.G;
    if (F.G > 64) { if (fb < 64) return; fb -= 64; fn -= 64; }
    unsigned char* ws = a.ws;
    tr_run(fb * 8 + F.wave, 3 * 4096, fn * 8, [&](int it) -> TrD { return moe_item(a, ws, it, 1); }, (LAS float*)(F.lds + F.wave * 16384), F.lane);
    __syncthreads();
}

__device__ __forceinline__ void p0_prologue(const Frame& F0, const Args& a) {
    const Frame F = phase_frame(F0);
    unsigned char* ws = a.ws;
    LAS float* scr = (LAS float*)(F.lds + F.wave * 16384);
    const int gw = F.vcu * 8 + F.wave, NGW = F.G * 8, lane = F.lane;
    bf16_t* WinA = (bf16_t*)(ws + WS_WINA); bf16_t* Wqkv = (bf16_t*)(ws + WS_WQKV); bf16_t* WinP = (bf16_t*)(ws + WS_WINP);
    bf16_t* Wmem = (bf16_t*)(ws + WS_WMEM); bf16_t* Wo = (bf16_t*)(ws + WS_WO); bf16_t* Wgu = (bf16_t*)(ws + WS_WGU); bf16_t* Wd = (bf16_t*)(ws + WS_WD);
    constexpr int I_INA = 16 * 21, I_UQ = 4 * 36, I_UKV = 2 * 48, I_INP = 16 * 32, I_MEM = 16 * 16, I_WO = 512 + 128, I_MOE = 3 * 4096;
    constexpr int NITEMS = I_INA + I_UQ + I_UKV + I_INP + I_MEM + I_WO + I_MOE;
    auto decode = [&](int it) -> TrD { int r = it; TrD d; d.gain = nullptr; d.dcol0 = 0; d.rmk = 0; d.rmo = 0;
        if (r < I_INA) { d.W = a.in[4]; d.ldw = 672; d.gain = a.in[3]; d.WT = WinA; d.ldt = 1024; d.rmk = 1; d.k0 = 64 * (r / 21); d.n0 = 32 * (r % 21); return d; } r -= I_INA;
        if (r < I_UQ) { d.W = a.in[6]; d.ldw = 1152; d.gain = a.in[5]; d.WT = Wqkv; d.ldt = 256; d.k0 = 64 * (r / 36); d.n0 = 32 * (r % 36); return d; } r -= I_UQ;
        if (r < I_UKV) { d.W = a.in[8]; d.ldw = 1536; d.gain = a.in[7]; d.WT = Wqkv; d.ldt = 256; d.rmo = 1280; d.k0 = 64 * (r / 48); d.n0 = 32 * (r % 48); return d; } r -= I_UKV;
        if (r < I_INP) { d.W = a.in[9]; d.ldw = 1024; d.gain = a.in[3] + 1024; d.WT = WinP; d.ldt = 1024; d.k0 = 64 * (r / 32); d.n0 = 32 * (r % 32); return d; } r -= I_INP;
        if (r < I_MEM) { d.W = a.in[13]; d.ldw = 512; d.gain = a.in[12]; d.WT = Wmem; d.ldt = 1024; d.k0 = 64 * (r / 16); d.n0 = 32 * (r % 16); return d; } r -= I_MEM;
        if (r < I_WO) { const int l = r < 512 ? 0 : 1, q = r < 512 ? r : r - 512 + 12 * 32;
            d.W = a.in[14] + (size_t)l * 1048576; d.ldw = 1024; d.WT = Wo + (size_t)l * 1048576; d.ldt = 1024; d.k0 = 64 * (q / 32); d.n0 = 32 * (q % 32); return d; } r -= I_WO;
        return moe_item(a, ws, r, 0); };
    tr_run(gw, NITEMS, NGW, decode, scr, lane);
    const int gt = (F.vcu * 8 + F.wave) * 64 + lane, NGT = NGW * 64;
    for (int c = gt; c < 96 * 128; c += NGT) zero16(WinA + (size_t)672 * 1024 + (size_t)c * 8);
    for (int c = gt; c < 128 * 32; c += NGT) zero16(Wqkv + (size_t)1152 * 256 + (size_t)c * 8);
    for (int c = gt; c < 1536 * 16; c += NGT) zero16(Wqkv + (size_t)(1280 + c / 16) * 256 + 128 + (c % 16) * 8);
    for (int it = gw; it < 4 * 24 * 16; it += NGW) { const int g = it / 384, q = it % 384, c0 = 8 * (q / 16), n = 64 * (q % 16) + lane;
        const float* wg = a.in[10] + ((size_t)g * 192 + c0) * 192; const float* sc = a.in[11] + g * 192; const float* wo = a.in[14] + 1048576 + (size_t)g * 192 * 1024 + n;
        for (int e = lane; e < 384; e += 64) *(LAS f32x4*)(scr + 4 * e) = *(const f32x4*)(wg + 4 * e);
        if (lane < 48) *(LAS f32x4*)(scr + 1536 + 4 * lane) = *(const f32x4*)(sc + 4 * lane);
        LDS_WAIT(); asm volatile("" ::: "memory");
        float acc[8] = {0.f, 0.f, 0.f, 0.f, 0.f, 0.f, 0.f, 0.f};
#pragma unroll 4
        for (int d = 0; d < 192; d += 4) { const f32x4 s4 = *(const LAS f32x4*)(scr + 1536 + d);
            const f32x4 w4 = (f32x4){wo[(size_t)d * 1024] * s4[0], wo[(size_t)(d + 1) * 1024] * s4[1], wo[(size_t)(d + 2) * 1024] * s4[2], wo[(size_t)(d + 3) * 1024] * s4[3]};
#pragma unroll
            for (int i = 0; i < 8; ++i) { const f32x4 m4 = *(const LAS f32x4*)(scr + i * 192 + d); acc[i] += (m4[0] * w4[0] + m4[1] * w4[1]) + (m4[2] * w4[2] + m4[3] * w4[3]); } }
        *(u32x4*)(Wo + 1048576 + (size_t)n * 1024 + g * 192 + c0) = (u32x4){pk2(acc[0], acc[1]), pk2(acc[2], acc[3]), pk2(acc[4], acc[5]), pk2(acc[6], acc[7])};
        LDS_WAIT(); asm volatile("" ::: "memory"); }
    { bf16_t* Wr = (bf16_t*)(ws + WS_WR);
      for (int c = gt; c < 2 * 256 * 1024; c += NGT) { const int l = c >> 18, q = c & 262143, row = q >> 10, k = q & 1023; unsigned o = 0u;
          if (row < 96) { const int L = 4 * (row >> 3) + (row & 3); float w = 0.f;
              if (L < 4) w = a.in[16][((size_t)l * 1024 + k) * 4 + L]; else if (L >= 16) w = a.in[18][((size_t)l * 1024 + k) * 32 + (L - 16)];
              w *= a.in[15][l * 1024 + k]; const unsigned hi = pk2(w, 0.f) & 0xffffu; const float rem = w - __uint_as_float(hi << 16);
              o = (row & 4) ? (pk2(rem, 0.f) & 0xffffu) : hi; }
          Wr[c] = (bf16_t)o; } }
    { float* cs = (float*)(ws + WS_CS); float* sn = (float*)(ws + WS_SN); const int* pos = (const int*)a.in[2];
      for (int c = gt; c < T * 16; c += NGT) { const int t = c >> 4, i = c & 15; const float inv = powf(10000.0f, -(float)(2 * i) / 32.0f); const float ang = (float)pos[t] * inv; cs[c] = cosf(ang); sn[c] = sinf(ang); } }
    { bf16_t* XS = (bf16_t*)(ws + WS_XS); float* rstd0 = (float*)(ws + WS_RSTD0); bf16_t* MB = (bf16_t*)(ws + WS_MEMB); float* rstdm = (float*)(ws + WS_RSTDM);
      auto xload = [&](int m, f32x4 (&v)[4]) { if (m < T + TMEM) { const bool ism = m >= T; const int row = ism ? m - T : m; const f32x4* xr = (const f32x4*)((ism ? a.in[1] : a.in[0]) + (size_t)row * DM) + lane;
#pragma unroll
              for (int j = 0; j < 4; ++j) v[j] = xr[64 * j]; } };
      auto xdone = [&](int m, const f32x4 (&v)[4]) { if (m < T + TMEM) { const bool ism = m >= T; const int row = ism ? m - T : m; float s2 = 0.f;
#pragma unroll
              for (int j = 0; j < 4; ++j) s2 += (v[j][0] * v[j][0] + v[j][1] * v[j][1]) + (v[j][2] * v[j][2] + v[j][3] * v[j][3]);
              s2 = wave_sum(s2); const float rs = 1.0f / sqrtf(s2 * (1.f / DM) + EPS);
              u32x2* o8 = (u32x2*)((ism ? MB : XS) + (size_t)row * DM) + lane;
#pragma unroll
              for (int j = 0; j < 4; ++j) o8[64 * j] = (u32x2){pk2(v[j][0], v[j][1]), pk2(v[j][2], v[j][3])};
              if (lane == 0) (ism ? rstdm : rstd0)[row] = rs; } };
      f32x4 v0[4], v1[4], v2[4], v3[4];
      xload(gw, v0); xload(gw + NGW, v1); xload(gw + 2 * NGW, v2);
#pragma unroll 1
      for (int m = gw; m < T + TMEM; m += 4 * NGW) {
          xload(m + 3 * NGW, v3); xdone(m, v0);
          xload(m + 4 * NGW, v0); xdone(m + NGW, v1);
          xload(m + 5 * NGW, v1); xdone(m + 2 * NGW, v2);
          xload(m + 6 * NGW, v2); xdone(m + 3 * NGW, v3); } }
}

__device__ __forceinline__ void attn_phase(const Frame& F0, unsigned char* ws, bool mla, const bf16_t* QC, int ldqc) {
    const Frame F = phase_frame(F0);
    const bf16_t* Q = (const bf16_t*)(ws + WS_Q); const bf16_t* KN = (const bf16_t*)(ws + WS_KN); const bf16_t* KR = (const bf16_t*)(ws + WS_KROPE); const bf16_t* V = (const bf16_t*)(ws + WS_V);
    const bf16_t* MKV = (const bf16_t*)(ws + WS_MEMKV); bf16_t* CC = (bf16_t*)(ws + WS_CONCAT);
    if (mla) {
        const float* CS = (const float*)(ws + WS_CS); const float* SN = (const float*)(ws + WS_SN);
        auto mk = [&](int j) -> att::AttU { const int pidx = F.vcu + (j >> 1) * F.G, bh = pidx >> 2, pr = pidx & 3, b = bh / NHEAD, h = bh % NHEAD, qb = (j & 1) ? pr : 7 - pr;
            const size_t row0 = (size_t)b * SEQ, q0 = row0 + (size_t)qb * 256;
            return att::AttU{Q + q0 * QW + h * DQK, KN + row0 * KVW + h * 64, KR + row0 * 32, V + row0 * KVW + h * 64, CC + q0 * DM + h * 64, CS + q0 * 16, SN + q0 * 16, 4 * (qb + 1)}; };
        const int nu = 2 * ((NB * NHEAD * 4 - F.vcu + F.G - 1) / F.G);
        u32x4 qr[6]; att::AttU cur = mk(0); int j = 0;
#pragma unroll 1
        do { const bool hn = j + 1 < nu; const att::AttU nxt = hn ? mk(j + 1) : cur;
            att::attn_unit<96, true>(F.lds, cur, nxt, j == 0, hn, QW, KVW, 32, KVW, DM, F.wave, qr);
            cur = nxt; ++j; } while (j < nu);
    }
    {   auto mx = [&](int j) -> att::AttU { const int uidx = F.vcu + j * F.G, qb = uidx & 7, h = (uidx >> 3) & 3, b = uidx >> 5; const size_t q0 = (size_t)b * SEQ + (size_t)qb * 256;
            return att::AttU{QC + q0 * ldqc + h * 64, MKV + (size_t)b * MEML * 512 + h * 64, nullptr, MKV + (size_t)b * MEML * 512 + 256 + h * 64, CC + q0 * DM + 768 + h * 64, nullptr, nullptr, 4}; };
        const int nx = (NB * 4 * 8 - F.vcu + F.G - 1) / F.G;
        u32x4 qx[4]; att::AttU cur = mx(0); int j = 0;
#pragma unroll 1
        do { const bool hn = j + 1 < nx; const att::AttU nxt = hn ? mx(j + 1) : cur;
            att::attn_unit<64, false>(F.lds, cur, nxt, j == 0, hn, ldqc, 512, 0, 512, DM, F.wave, qx);
            cur = nxt; ++j; } while (j < nx); }
}

__device__ __forceinline__ void router_phase(const Frame& F, const Args& a, int layer, LAS unsigned char* listbuf) {
    unsigned char* ws = a.ws;
    for (int blk = F.vcu; blk < T / 256; blk += F.G) {
        SchedOne S{(const char*)(ws + WS_XS), (const char*)(ws + WS_WR) + (size_t)layer * (256 * 2048), blk};
        EpiRouter E{(const float*)(ws + WS_SSQX), a.in[17] + layer * 4, a.in[19] + layer * 32, (float*)(ws + WS_TOKW), (float*)(ws + WS_TOKR), (int*)(ws + WS_LIST), F.ctl + CW_CNT + layer * 128};
        pg8::gemm_run<EpiRouter, SchedOne, false>(F.lds, listbuf, S, E, 16, 1 << 30, 2048u, 2048u, F.wave);
        __syncthreads();
    }
}
__device__ __forceinline__ void moe_table(const Frame& F0, int layer) {
    const Frame F = phase_frame(F0);
    LAS int* tab = (LAS int*)(F.lds + L_TAB); const unsigned* cnt = F.ctl + CW_CNT + layer * 128;
    LAS unsigned short* items = (LAS unsigned short*)(tab + 240);
    int c = 0, v = 0, f = 0, x = 0, xf = 0;
    if (F.tid < 128) { if (F.tid < NBUCKET) { c = (int)__hip_atomic_load(cnt + F.tid, __ATOMIC_RELAXED, __HIP_MEMORY_SCOPE_AGENT); tab[128 + F.tid] = c; v = (c + 255) >> 8; f = (c >> 8) + ((c & 255) > 128 ? 1 : 0); }
        x = v; xf = f;
#pragma unroll
        for (int o = 1; o < 64; o <<= 1) { const int y = __shfl_up(x, o), yf = __shfl_up(xf, o); if (F.lane >= o) { x += y; xf += yf; } }
        if (F.tid == 63) { tab[127] = x; tab[126] = xf; } }
    __syncthreads();
    int tile0 = 0, fpos = 0;
    if (F.tid <= NBUCKET) { tile0 = x - v + (F.tid >= 64 ? tab[127] : 0); fpos = xf - f + (F.tid >= 64 ? tab[126] : 0); tab[F.tid] = tile0;
        if (F.tid == NBUCKET) { tab[121] = fpos; } }
    __syncthreads();
    { const int ntile = tab[NBUCKET], NF = tab[121], NH = ntile - NF;
      int sp = NF - 256; if (sp < 0) sp = 0; { int room = (64 - NH) / 2; if (room < 0) room = 0; if (sp > room) sp = room; }
      const int NFk = NF - sp;
      if (F.tid == 0) tab[120] = NFk + NH + 2 * sp;
      if (F.tid < NBUCKET) {
          for (int k = 0; k < f; ++k) { const int p = fpos + k, tile = tile0 + k;
              if (p < NFk) items[p] = (unsigned short)tile;
              else { const int q = NFk + NH + 2 * (p - NFk); items[q] = (unsigned short)(tile | (1 << 12)); items[q + 1] = (unsigned short)(tile | (2 << 12)); } }
          if (v > f) items[NFk + (tile0 - fpos)] = (unsigned short)((tile0 + f) | (1 << 12)); } }
    __syncthreads();
}

__device__ __forceinline__ void pool_diff_phase(const Frame& F0, unsigned char* ws) {
    const Frame F = phase_frame(F0);
    const bf16_t* Z = (const bf16_t*)(ws + WS_Z); bf16_t* CC = (bf16_t*)(ws + WS_CONCAT);
    constexpr int SR = 32, RR = 96, PITCH = 1536, NS = 256 / SR;
    const unsigned lds0 = (unsigned)(uintptr_t)F.lds;
    const int lane = F.lane, wave = F.wave;
    for (int blk = F.vcu; blk < T / 256; blk += F.G) {
        const int t0 = blk * 256, s0 = t0 & (SEQ - 1);
#define POOL_DMA(trow0, ringrow0, npc) do { _Pragma("unroll") for (int i_ = 0; i_ < (npc); ++i_) { const int p_ = wave * (npc) + i_, k_ = p_ * 64 + lane, r_ = k_ / 96, ch_ = k_ - r_ * 96; \
            att::glds16(Z + (size_t)((trow0) + r_) * DM + ch_ * 8, (unsigned)__builtin_amdgcn_readfirstlane(lds0 + (ringrow0) * PITCH + p_ * 1024)); } } while (0)
        __syncthreads();
        if (s0 != 0) POOL_DMA(t0 - 16, RR - 16, 3);
        POOL_DMA(t0, 0, 6);
#pragma unroll 1
        for (int s = 0; s < NS; ++s) {
            if (s == 0 || wave >= 6) asm volatile("s_waitcnt vmcnt(0)" ::: "memory"); else asm volatile("s_waitcnt vmcnt(8)" ::: "memory");
            __builtin_amdgcn_s_barrier(); asm volatile("" ::: "memory");
            if (s + 1 < NS) POOL_DMA(t0 + (s + 1) * SR, ((s + 1) % 3) * SR, 6);
            if (wave < 6) {
                const int run = F.tid / 96, q = F.tid - run * 96, g = q / 24, w = 2 << g, r0 = s * SR + run * 8;
                int pos = s0 + r0;
                const LAS unsigned char* col = F.lds + q * 16;
#define POOL_ROW(dst, r) do { const int rr_ = ((r) + RR) % RR; const u32x4 w_ = *(const LAS u32x4*)(col + rr_ * PITCH); \
                    dst[0] = bflo(w_.x); dst[1] = bfhi(w_.x); dst[2] = bflo(w_.y); dst[3] = bfhi(w_.y); dst[4] = bflo(w_.z); dst[5] = bfhi(w_.z); dst[6] = bflo(w_.w); dst[7] = bfhi(w_.w); } while (0)
                float S[8] = {0.f, 0.f, 0.f, 0.f, 0.f, 0.f, 0.f, 0.f};
                const int m = min(pos, w - 1);
                for (int j = 1; j <= m; ++j) { float y[8]; POOL_ROW(y, r0 - j);
#pragma unroll
                    for (int k = 0; k < 8; ++k) S[k] += y[k]; }
#pragma unroll 2
                for (int i = 0; i < 8; ++i) { float x[8]; POOL_ROW(x, r0 + i);
#pragma unroll
                    for (int k = 0; k < 8; ++k) S[k] += x[k];
                    const float inv = 1.0f / (float)min(pos + 1, w);
                    *(u32x4*)(CC + (size_t)(t0 + r0 + i) * DM + q * 8) = (u32x4){pk2(S[0] * inv - x[0], S[1] * inv - x[1]), pk2(S[2] * inv - x[2], S[3] * inv - x[3]), pk2(S[4] * inv - x[4], S[5] * inv - x[5]), pk2(S[6] * inv - x[6], S[7] * inv - x[7])};
                    if (pos + 1 >= w) { float y[8]; POOL_ROW(y, r0 + i - (w - 1));
#pragma unroll
                        for (int k = 0; k < 8; ++k) S[k] -= y[k]; }
                    ++pos; }
#undef POOL_ROW
            }
        }
#undef POOL_DMA
    }
    __syncthreads();
}
__device__ __forceinline__ void final_phase(const Frame& F0, const Args& a) {
    const Frame F = phase_frame(F0);
    const bf16_t* XS = (const bf16_t*)(a.ws + WS_XS); const float* gf = a.in[23];
    const int gw = F.vcu * 8 + F.wave, NGW = F.G * 8, lane = F.lane;
    f32x4 gv[4];
#pragma unroll
    for (int j = 0; j < 4; ++j) gv[j] = *((const f32x4*)gf + lane + 64 * j);
    auto fload = [&](int m, u32x2 (&w)[4]) { if (m < T) { const u32x2* xr = (const u32x2*)(XS + (size_t)m * DM) + lane;
#pragma unroll
            for (int j = 0; j < 4; ++j) w[j] = xr[64 * j]; } };
    auto fdone = [&](int m, const u32x2 (&w)[4]) { if (m < T) { f32x4 v[4]; float s2 = 0.f;
#pragma unroll
            for (int j = 0; j < 4; ++j) { v[j] = (f32x4){bflo(w[j].x), bfhi(w[j].x), bflo(w[j].y), bfhi(w[j].y)}; s2 += (v[j][0] * v[j][0] + v[j][1] * v[j][1]) + (v[j][2] * v[j][2] + v[j][3] * v[j][3]); }
            s2 = wave_sum(s2); const float rs = 1.0f / sqrtf(s2 * (1.f / DM) + EPS);
            f32x4* o = (f32x4*)(a.out + (size_t)m * DM) + lane;
#pragma unroll
            for (int j = 0; j < 4; ++j) o[64 * j] = v[j] * rs * gv[j]; } };
    u32x2 w0[4], w1[4], w2[4], w3[4];
    fload(gw, w0); fload(gw + NGW, w1); fload(gw + 2 * NGW, w2);
#pragma unroll 1
    for (int m = gw; m < T; m += 4 * NGW) {
        fload(m + 3 * NGW, w3); fdone(m, w0);
        fload(m + 4 * NGW, w0); fdone(m + NGW, w1);
        fload(m + 5 * NGW, w1); fdone(m + 2 * NGW, w2);
        fload(m + 6 * NGW, w2); fdone(m + 3 * NGW, w3); }
}

#ifndef PHASE_MASK
#define PHASE_MASK 0xFFFFFFFFu
#endif
#define PH(n) ((PHASE_MASK >> (n)) & 1u)
__global__ void __launch_bounds__(512, 2) fwd_kernel(Args args) {
    extern __shared__ __attribute__((aligned(16))) unsigned char lds_raw[];
    Frame F; F.lds = (LAS unsigned char*)lds_raw; F.tid = threadIdx.x; F.lane = F.tid & 63; F.wave = __builtin_amdgcn_readfirstlane(F.tid >> 6);
    __builtin_assume(gridDim.x <= 256u); __builtin_assume(blockIdx.x < gridDim.x);
    F.G = gridDim.x; { const int bx = blockIdx.x; F.vcu = (F.G % 8 == 0) ? (bx % 8) * (F.G / 8) + bx / 8 : bx; }
    unsigned char* ws = args.ws; F.ctl = (unsigned*)(ws + WS_CTL);
    for (int u = F.tid; u < (LDS_BYTES - RING_BYTES) / 4; u += 512) ((LAS unsigned*)(F.lds + RING_BYTES))[u] = 0u;
    __syncthreads();
    XcdBarrier bar = xcd_barrier_post(F.ctl + CW_BAR, (volatile LAS unsigned*)(F.lds + L_MISC) + 8, F.wave);
    LAS unsigned char* listbuf = F.lds + L_LIST;
    const float qcscale = 0.125f * LOG2E;
    const float qscale = 0.10206207261596577f * LOG2E;

    if (PH(0)) p0_prologue(F, args);
    xcd_barrier(bar);
    if (PH(1)) p1_fill(F, args);
    if (PH(1)) {   SchedPlainPart S; S.o.init(TMEM / 256, 2, F.G, (int)blockIdx.x); S.A = (const char*)(ws + WS_MEMB); S.B = (const char*)(ws + WS_WMEM); S.a_tile = 256 * 2048; S.b_tile = 256 * 2048;
        EpiRowScale E{(bf16_t*)(ws + WS_MEMKV), 512, (const float*)(ws + WS_RSTDM)};
        pg8::gemm_run<EpiRowScale, SchedPlainPart, false>(F.lds, listbuf, S, E, 16, 1 << 30, 2048u, 2048u, F.wave); }
    if (PH(2)) {   SchedPlain S; S.o.init(T / 256, 3, F.G, (int)blockIdx.x); S.A = (const char*)(ws + WS_XS); S.B = (const char*)(ws + WS_WINA); S.a_tile = 256 * 2048; S.b_tile = 256 * 2048;
        EpiInA E{(const float*)(ws + WS_RSTD0), (bf16_t*)(ws + WS_QLAT), (bf16_t*)(ws + WS_QC), (bf16_t*)(ws + WS_KVLAT), (bf16_t*)(ws + WS_KROPE), (float*)(ws + WS_SSQQ), (float*)(ws + WS_SSQKV),
                 (const float*)(ws + WS_CS), (const float*)(ws + WS_SN), qcscale};
        pg8::gemm_run<EpiInA, SchedPlain, false>(F.lds, listbuf, S, E, 16, 1 << 30, 2048u, 2048u, F.wave); }
    xcd_barrier(bar);
    if (PH(3)) {   SchedQKV S; S.o.init(T / 256, 11, F.G, (int)blockIdx.x); S.Aq = (const char*)(ws + WS_QLAT); S.Akv = (const char*)(ws + WS_KVLAT); S.B = (const char*)(ws + WS_WQKV);
        EpiQKV E{(const float*)(ws + WS_SSQQ), (const float*)(ws + WS_SSQKV), (bf16_t*)(ws + WS_Q), (bf16_t*)(ws + WS_KN), (bf16_t*)(ws + WS_V), qscale};
        pg8::gemm_run<EpiQKV, SchedQKV, false>(F.lds, listbuf, S, E, 4, 1 << 30, 512u, 512u, F.wave); }
    xcd_barrier(bar);
#pragma unroll 1
    for (int layer = 0; layer < 2; ++layer) {
        int gG = F.G, gB = (int)blockIdx.x, gV = F.vcu; asm volatile("" : "+s"(gG), "+s"(gB), "+s"(gV));
        { size_t zoff = 0; asm volatile("" : "+s"(zoff)); ws = args.ws + zoff; }
        if (layer == 0) {
            if (PH(4)) attn_phase(F, ws, true, (const bf16_t*)(ws + WS_QC), 256);
            xcd_barrier(bar);
        } else {
            if (PH(5)) {   SchedPlain S; S.o.init(T / 256, 4, gG, gB); S.A = (const char*)(ws + WS_XS); S.B = (const char*)(ws + WS_WINP); S.a_tile = 256 * 2048; S.b_tile = 256 * 2048;
                EpiInP E{(const float*)(ws + WS_SSQX), (bf16_t*)(ws + WS_Z), qcscale};
                pg8::gemm_run<EpiInP, SchedPlain, false>(F.lds, listbuf, S, E, 16, 1 << 30, 2048u, 2048u, F.wave); }
            xcd_barrier(bar);
            if (PH(6)) pool_diff_phase(F, ws);
            if (PH(7)) attn_phase(F, ws, false, (const bf16_t*)(ws + WS_Z) + 768, 1024);
            xcd_barrier(bar);
        }
        if (PH(9)) {   SchedPlain S; S.o.init(T / 256, 4, gG, gB); S.A = (const char*)(ws + WS_CONCAT); S.B = (const char*)(ws + WS_WO) + (size_t)layer * 2097152; S.a_tile = 256 * 2048; S.b_tile = 256 * 2048;
            EpiWo E{(bf16_t*)(ws + WS_XS), (float*)(ws + WS_SSQX)};
            pg8::gemm_run<EpiWo, SchedPlain, false>(F.lds, listbuf, S, E, 16, 1 << 30, 2048u, 2048u, F.wave); }
        xcd_barrier(bar);
        if (PH(10)) router_phase(F, args, layer, listbuf);
        xcd_barrier(bar);
        moe_table(F, layer);
        if (PH(11)) {   SchedMoe<false> S{(const LAS int*)(F.lds + L_TAB), gG, gV, (const char*)(ws + WS_XS), (const char*)(ws + WS_WGU) + (size_t)layer * (32u * 512u * 2048u), (const int*)(ws + WS_LIST)};
            EpiMoeUp E{(const float*)(ws + WS_TOKR), (const float*)(ws + WS_TOKW), (bf16_t*)(ws + WS_ACT)};
            pg8::gemm_run<EpiMoeUp, SchedMoe<false>, true>(F.lds, listbuf, S, E, 16, 1 << 30, 2048u, 2048u, F.wave); }
        xcd_barrier(bar);
        if (PH(12)) {   SchedMoe<true> S{(const LAS int*)(F.lds + L_TAB), gG, gV, (const char*)(ws + WS_ACT), (const char*)(ws + WS_WD) + (size_t)layer * (4u * 1024u * 4096u), (const int*)(ws + WS_LIST)};
            EpiMoeDown E{(bf16_t*)(ws + WS_XS), (float*)(ws + WS_SSQX)};
            pg8::gemm_run<EpiMoeDown, SchedMoe<true>, false>(F.lds, listbuf, S, E, 8, 4, 1024u, 4096u, F.wave); }
        xcd_barrier(bar);
    }
    if (PH(13)) final_phase(F, args);
}

extern "C" void kernel_launch(void* const* d_in, const int* in_sizes, int n_in, void* d_out, int out_size, void* d_ws, size_t ws_size, hipStream_t stream) {
    static int grid = 0;
    if (grid == 0) {
        if (n_in != 24 || in_sizes[0] != T * DM || out_size != T * DM || ws_size < WS_END) { fprintf(stderr, "kernel_launch: unexpected shapes (n_in %d, in0 %d, out %d, ws %zu); nothing launched\n", n_in, n_in > 0 ? in_sizes[0] : -1, out_size, ws_size); grid = -1; return; }
        int dev = 0, cus = 0, per_cu = 0;
        if (hipGetDevice(&dev) != hipSuccess || hipDeviceGetAttribute(&cus, hipDeviceAttributeMultiprocessorCount, dev) != hipSuccess) { grid = -1; return; }
        if (hipFuncSetAttribute((const void*)fwd_kernel, hipFuncAttributeMaxDynamicSharedMemorySize, LDS_BYTES) != hipSuccess) { fprintf(stderr, "kernel_launch: hipFuncSetAttribute failed\n"); grid = -1; return; }
        if (hipOccupancyMaxActiveBlocksPerMultiprocessor(&per_cu, (const void*)fwd_kernel, 512, LDS_BYTES) != hipSuccess || per_cu < 1) fprintf(stderr, "kernel_launch: occupancy query reports %d\n", per_cu);
        (void)hipGetLastError();
        grid = cus < 256 ? cus : 256;
    }
    if (grid < 0) return;
    if (hipMemsetAsync((char*)d_ws + WS_CTL, 0, CTL_ZERO_BYTES, stream) != hipSuccess) return;
    Args a{};
    for (int i = 0; i < 24; ++i) a.in[i] = (const float*)d_in[i];
    a.out = (float*)d_out; a.ws = (unsigned char*)d_ws;
    hipLaunchKernelGGL(fwd_kernel, dim3(grid), dim3(512), LDS_BYTES, stream, a);
}
```

```cpp
#include <hip/hip_runtime.h>
#include <cstdio>
#include <cstdint>

#define LAS __attribute__((address_space(3)))
#define GAS __attribute__((address_space(1)))
typedef unsigned short bf16_t;
typedef short bf16x8 __attribute__((ext_vector_type(8)));
typedef short s16x4 __attribute__((ext_vector_type(4)));
typedef float f32x2 __attribute__((ext_vector_type(2)));
typedef float f32x4 __attribute__((ext_vector_type(4)));
typedef float f32x16 __attribute__((ext_vector_type(16)));
typedef unsigned u32x2 __attribute__((ext_vector_type(2)));
typedef unsigned u32x4 __attribute__((ext_vector_type(4)));
typedef __bf16 bf16x2_t __attribute__((ext_vector_type(2)));

constexpr int T = 65536, DM = 1024, SEQ = 2048, NB = 32, MEML = 256, TMEM = NB * MEML;
constexpr int NHEAD = 12, DQK = 96, DV = 64, QW = NHEAD * DQK  , KVW = NHEAD * DV  ;
constexpr float EPS = 1e-6f;
constexpr int NBUCKET = 112, CAP = 65536;
constexpr float LOG2E = 1.4426950408889634f;

constexpr size_t MiB = 1u << 20;
constexpr size_t WS_CTL = 0, CTL_ZERO_BYTES = 64 * 1024;
constexpr size_t WS_WINA = 1 * MiB;
constexpr size_t WS_WQKV = 3 * MiB;
constexpr size_t WS_WINP = 5 * MiB;
constexpr size_t WS_WMEM = 8 * MiB;
constexpr size_t WS_WO = 9 * MiB;
constexpr size_t WS_WR = 13 * MiB;
constexpr size_t WS_WGU = 14 * MiB;
constexpr size_t WS_WD = 78 * MiB;
constexpr size_t WS_XS = 110 * MiB;
constexpr size_t WS_RSTD0 = 238 * MiB;
constexpr size_t WS_RSTDM = 238 * MiB + 512 * 1024;
constexpr size_t WS_CS = 239 * MiB, WS_SN = 243 * MiB;
constexpr size_t WS_MEMB = 247 * MiB;
constexpr size_t WS_MEMKV = 263 * MiB;
constexpr size_t WS_SSQQ = 271 * MiB, WS_SSQKV = 272 * MiB, WS_SSQX = 273 * MiB;
constexpr size_t WS_TOKW = 277 * MiB;
constexpr size_t WS_TOKR = 278 * MiB;
constexpr size_t WS_KROPE = 279 * MiB;
constexpr size_t WS_LIST = 283 * MiB;
constexpr size_t WS_QLAT = 311 * MiB, WS_QC = 343 * MiB, WS_KVLAT = 375 * MiB;
constexpr size_t WS_ACT = 311 * MiB;
constexpr size_t WS_Q = 407 * MiB, WS_KN = 551 * MiB, WS_V = 647 * MiB;
constexpr size_t WS_Z = 407 * MiB;
constexpr size_t WS_CONCAT = 743 * MiB;
constexpr size_t WS_END = 871 * MiB;
constexpr int CW_BAR = 4096, CW_CNT = 8192;

constexpr int RING_BYTES = 147456;
constexpr int L_MISC = RING_BYTES, L_LIST = RING_BYTES + 256, L_TAB = RING_BYTES + 256 + 2048, LDS_BYTES = RING_BYTES + 4096;

__device__ __forceinline__ unsigned pk2(float lo, float hi) { f32x2 v = {lo, hi}; bf16x2_t b = __builtin_convertvector(v, bf16x2_t); return __builtin_bit_cast(unsigned, b); }
__device__ __forceinline__ float bflo(unsigned w) { return __uint_as_float(w << 16); }
__device__ __forceinline__ float bfhi(unsigned w) { return __uint_as_float(w & 0xffff0000u); }
__device__ __forceinline__ u32x4 pack8(f32x4 a, f32x4 b) { u32x4 w; w.x = pk2(a[0], a[1]); w.y = pk2(a[2], a[3]); w.z = pk2(b[0], b[1]); w.w = pk2(b[2], b[3]); return w; }
__device__ __forceinline__ float wave_sum(float v) {
#pragma unroll
    for (int o = 1; o < 64; o <<= 1) v += __shfl_xor(v, o);
    return v;
}
#define LDS_WAIT() asm volatile("s_waitcnt lgkmcnt(0)" ::: "memory")
__device__ __forceinline__ int hw_lane() { int l; asm volatile("v_mbcnt_lo_u32_b32 %0, -1, 0\n\tv_mbcnt_hi_u32_b32 %0, -1, %0" : "=v"(l)); return l; }
#define VM_WAIT() asm volatile("s_waitcnt vmcnt(0)" ::: "memory")

#define XB_TMO      128
#define XB_XCNT(j)  (256  + 64 * (j))
#define XB_XSUB(j)  (1280 + 64 * (j))
#define XB_XGEN(j)  (2304 + 64 * (j))
#define XB_TOP      3328
#define XB_TOPGEN   3392
#define XCD_BAR_WORDS 3456
#define XB_SPIN_CAP (1u << 18)
__device__ __forceinline__ unsigned xb_ld(unsigned* p)              { return __hip_atomic_load(p, __ATOMIC_RELAXED, __HIP_MEMORY_SCOPE_AGENT); }
__device__ __forceinline__ unsigned xb_add(unsigned* p, unsigned v) { return __hip_atomic_fetch_add(p, v, __ATOMIC_RELAXED, __HIP_MEMORY_SCOPE_AGENT); }
__device__ __forceinline__ unsigned xb_xcc_id() { return (unsigned)__builtin_amdgcn_s_getreg((3 << 11) | 20) & 0xFu; }
#define XB_SPIN(cond, bar) do { unsigned _sp = 0; while (cond) { __builtin_amdgcn_s_sleep(1); \
    if ((++_sp & 255u) == 0u) { if (xb_ld(&(bar)[XB_TMO])) break; if (_sp > XB_SPIN_CAP) { atomicAdd(&(bar)[XB_TMO], 1u); break; } } } } while (0)
struct XcdBarrier { unsigned* bar; unsigned x; volatile LAS unsigned* st; int w; };
__device__ __forceinline__ XcdBarrier xcd_barrier_post(unsigned* bar, volatile LAS unsigned* st, int wave) {
    XcdBarrier b; b.bar = bar; b.x = xb_xcc_id(); b.st = st; b.w = wave;
    if (threadIdx.x == 0) (void)xb_add(&bar[XB_XCNT(b.x)], 1u);
    return b;
}
__device__ __forceinline__ void xcd_barrier_complete(unsigned* bar, unsigned x, unsigned& nloc, unsigned& nx) {
    const unsigned G = gridDim.x * gridDim.y * gridDim.z;
    unsigned sum, cnt, mine, sp = 0u;
    for (;;) {
        sum = 0u; cnt = 0u; mine = 0u;
#pragma unroll
        for (unsigned j = 0; j < 16; ++j) { const unsigned c = xb_ld(&bar[XB_XCNT(j)]); sum += c; cnt += (c > 0u) ? 1u : 0u; mine = (j == x) ? c : mine; }
        if (sum == G) break;
        __builtin_amdgcn_s_sleep(1);
        if ((++sp & 255u) == 0u) { if (xb_ld(&bar[XB_TMO])) break; if (sp > XB_SPIN_CAP) { atomicAdd(&bar[XB_TMO], 1u); break; } }
    }
    nloc = mine > 0u ? mine : 1u; nx = cnt > 0u ? cnt : 1u;
}
__device__ __forceinline__ void xcd_barrier(const XcdBarrier& b) {
    asm volatile("s_waitcnt vmcnt(0)" ::: "memory");
    __syncthreads();
    if (b.w == 0 && hw_lane() == 0) {
        unsigned zoff = 0u; asm volatile("" : "+s"(zoff));
        unsigned* bar = b.bar + zoff;
        __builtin_amdgcn_s_waitcnt(0);
        const unsigned bx = xb_xcc_id();
        unsigned nloc = b.st[0], nx = b.st[1];
        if (nloc == 0u) { xcd_barrier_complete(bar, bx, nloc, nx); b.st[0] = nloc; b.st[1] = nx; }
        const unsigned old = xb_add(&bar[XB_XSUB(bx)], 1u);
        const unsigned gen = old / nloc;
        if (old + 1u == (gen + 1u) * nloc) {
            __builtin_amdgcn_fence(__ATOMIC_RELEASE, "agent");
            asm volatile("s_waitcnt vmcnt(0)" ::: "memory");
            const unsigned og = xb_add(&bar[XB_TOP], 1u);
            const unsigned tg = og / nx;
            if (og + 1u == (tg + 1u) * nx) xb_add(&bar[XB_TOPGEN], 1u);
            else XB_SPIN(xb_ld(&bar[XB_TOPGEN]) == tg, bar);
            __builtin_amdgcn_fence(__ATOMIC_ACQUIRE, "agent");
            xb_add(&bar[XB_XGEN(bx)], 1u);
            asm volatile("s_waitcnt vmcnt(0)" ::: "memory");
        } else {
            XB_SPIN(xb_ld(&bar[XB_XGEN(bx)]) == gen, bar);
            __builtin_amdgcn_fence(__ATOMIC_ACQUIRE, "agent");
            asm volatile("s_waitcnt vmcnt(0)" ::: "memory");
        }
    }
    __syncthreads();
}

namespace pg8 {
constexpr int BM = 256, BK = 64, HALF = 128, HTB = HALF * BK * 2, NXCD = 8, WGM = 8;
__host__ __device__ __forceinline__ int lds_byte(int r, int c) { const int st = (r >> 4) * 2 + (c >> 5), rr = r & 15, cc = c & 31, ob = rr * 64 + cc * 2; return st * 1024 + (ob ^ (((ob >> 9) & 1) << 5)); }
__host__ __device__ __forceinline__ void stage_rc(int b, int& R, int& C) { const int st = b / 1024, sb = b % 1024, swz = sb ^ (((sb >> 9) & 1) << 5); R = (st >> 1) * 16 + swz / 64; C = (st & 1) * 32 + (swz % 64) / 2; }
__host__ __device__ __forceinline__ int perm32(int rho) { const int n = rho >> 4, i = rho & 15; return 8 * (i >> 2) + 4 * n + (i & 3); }

struct Unit { const char* A; const char* B; int bjump; int nvalid; const int* list; int pm, pn, aux; unsigned ll; int half; int nt; };

struct TileOrder {
    int nM, nN, nwg, G, c;
    __device__ __forceinline__ void init(int nM_, int nN_, int G_, int c_) { nM = nM_; nN = nN_; nwg = nM * nN; G = G_; c = c_; }
    __device__ __forceinline__ bool get(int i, int& pm, int& pn) const {
        const long L = (long)i * G + c; if (L >= nwg) return false;
        int wgid = (int)L; { const int q = nwg / NXCD, r = nwg % NXCD, xcd = wgid % NXCD, off = wgid / NXCD; wgid = (xcd < r ? xcd * (q + 1) : r * (q + 1) + (xcd - r) * q) + off; }
        const int nig = WGM * nN, gid = wgid / nig, fm = gid * WGM, gsz = (nM - fm) < WGM ? (nM - fm) : WGM;
        pm = fm + ((wgid % nig) % gsz); pn = (wgid % nig) / gsz; return true;
    }
};

template <class E_> struct epi_wants_list { template <class X> static constexpr bool get(decltype(X::LDS_LIST)*) { return X::LDS_LIST; } template <class X> static constexpr bool get(...) { return false; } static constexpr bool value = get<E_>(nullptr); };
template <class S_> struct sched_halves { template <class X> static constexpr bool get(decltype(X::HALVES)*) { return X::HALVES; } template <class X> static constexpr bool get(...) { return false; } static constexpr bool value = get<S_>(nullptr); };
template <class S_> struct sched_pernt { template <class X> static constexpr bool get(decltype(X::PERUNIT_NT)*) { return X::PERUNIT_NT; } template <class X> static constexpr bool get(...) { return false; } static constexpr bool value = get<S_>(nullptr); };
template <class Epi, class Sched, bool GATHER>
__device__ __forceinline__ void gemm_run(LAS unsigned char* lds, LAS unsigned char* listbuf, const Sched& S, const Epi& E, const int nt, const int jt, const unsigned lda2, const unsigned ldb2, const int wv) {
    int tid = (wv << 6) | hw_lane(); asm volatile("" : "+v"(tid));
    const int wid = __builtin_amdgcn_readfirstlane(tid >> 6), lane = tid & 63, wr = wid >> 2, wc = wid & 3, fr = lane & 15, fq = lane >> 4;
    int Rr[2]; unsigned Cc[2], voffB[2];
#pragma unroll
    for (int i = 0; i < 2; ++i) { int R, C; stage_rc(tid * 16 + i * 8192, R, C); const int Rb = (R & ~31) + perm32(R & 31); Rr[i] = R; Cc[i] = (unsigned)C * 2u; voffB[i] = (unsigned)Rb * ldb2 + (unsigned)C * 2u; }
    const size_t kstep = (size_t)(BK * 2);
    const size_t hstepB = (size_t)HALF * ldb2;
    const size_t hstepA = GATHER ? (size_t)0 : (size_t)HALF * lda2;
    const unsigned ldsw = (unsigned)wid * 1024u;
    const int aoff = lds_byte(wr * 64 + fr, fq * 8), boff = lds_byte(wc * 32 + fr, fq * 8);
#define PG8_SB(b, h) (((b) * 2 + (h)) * HTB)
#define PG8_AB (4 * HTB)
#define PG8_STAGE(bufoff, gbase, voff) do { _Pragma("unroll") for (int _i = 0; _i < 2; ++_i) \
        __builtin_amdgcn_global_load_lds((const unsigned*)((const char*)(gbase) + (voff)[_i]), (LAS unsigned*)(lds + (bufoff) + ldsw + _i * 8192), 16, 0, 0); } while (0)
#define PG8_STAGE_A(gbase, voff) PG8_STAGE(PG8_AB + (rs == 0 ? 4 : rs - 1) * HTB, gbase, voff)
#define PG8_LDA(dst) do { const LAS unsigned char* ap_ = lds + PG8_AB + rs * HTB + aoff; _Pragma("unroll") for (int m = 0; m < 4; ++m) _Pragma("unroll") for (int k = 0; k < 2; ++k) dst[m][k] = *(const LAS bf16x8*)(ap_ + m * 2048 + k * 1024); } while (0)
#define PG8_NEXT_RS() do { rs = (rs == 4) ? 0 : rs + 1; } while (0)
#define PG8_LDB(dst, b, h) do { _Pragma("unroll") for (int n = 0; n < 2; ++n) _Pragma("unroll") for (int k = 0; k < 2; ++k) dst[n][k] = *(const LAS bf16x8*)(lds + PG8_SB(b, h) + boff + n * 2048 + k * 1024); } while (0)
#define PG8_MMA(ai, bj, At, Bt) do { __builtin_amdgcn_s_setprio(1); _Pragma("unroll") for (int m = 0; m < 4; ++m) _Pragma("unroll") for (int n = 0; n < 2; ++n) _Pragma("unroll") for (int k = 0; k < 2; ++k) \
        acc[ai][bj][m][n] = __builtin_amdgcn_mfma_f32_16x16x32_bf16(Bt[n][k], At[m][k], acc[ai][bj][m][n], 0, 0, 0); __builtin_amdgcn_s_setprio(0); } while (0)
#define PG8_WAIT_V(n) asm volatile("s_waitcnt vmcnt(" #n ")" ::: "memory")
#define PG8_WAIT_L(n) asm volatile("s_waitcnt lgkmcnt(" #n ")" ::: "memory")
#define PG8_BAR __builtin_amdgcn_s_barrier()
#define PG8_SCHED __builtin_amdgcn_sched_barrier(0)
#define PG8_BPTR(X, tt) ((X).B + (size_t)(tt) * kstep + (((tt) >= jt) ? (X).bjump : 0))
    Unit cur, nxt; int ui = 0; cur.ll = 0u; nxt.ll = 0u; cur.half = 0; nxt.half = 0; cur.nt = 0; nxt.nt = 0;
    { const bool ok0_ = S.next(0, cur); if (!Sched::FULL && !ok0_) return; }
    unsigned offA[2][2];
#pragma unroll
    for (int h = 0; h < 2; ++h)
#pragma unroll
        for (int i = 0; i < 2; ++i) {
            const int row = h * HALF + Rr[i];
            if constexpr (GATHER) { int idx = cur.list[row]; if (row >= cur.nvalid) idx = 0; offA[h][i] = (unsigned)idx * lda2 + Cc[i]; }
            else offA[h][i] = (unsigned)Rr[i] * lda2 + Cc[i];
        }
    f32x4 acc[2][2][4][2];
#pragma unroll
    for (int a = 0; a < 2; ++a)
#pragma unroll
        for (int b = 0; b < 2; ++b)
#pragma unroll
            for (int m = 0; m < 4; ++m)
#pragma unroll
                for (int n = 0; n < 2; ++n) acc[a][b][m][n] = (f32x4){0.f, 0.f, 0.f, 0.f};
    bf16x8 At[4][2], B0[2][2], B1[2][2];
    int rs = 0;
    constexpr bool LLIST = epi_wants_list<Epi>::value;
    if constexpr (LLIST) __builtin_amdgcn_global_load_lds((const unsigned*)((const char*)cur.list + lane * 16), (LAS unsigned*)listbuf, 16, 0, 0);
    {
        const char* cA = cur.A; const char* cB = cur.B;
        PG8_STAGE(PG8_SB(0, 0), cB, voffB); PG8_STAGE(PG8_SB(0, 1), cB + hstepB, voffB); PG8_STAGE(PG8_AB, cA, offA[0]); PG8_STAGE(PG8_AB + HTB, cA + hstepA, offA[1]);
        if (wr == 1) PG8_BAR;
        PG8_WAIT_V(2); PG8_BAR;
        const char* cB1 = PG8_BPTR(cur, 1);
        PG8_STAGE(PG8_SB(1, 0), cB1, voffB); PG8_STAGE(PG8_AB + 2 * HTB, cA + kstep, offA[0]); PG8_STAGE(PG8_SB(1, 1), cB1 + hstepB, voffB); PG8_STAGE(PG8_AB + 3 * HTB, cA + kstep + hstepA, offA[1]);
        PG8_WAIT_V(8); PG8_BAR;
    }
    for (;;) {
        const bool has_next = S.next(ui + 1, nxt);
        const int unt = sched_pernt<Sched>::value ? cur.nt : nt;
        const bool chalf = sched_halves<Sched>::value && cur.half != 0;
        const char* cA = cur.A;
        const char* nA = has_next ? nxt.A : cur.A;
        const char* nB0 = has_next ? nxt.B : cur.B;
        const char* nB1 = has_next ? PG8_BPTR(nxt, 1) : PG8_BPTR(cur, 1);
#pragma unroll 1
        for (int t = 0; t < unt; t += 2) {
            const bool last = (t == unt - 2);
            const bool thalf = sched_halves<Sched>::value && (last ? (has_next ? nxt.half != 0 : chalf) : chalf);
            const bool w6 = sched_halves<Sched>::value && (chalf || thalf);
            if constexpr (GATHER) {
                if (last && has_next) {
                    const LAS int* lb = (const LAS int*)(listbuf + ((ui + 1) & 1) * 1024);
#pragma unroll
                    for (int h = 0; h < 2; ++h)
#pragma unroll
                        for (int i = 0; i < 2; ++i) { const int row = h * HALF + Rr[i]; int idx = lb[row]; if (row >= nxt.nvalid) idx = 0; offA[h][i] = (unsigned)idx * lda2 + Cc[i]; }
                }
            }
            const char* a2 = last ? nA : cA + (size_t)(t + 2) * kstep; const char* b2 = last ? nB0 : PG8_BPTR(cur, t + 2);
            const char* a3 = a2 + kstep;                              const char* b3 = last ? nB1 : PG8_BPTR(cur, t + 3);
            PG8_LDB(B0, 0, 0); PG8_LDB(B1, 0, 1); PG8_SCHED; PG8_LDA(At); PG8_STAGE_A(a2, offA[0]);
            if (w6) PG8_WAIT_V(6); else PG8_WAIT_V(10); PG8_WAIT_L(0); PG8_BAR; PG8_MMA(0, 0, At, B0); PG8_MMA(0, 1, At, B1); PG8_BAR; PG8_SCHED; PG8_NEXT_RS();
            if constexpr (LLIST || GATHER) {
                if (t == 0 && has_next) __builtin_amdgcn_global_load_lds((const unsigned*)((const char*)nxt.list + lane * 16), (LAS unsigned*)(listbuf + ((ui + 1) & 1) * 1024), 16, 0, 0);
            }
            if (!chalf) PG8_LDA(At); PG8_STAGE(PG8_SB(0, 0), b2, voffB); PG8_STAGE(PG8_SB(0, 1), b2 + hstepB, voffB); if (!thalf) PG8_STAGE_A(a2 + hstepA, offA[1]);
            if (w6) PG8_WAIT_V(6); else PG8_WAIT_V(10); PG8_WAIT_L(0); PG8_BAR; if (!chalf) { PG8_MMA(1, 0, At, B0); PG8_MMA(1, 1, At, B1); } PG8_BAR; PG8_SCHED; PG8_NEXT_RS();
            PG8_LDB(B0, 1, 0); PG8_LDB(B1, 1, 1); PG8_SCHED; PG8_LDA(At); PG8_STAGE_A(a3, offA[0]);
            if (w6) PG8_WAIT_V(6); else PG8_WAIT_V(10); PG8_WAIT_L(0); PG8_BAR; PG8_MMA(0, 0, At, B0); PG8_MMA(0, 1, At, B1); PG8_BAR; PG8_SCHED; PG8_NEXT_RS();
            if (!chalf) PG8_LDA(At); PG8_STAGE(PG8_SB(1, 0), b3, voffB); PG8_STAGE(PG8_SB(1, 1), b3 + hstepB, voffB); if (!thalf) PG8_STAGE_A(a3 + hstepA, offA[1]);
            if (w6) PG8_WAIT_V(6); else PG8_WAIT_V(10); PG8_WAIT_L(0); PG8_BAR; if (!chalf) { PG8_MMA(1, 0, At, B0); PG8_MMA(1, 1, At, B1); } PG8_BAR; PG8_SCHED; PG8_NEXT_RS();
        }
        if (wr == 0) PG8_BAR;
        if constexpr (!Epi::AFTER_DRAIN) { int fr_ = fr, fq_ = fq; asm volatile("" : "+v"(fr_), "+v"(fq_));
            if constexpr (LLIST) cur.ll = (unsigned)(uintptr_t)(listbuf + (ui & 1) * 1024);
            E(acc, cur, wr, wc, fr_, fq_); }
        if (!has_next) break;
#pragma unroll
        for (int a = 0; a < 2; ++a)
#pragma unroll
            for (int b = 0; b < 2; ++b)
#pragma unroll
                for (int m = 0; m < 4; ++m)
#pragma unroll
                    for (int n = 0; n < 2; ++n) acc[a][b][m][n] = (f32x4){0.f, 0.f, 0.f, 0.f};
        cur = nxt; ++ui;
        if (wr == 1) PG8_BAR;
    }
    PG8_WAIT_V(0);
    PG8_BAR;
    if constexpr (Epi::AFTER_DRAIN) E.fused(acc, cur, wr, wc, fr, fq, lds);
#undef PG8_AB
#undef PG8_STAGE_A
#undef PG8_NEXT_RS
#undef PG8_SB
#undef PG8_STAGE
#undef PG8_LDA
#undef PG8_LDB
#undef PG8_MMA
#undef PG8_WAIT_V
#undef PG8_WAIT_L
#undef PG8_BAR
#undef PG8_SCHED
#undef PG8_BPTR
}
}
using pg8::Unit;

template <bool FULL_> struct SchedPlainT {
    static constexpr bool FULL = FULL_;
    pg8::TileOrder o; const char* A; const char* B; size_t a_tile, b_tile;
    __device__ __forceinline__ bool next(int i, Unit& u) const { int pm, pn; if (!o.get(i, pm, pn)) return false;
        u.A = A + (size_t)pm * a_tile; u.B = B + (size_t)pn * b_tile; u.bjump = 0; u.nvalid = 256; u.list = nullptr; u.pm = pm; u.pn = pn; u.aux = 0; return true; }
};
typedef SchedPlainT<true> SchedPlain;
typedef SchedPlainT<false> SchedPlainPart;
struct SchedOne {
    static constexpr bool FULL = true;
    const char* A; const char* B; int pm;
    __device__ __forceinline__ bool next(int i, Unit& u) const { if (i != 0) return false;
        u.A = A + (size_t)pm * (256 * 2048); u.B = B; u.bjump = 0; u.nvalid = 256; u.list = nullptr; u.pm = pm; u.pn = 0; u.aux = 0; return true; }
};
struct SchedQKV {
    static constexpr bool FULL = true;
    static constexpr bool PERUNIT_NT = true;
    pg8::TileOrder o; const char* Aq; const char* Akv; const char* B;
    __device__ __forceinline__ bool next(int i, Unit& u) const { int pm, pn; if (!o.get(i, pm, pn)) return false;
        u.A = (pn < 5 ? Aq : Akv) + (size_t)pm * (256 * 512); u.B = B + (size_t)pn * (256 * 512); u.bjump = 0; u.nvalid = 256; u.list = nullptr; u.pm = pm; u.pn = pn; u.aux = 0; u.nt = pn < 5 ? 4 : 2; return true; }
};
__device__ __forceinline__ void pair_decode(int p, int& lo, int& hi) { int l = 0, rem = p; while (rem >= 7 - l) { rem -= 7 - l; ++l; } lo = l; hi = l + 1 + rem; }
template <bool DOWN> struct SchedMoe {
    static constexpr bool FULL = false;
    static constexpr bool HALVES = true;
    const LAS int* tab; int G, c; const char* A; const char* W; const int* list;
    __device__ __forceinline__ bool next(int i, Unit& u) const {
        const int nitems = tab[120]; const long L = (long)i * G + c; if (L >= (long)nitems * 4) return false;
        const int it = (int)((const LAS unsigned short*)(tab + 240))[L >> 2], tile = it & 4095, kind = it >> 12, pn = (int)(L & 3);
        int lo_ = 0, hi_ = NBUCKET - 1;
        while (lo_ < hi_) { const int mid = (lo_ + hi_ + 1) >> 1; if (tab[mid] <= tile) lo_ = mid; else hi_ = mid - 1; }
        const int b = __builtin_amdgcn_readfirstlane(lo_);
        const int tib = tile - __builtin_amdgcn_readfirstlane(tab[b]), cnt = __builtin_amdgcn_readfirstlane(tab[128 + b]);
        int elo, ehi; pair_decode(b % 28, elo, ehi); const int g = b / 28;
        int nv = min(256, cnt - tib * 256), roff = 0;
        if (kind == 2) { roff = 128; nv -= 128; }
        if (kind != 0) nv = min(nv, 128);
        u.nvalid = nv; u.list = list + (size_t)b * CAP + tib * 256 + roff; u.pm = tile; u.pn = pn; u.aux = tile * 256 + roff; u.half = kind != 0 ? 1 : 0;
        if (!DOWN) { u.A = A; u.B = W + ((size_t)(g * 8 + (pn < 2 ? elo : ehi)) * 512 + (pn & 1) * 256) * 2048; u.bjump = 0; }
        else { u.A = A + (size_t)(tile * 256 + roff) * 1024; u.B = W + (size_t)g * (1024 * 4096) + (size_t)pn * (256 * 4096) + elo * 512; u.bjump = (ehi - elo - 1) * 512; }
        return true;
    }
};

#define EPI_ROWS(ai, m) (128 * (ai) + 64 * wr + 16 * (m) + fr)
#define EPI_COL(bj) (128 * (bj) + 32 * wc + 8 * fq)
#define EPI_FENCE asm volatile("" ::: "memory")
typedef f32x4 acc_t[2][2][4][2];

struct EpiRowScale {
    static constexpr bool AFTER_DRAIN = false;
    bf16_t* O; int ldc; const float* rs;
    __device__ __forceinline__ void operator()(const acc_t& acc, const Unit& u, int wr, int wc, int fr, int fq) const {
        float sv[2][4];
#pragma unroll
        for (int ai = 0; ai < 2; ++ai)
#pragma unroll
            for (int m = 0; m < 4; ++m) sv[ai][m] = rs[u.pm * 256 + EPI_ROWS(ai, m)];
        EPI_FENCE;
#pragma unroll
        for (int ai = 0; ai < 2; ++ai)
#pragma unroll
            for (int m = 0; m < 4; ++m) { const int r = u.pm * 256 + EPI_ROWS(ai, m); const float s = sv[ai][m];
#pragma unroll
                for (int bj = 0; bj < 2; ++bj) *(u32x4*)(O + (size_t)r * ldc + u.pn * 256 + EPI_COL(bj)) = pack8(acc[ai][bj][m][0] * s, acc[ai][bj][m][1] * s); }
    }
};
__device__ __forceinline__ void rope8(f32x4& v0, f32x4& v1, f32x4 c0, f32x4 c1, f32x4 s0, f32x4 s1, int fq) {
    f32x4 p0, p1;
#pragma unroll
    for (int j = 0; j < 4; ++j) { p0[j] = __shfl_xor(v0[j], 32); p1[j] = __shfl_xor(v1[j], 32); }
    const float sg = (fq < 2) ? -1.f : 1.f;
    v0 = v0 * c0 + (p0 * s0) * sg; v1 = v1 * c1 + (p1 * s1) * sg;
}
struct EpiInA {
    static constexpr bool AFTER_DRAIN = false;
    const float* rstd0; bf16_t* qlat; bf16_t* qc; bf16_t* kvlat; bf16_t* krope; float* ssqq; float* ssqkv; const float* cs; const float* sn; float qcscale;
    __device__ __forceinline__ void operator()(const acc_t& acc, const Unit& u, int wr, int wc, int fr, int fq) const {
        float sv[2][4];
#pragma unroll
        for (int ai = 0; ai < 2; ++ai)
#pragma unroll
            for (int m = 0; m < 4; ++m) sv[ai][m] = rstd0[u.pm * 256 + EPI_ROWS(ai, m)];
        EPI_FENCE;
        const bool roper = (u.pn == 2) && (wc == 0);
#pragma unroll
        for (int ai = 0; ai < 2; ++ai)
#pragma unroll
          for (int mh = 0; mh < 2; ++mh) {
            f32x4 tc[2][4];
            if (roper) {
#pragma unroll
                for (int mm = 0; mm < 2; ++mm) { const size_t o = (size_t)(u.pm * 256 + EPI_ROWS(ai, 2 * mh + mm)) * 16 + 8 * (fq & 1);
                    tc[mm][0] = *(const f32x4*)(cs + o); tc[mm][1] = *(const f32x4*)(cs + o + 4); tc[mm][2] = *(const f32x4*)(sn + o); tc[mm][3] = *(const f32x4*)(sn + o + 4); }
            }
            EPI_FENCE;
#pragma unroll
            for (int mm = 0; mm < 2; ++mm) { const int m = 2 * mh + mm; const int r = u.pm * 256 + EPI_ROWS(ai, m); const float s = sv[ai][m];
                f32x4 v[2][2];
#pragma unroll
                for (int bj = 0; bj < 2; ++bj) { v[bj][0] = acc[ai][bj][m][0] * s; v[bj][1] = acc[ai][bj][m][1] * s; }
                if (u.pn == 0) {
                    float ss = 0.f;
#pragma unroll
                    for (int bj = 0; bj < 2; ++bj) { *(u32x4*)(qlat + (size_t)r * 256 + EPI_COL(bj)) = pack8(v[bj][0], v[bj][1]);
#pragma unroll
                        for (int n = 0; n < 2; ++n) ss += (v[bj][n][0] * v[bj][n][0] + v[bj][n][1] * v[bj][n][1]) + (v[bj][n][2] * v[bj][n][2] + v[bj][n][3] * v[bj][n][3]); }
                    ss += __shfl_xor(ss, 16); ss += __shfl_xor(ss, 32);
                    if (fq == 0) ssqq[(size_t)r * 4 + wc] = ss;
                } else if (u.pn == 1) {
#pragma unroll
                    for (int bj = 0; bj < 2; ++bj) *(u32x4*)(qc + (size_t)r * 256 + EPI_COL(bj)) = pack8(v[bj][0] * qcscale, v[bj][1] * qcscale);
                } else {
                    float ss = 0.f;
#pragma unroll
                    for (int n = 0; n < 2; ++n) ss += (v[0][n][0] * v[0][n][0] + v[0][n][1] * v[0][n][1]) + (v[0][n][2] * v[0][n][2] + v[0][n][3] * v[0][n][3]);
                    ss += __shfl_xor(ss, 16); ss += __shfl_xor(ss, 32);
                    if (fq == 0) ssqkv[(size_t)r * 4 + wc] = ss;
                    *(u32x4*)(kvlat + (size_t)r * 256 + EPI_COL(0)) = pack8(v[0][0], v[0][1]);
                    if (wc == 0) { f32x4 a = v[1][0], b = v[1][1]; rope8(a, b, tc[mm][0], tc[mm][1], tc[mm][2], tc[mm][3], fq); *(u32x4*)(krope + (size_t)r * 32 + 8 * fq) = pack8(a, b); }
                }
            }
          }
    }
};
struct EpiQKV {
    static constexpr bool AFTER_DRAIN = false;
    const float* ssqq; const float* ssqkv; bf16_t* Q; bf16_t* KN; bf16_t* V; float qscale;
    __device__ __forceinline__ void operator()(const acc_t& acc, const Unit& u, int wr, int wc, int fr, int fq) const {
        const bool isq = u.pn < 5;
        const int g32a = isq ? u.pn * 8 + wc : (u.pn - 5) * 8 + wc, g32b = g32a + 4;
        f32x4 p4[2][4];
#pragma unroll
        for (int ai = 0; ai < 2; ++ai)
#pragma unroll
            for (int m = 0; m < 4; ++m) p4[ai][m] = *(const f32x4*)((isq ? ssqq : ssqkv) + (size_t)(u.pm * 256 + EPI_ROWS(ai, m)) * 4);
        EPI_FENCE;
#pragma unroll
        for (int ai = 0; ai < 2; ++ai)
#pragma unroll
            for (int m = 0; m < 4; ++m) { const int r = u.pm * 256 + EPI_ROWS(ai, m);
                const float rs = __builtin_amdgcn_rsqf(((p4[ai][m][0] + p4[ai][m][1]) + (p4[ai][m][2] + p4[ai][m][3])) * (isq ? (1.f / 256.f) : (1.f / 128.f)) + EPS) * (isq ? qscale : 1.0f);
#pragma unroll
                for (int bj = 0; bj < 2; ++bj) {
                    const f32x4 v0 = acc[ai][bj][m][0] * rs, v1 = acc[ai][bj][m][1] * rs;
                    const int g32 = bj ? g32b : g32a;
                    if (isq) { if (g32 < 36) *(u32x4*)(Q + (size_t)r * QW + g32 * 32 + 8 * fq) = pack8(v0, v1); }
                    else { const int h = g32 >> 2, part = g32 & 3;
                        bf16_t* dst = (part < 2 ? KN : V) + (size_t)r * KVW + h * 64 + (part & 1) * 32 + 8 * fq;
                        *(u32x4*)dst = pack8(v0, v1); }
                }
            }
    }
};
struct EpiWo {
    static constexpr bool AFTER_DRAIN = false;
    bf16_t* XS; float* ssq;
    __device__ __forceinline__ void operator()(const acc_t& acc, const Unit& u, int wr, int wc, int fr, int fq) const {
#pragma unroll
        for (int ai = 0; ai < 2; ++ai)
#pragma unroll
          for (int mh = 0; mh < 2; ++mh) {
            u32x4 w[2][2];
#pragma unroll
            for (int mm = 0; mm < 2; ++mm)
#pragma unroll
                for (int bj = 0; bj < 2; ++bj) w[mm][bj] = *(const u32x4*)(XS + (size_t)(u.pm * 256 + EPI_ROWS(ai, 2 * mh + mm)) * DM + u.pn * 256 + EPI_COL(bj));
            EPI_FENCE;
#pragma unroll
            for (int mm = 0; mm < 2; ++mm) { const int m = 2 * mh + mm; const int r = u.pm * 256 + EPI_ROWS(ai, m); float ss = 0.f;
#pragma unroll
                for (int bj = 0; bj < 2; ++bj) { const u32x4 x = w[mm][bj]; const size_t off = (size_t)r * DM + u.pn * 256 + EPI_COL(bj);
                    const f32x4 a = acc[ai][bj][m][0] + (f32x4){bflo(x.x), bfhi(x.x), bflo(x.y), bfhi(x.y)}, b = acc[ai][bj][m][1] + (f32x4){bflo(x.z), bfhi(x.z), bflo(x.w), bfhi(x.w)};
                    ss += (a[0] * a[0] + a[1] * a[1]) + (a[2] * a[2] + a[3] * a[3]) + (b[0] * b[0] + b[1] * b[1]) + (b[2] * b[2] + b[3] * b[3]);
                    *(u32x4*)(XS + off) = pack8(a, b); }
                ss += __shfl_xor(ss, 16); ss += __shfl_xor(ss, 32);
                if (fq == 0) ssq[(size_t)r * 16 + u.pn * 4 + wc] = ss; }
            EPI_FENCE;
          }
    }
};
struct EpiRouter {
    static constexpr bool AFTER_DRAIN = true;
    const float* ssq; const float* brg; const float* bre; float* tokw; float* tokr; int* list; unsigned* cnt;
    __device__ __forceinline__ void operator()(const acc_t&, const Unit&, int, int, int, int) const {}
    __device__ __forceinline__ void fused(const acc_t& acc, const Unit& u, int wr, int wc, int fr, int fq, LAS unsigned char* lds) const {
        LAS float* LG = (LAS float*)lds;
        int tid = ((wr * 4 + wc) << 6) | (fq * 16 + fr); asm volatile("" : "+v"(tid));
        f32x4 pq[4] = {};
        if (tid < 256) { const f32x4* pp = (const f32x4*)(ssq + (size_t)(u.pm * 256 + tid) * 16); pq[0] = pp[0]; pq[1] = pp[1]; pq[2] = pp[2]; pq[3] = pp[3]; }
        if (wc < 3) {
#pragma unroll
            for (int ai = 0; ai < 2; ++ai)
#pragma unroll
                for (int m = 0; m < 4; ++m) { const int row = EPI_ROWS(ai, m); const f32x4 v = acc[ai][0][m][0] + acc[ai][0][m][1];
#pragma unroll
                    for (int j = 0; j < 4; ++j) LG[row * 49 + 4 * (4 * wc + fq) + j] = v[j]; }
        }
        LAS unsigned* lc = (LAS unsigned*)(lds + 256 * 49 * 4);
        if (tid < 128) lc[tid] = 0u;
        LDS_WAIT(); __builtin_amdgcn_s_barrier(); asm volatile("" ::: "memory");
        int b = 0, tok = 0; unsigned rank = 0u;
        if (tid < 256) { tok = u.pm * 256 + tid; const LAS float* lg = LG + tid * 49;
            const f32x4 s4 = (pq[0] + pq[1]) + (pq[2] + pq[3]);
            const float rs = 1.0f / sqrtf(((s4[0] + s4[1]) + (s4[2] + s4[3])) * (1.f / DM) + EPS);
            float g[4]; int gs = 0; float gm;
#pragma unroll
            for (int j = 0; j < 4; ++j) g[j] = lg[j] * rs + brg[j];
            gm = g[0];
#pragma unroll
            for (int j = 1; j < 4; ++j) if (g[j] > gm) { gm = g[j]; gs = j; }
            float den = 0.f;
#pragma unroll
            for (int j = 0; j < 4; ++j) den += __expf(g[j] - gm);
            const float gate = 1.0f / den;
            float e[8];
#pragma unroll
            for (int j = 0; j < 8; ++j) e[j] = lg[16 + gs * 8 + j] * rs + bre[gs * 8 + j];
            int i1 = 0; float m1 = e[0];
#pragma unroll
            for (int j = 1; j < 8; ++j) if (e[j] > m1) { m1 = e[j]; i1 = j; }
            int i2 = -1; float m2 = -INFINITY;
#pragma unroll
            for (int j = 0; j < 8; ++j) if (j != i1 && e[j] > m2) { m2 = e[j]; i2 = j; }
            const float w1 = gate / (1.0f + __expf(m2 - m1)), w2 = gate - w1;
            const int elo = i1 < i2 ? i1 : i2, ehi = i1 < i2 ? i2 : i1; const float wlo = i1 < i2 ? w1 : w2, whi = i1 < i2 ? w2 : w1;
            const int pidx = elo * 7 - (elo * (elo - 1)) / 2 + (ehi - elo - 1);
            b = gs * 28 + pidx;
            tokw[(size_t)tok * 2] = wlo; tokw[(size_t)tok * 2 + 1] = whi; tokr[tok] = rs;
            rank = __hip_atomic_fetch_add(lc + b, 1u, __ATOMIC_RELAXED, __HIP_MEMORY_SCOPE_WORKGROUP);
        }
        LDS_WAIT(); __builtin_amdgcn_s_barrier(); asm volatile("" ::: "memory");
        if (tid < NBUCKET) { const unsigned c = lc[tid]; lc[128 + tid] = c ? atomicAdd(cnt + tid, c) : 0u; }
        LDS_WAIT(); __builtin_amdgcn_s_barrier(); asm volatile("" ::: "memory");
        if (tid < 256) list[(size_t)b * CAP + lc[128 + b] + rank] = tok;
    }
};
struct EpiMoeUp {
    static constexpr bool AFTER_DRAIN = false;
    static constexpr bool LDS_LIST = true;
    const float* tokr; const float* tokw; bf16_t* ACT;
    __device__ __forceinline__ void operator()(const acc_t& acc, const Unit& u, int wr, int wc, int fr, int fq) const {
        int tok[2][4]; float rsv[2][4], wv[2][4];
#pragma unroll
        for (int ai = 0; ai < 2; ++ai)
#pragma unroll
            for (int m = 0; m < 4; ++m) { const int lr = EPI_ROWS(ai, m); tok[ai][m] = ((const LAS int*)u.ll)[lr < u.nvalid ? lr : 0]; }
        LDS_WAIT(); EPI_FENCE;
#pragma unroll
        for (int ai = 0; ai < 2; ++ai)
#pragma unroll
            for (int m = 0; m < 4; ++m) { rsv[ai][m] = tokr[tok[ai][m]]; wv[ai][m] = tokw[(size_t)tok[ai][m] * 2 + (u.pn >> 1)]; }
        EPI_FENCE;
#pragma unroll
        for (int ai = 0; ai < 2; ++ai) { if (ai == 1 && u.half) break;
#pragma unroll
            for (int m = 0; m < 4; ++m) { const int lr = EPI_ROWS(ai, m); const float rs = rsv[ai][m], w = wv[ai][m];
                const float c1 = -rs * LOG2E, c2 = rs * rs * w;
#pragma unroll
                for (int bj = 0; bj < 2; ++bj) { const f32x4 ag = acc[ai][bj][m][0], au = acc[ai][bj][m][1]; const f32x4 t = ag * c1; f32x4 r;
#pragma unroll
                    for (int j = 0; j < 4; ++j) r[j] = __builtin_amdgcn_rcpf(1.0f + __builtin_amdgcn_exp2f(t[j]));
                    const f32x4 a = (ag * au) * (r * c2);
                    u32x2 o; o.x = pk2(a[0], a[1]); o.y = pk2(a[2], a[3]);
                    *(u32x2*)(ACT + (size_t)(u.aux + lr) * 512 + (u.pn >> 1) * 256 + (u.pn & 1) * 128 + bj * 64 + 16 * wc + 4 * fq) = o; }
            } }
    }
};
struct EpiMoeDown {
    static constexpr bool AFTER_DRAIN = false;
    static constexpr bool LDS_LIST = true;
    bf16_t* XS; float* ssq;
    __device__ __forceinline__ void operator()(const acc_t& acc, const Unit& u, int wr, int wc, int fr, int fq) const {
        int tok[2][4];
#pragma unroll
        for (int ai = 0; ai < 2; ++ai)
#pragma unroll
            for (int m = 0; m < 4; ++m) { const int lr = EPI_ROWS(ai, m); tok[ai][m] = ((const LAS int*)u.ll)[lr < u.nvalid ? lr : 0]; }
        LDS_WAIT(); EPI_FENCE;
#pragma unroll
        for (int ai = 0; ai < 2; ++ai) { if (ai == 1 && u.half) break;
            u32x4 w[4][2];
#pragma unroll
            for (int m = 0; m < 4; ++m)
#pragma unroll
                for (int bj = 0; bj < 2; ++bj) w[m][bj] = *(const u32x4*)(XS + (size_t)tok[ai][m] * DM + u.pn * 256 + EPI_COL(bj));
            EPI_FENCE;
#pragma unroll
            for (int m = 0; m < 4; ++m) { const int lr = EPI_ROWS(ai, m); const bool ok = lr < u.nvalid; float ss = 0.f;
#pragma unroll
                for (int bj = 0; bj < 2; ++bj) { const size_t off = (size_t)tok[ai][m] * DM + u.pn * 256 + EPI_COL(bj); const u32x4 x = w[m][bj];
                    const f32x4 a = acc[ai][bj][m][0] + (f32x4){bflo(x.x), bfhi(x.x), bflo(x.y), bfhi(x.y)}, b = acc[ai][bj][m][1] + (f32x4){bflo(x.z), bfhi(x.z), bflo(x.w), bfhi(x.w)};
                    ss += (a[0] * a[0] + a[1] * a[1]) + (a[2] * a[2] + a[3] * a[3]) + (b[0] * b[0] + b[1] * b[1]) + (b[2] * b[2] + b[3] * b[3]);
                    if (ok) *(u32x4*)(XS + off) = pack8(a, b); }
                ss += __shfl_xor(ss, 16); ss += __shfl_xor(ss, 32);
                if (ok && fq == 0) ssq[(size_t)tok[ai][m] * 16 + u.pn * 4 + wc] = ss;
            }
        }
    }
};
struct EpiInP {
    static constexpr bool AFTER_DRAIN = false;
    const float* ssq; bf16_t* Z; float qcscale;
    __device__ __forceinline__ void operator()(const acc_t& acc, const Unit& u, int wr, int wc, int fr, int fq) const {
        const float cscale = (u.pn == 3) ? qcscale : 1.0f;
#pragma unroll
        for (int ai = 0; ai < 2; ++ai) {
            f32x4 p[4][4];
#pragma unroll
            for (int m = 0; m < 4; ++m) { const f32x4* pp = (const f32x4*)(ssq + (size_t)(u.pm * 256 + EPI_ROWS(ai, m)) * 16);
#pragma unroll
                for (int q = 0; q < 4; ++q) p[m][q] = pp[q]; }
            EPI_FENCE;
#pragma unroll
            for (int m = 0; m < 4; ++m) { const int r = u.pm * 256 + EPI_ROWS(ai, m);
                const f32x4 s4 = (p[m][0] + p[m][1]) + (p[m][2] + p[m][3]); const float rs = cscale * __builtin_amdgcn_rsqf(((s4[0] + s4[1]) + (s4[2] + s4[3])) * (1.f / 1024.f) + EPS);
#pragma unroll
                for (int bj = 0; bj < 2; ++bj) *(u32x4*)(Z + (size_t)r * DM + u.pn * 256 + EPI_COL(bj)) = pack8(acc[ai][bj][m][0] * rs, acc[ai][bj][m][1] * rs); }
        }
    }
};

namespace att {
__device__ __forceinline__ int crow(int r, int hi) { return (r & 3) + 8 * (r >> 2) + 4 * hi; }
__device__ __forceinline__ void glds16(const void* gsrc, unsigned lds_dst) { unsigned keep;
    asm volatile("s_mov_b32 %0, m0\n\ts_mov_b32 m0, %2\n\ts_nop 0\n\tglobal_load_lds_dwordx4 %1, off\n\ts_mov_b32 m0, %0" : "=&s"(keep) : "v"(gsrc), "s"(lds_dst) : "memory"); }
__device__ __forceinline__ void glds16s(const void* sbase, unsigned voff, unsigned lds_dst) { unsigned keep;
    asm volatile("s_mov_b32 %0, m0\n\ts_mov_b32 m0, %3\n\ts_nop 0\n\tglobal_load_lds_dwordx4 %1, %2\n\ts_mov_b32 m0, %0" : "=&s"(keep) : "v"(voff), "s"(sbase), "s"(lds_dst) : "memory"); }
__device__ __forceinline__ float max3f(float a, float b, float c) { float r; asm("v_max3_f32 %0, %1, %2, %3" : "=v"(r) : "v"(a), "v"(b), "v"(c)); return r; }
__device__ __forceinline__ float max2f(float a, float b) { float r; asm("v_max_f32_e32 %0, %1, %2" : "=v"(r) : "v"(a), "v"(b)); return r; }
struct AttU { const bf16_t* Q; const bf16_t* Kn; const bf16_t* Kr; const bf16_t* V; bf16_t* O; const float* cs; const float* sn; int NT; };
template <int DQ, bool CAUSAL>
__device__ __forceinline__ void attn_unit(LAS unsigned char* L, const AttU& U, const AttU& N, const bool first, const bool hn, const int ldq, const int ldk, const int ldkr, const int ldv, const int ldo, const int wid, u32x4 (&qr)[DQ / 16]) {
    constexpr int ND = DQ / 16, NCH = DQ / 8, KSL = NCH * 1024, LV = 4 * KSL, LWS = LV + 4 * 8192, LOST = LWS + 2048, NG = 2 * ND;
    constexpr float THR = 8.0f;
    const int NT = U.NT; const bf16_t* Kn = U.Kn; const bf16_t* Kr = U.Kr; const bf16_t* Vp = U.V; bf16_t* Ow = U.O;
    int lane = hw_lane(); asm volatile("" : "+v"(lane));
    const int r32 = lane & 31, hi = lane >> 5;
    LAS float* wsf = (LAS float*)(L + LWS) + wid * 64;
    const unsigned lds0 = (unsigned)(uintptr_t)L;
    const unsigned koff = (unsigned)(lane * ldk + wid * 8) * 2u, kroff = (unsigned)(lane * ldkr + wid * 8) * 2u, voff = (unsigned)((16 * (wid & 3) + (lane >> 2)) * ldv + (wid >> 2) * 32 + (lane & 3) * 8) * 2u;
#define ATT_DMA_KX(KB, RB, t, slot) do { \
        glds16s((KB) + (size_t)(t) * 64 * ldk, koff, (unsigned)__builtin_amdgcn_readfirstlane(lds0 + (slot) * KSL + wid * 1024)); \
        if (NCH > 8 && wid < NCH - 8) glds16s((RB) + (size_t)(t) * 64 * ldkr, kroff, (unsigned)__builtin_amdgcn_readfirstlane(lds0 + (slot) * KSL + (8 + wid) * 1024)); } while (0)
#define ATT_DMA_K(t, slot) ATT_DMA_KX(Kn, Kr, t, slot)
#define ATT_DMA_KN(t, slot) ATT_DMA_KX(N.Kn, N.Kr, t, slot)
#define ATT_DMA_VX(VB, t, slot) glds16s((VB) + (size_t)(t) * 64 * ldv, voff, (unsigned)__builtin_amdgcn_readfirstlane(lds0 + LV + (slot) * 8192 + wid * 1024))
#define ATT_DMA_V(t, slot) ATT_DMA_VX(Vp, t, slot)
#define ATT_DMA_VN(t, slot) ATT_DMA_VX(N.V, t, slot)
#define ATT_SB() __builtin_amdgcn_sched_barrier(0)
#define ATT_VFRAG(dst, vp_, i_) do { const s16x4 lo_ = __builtin_bit_cast(s16x4, __builtin_amdgcn_ds_read_tr16_b64_v4i16((LAS s16x4*)((vp_) + (((i_) >> 1) & 3) * 1024 + ((i_) & 1) * 4096))); \
        const s16x4 hh_ = __builtin_bit_cast(s16x4, __builtin_amdgcn_ds_read_tr16_b64_v4i16((LAS s16x4*)((vp_) + (((i_) >> 1) & 3) * 1024 + ((i_) & 1) * 4096 + 512))); \
        dst = (bf16x8){lo_[0], lo_[1], lo_[2], lo_[3], hh_[0], hh_[1], hh_[2], hh_[3]}; } while (0)
#define ATT_KFRAG(g, slot) (*(const LAS bf16x8*)(L + (slot) * KSL + hi * 1024 + r32 * 16 + ((g) >> 1) * 2048 + ((g) & 1) * 512))
#define ATT_Q(i) __builtin_bit_cast(bf16x8, qr[i])
#define ATT_QLOAD(X, c0, c1, s0, s1) do { \
        _Pragma("unroll") for (int d0 = 0; d0 < ND; ++d0) qr[d0] = *(const u32x4*)((X).Q + (size_t)(wid * 32 + r32) * ldq + d0 * 16 + hi * 8); \
        if constexpr (DQ == 96) { const float* cp = (X).cs + (size_t)(wid * 32 + r32) * 16 + 8 * hi; const float* sp = (X).sn + (size_t)(wid * 32 + r32) * 16 + 8 * hi; \
            c0 = *(const f32x4*)cp; c1 = *(const f32x4*)(cp + 4); s0 = *(const f32x4*)sp; s1 = *(const f32x4*)(sp + 4); } } while (0)
#define ATT_QROPE(c0, c1, s0, s1) do { if constexpr (DQ == 96) { u32x4 a = qr[4], b = qr[5]; \
        _Pragma("unroll") for (int w = 0; w < 4; ++w) { const float xa0 = bflo(a[w]), xa1 = bfhi(a[w]), xb0 = bflo(b[w]), xb1 = bfhi(b[w]); \
            const float ca = w < 2 ? c0[2 * w] : c1[2 * w - 4], cb = w < 2 ? c0[2 * w + 1] : c1[2 * w - 3], sa = w < 2 ? s0[2 * w] : s1[2 * w - 4], sb = w < 2 ? s0[2 * w + 1] : s1[2 * w - 3]; \
            a[w] = pk2(xa0 * ca - xb0 * sa, xa1 * cb - xb1 * sb); b[w] = pk2(xb0 * ca + xa0 * sa, xb1 * cb + xa1 * sb); } \
        qr[4] = a; qr[5] = b; } } while (0)
    if (first) {
        ATT_DMA_K(0, 0); ATT_DMA_V(0, 0); ATT_DMA_K(1, 1); ATT_DMA_V(1, 1); ATT_DMA_K(2, 2); ATT_DMA_K(3, 3);
        f32x4 c0 = {}, c1 = {}, s0 = {}, s1 = {}; ATT_QLOAD(U, c0, c1, s0, s1); ATT_QROPE(c0, c1, s0, s1);
    }
    f32x16 o0 = {}, o1 = {};
    float mrun = -1e30f, lrun = 0.f;
    const int vb0 = ((lane >> 4) & 1) * 32 + (lane & 3) * 8 + (4 * hi + ((lane & 15) >> 2)) * 64;
    const int qrel = wid * 32 + r32;
    const int NTw = CAUSAL ? NT - 3 + (wid >> 1) : NT;
    const int kcnt = (NCH > 8 && wid < NCH - 8) ? 2 : 1;
    if (first) asm volatile("s_waitcnt vmcnt(0) lgkmcnt(0)" ::: "memory"); else asm volatile("s_waitcnt vmcnt(4) lgkmcnt(0)" ::: "memory");
    __builtin_amdgcn_s_barrier(); asm volatile("" ::: "memory");
    bf16x8 kf[NG];
#pragma unroll
    for (int g = 0; g < NG; ++g) kf[g] = ATT_KFRAG(g, 0);
    f32x16 sA0, sA1, sB0, sB1;
    bool resc = false;
#define ATT_DECIDE(C0, C1, t, MASK) do { \
        asm volatile("s_nop 15\n\ts_nop 7" : "+v"(C0), "+v"(C1));     \
        if (MASK) { int dq_ = qrel - (64 * ((t) - (NT - 4)) + 4 * hi); asm volatile("" : "+v"(dq_));     \
            _Pragma("unroll") for (int r = 0; r < 16; ++r) { const int kr_ = (r & 3) + 8 * (r >> 2); if (kr_ > dq_) C0[r] = -INFINITY; if (kr_ + 32 > dq_) C1[r] = -INFINITY; } } \
        float ra_ = max3f(C0[0], C0[1], C1[0]), rb_ = max3f(C0[2], C0[3], C1[1]); ra_ = max3f(ra_, C1[2], C1[3]); \
        _Pragma("unroll") for (int r = 4; r < 16; r += 4) { ra_ = max3f(ra_, C0[r], C0[r + 1]); rb_ = max3f(rb_, C0[r + 2], C0[r + 3]); ra_ = max3f(ra_, C1[r], C1[r + 1]); rb_ = max3f(rb_, C1[r + 2], C1[r + 3]); } \
        float rm_ = max2f(ra_, rb_); \
        { auto rr_ = __builtin_amdgcn_permlane32_swap(__float_as_uint(rm_), __float_as_uint(rm_), false, false); rm_ = max2f(__uint_as_float(rr_[0]), __uint_as_float(rr_[1])); } \
        resc = false; \
        if (__any(rm_ > mrun + THR)) { const float mnew_ = max2f(mrun, rm_), f_ = __builtin_amdgcn_exp2f(mrun - mnew_); mrun = mnew_; lrun *= f_; if (hi == 0) wsf[r32] = f_; resc = true; } } while (0)
#define ATT_RESC() do { if (resc) { LDS_WAIT(); _Pragma("unroll") for (int r = 0; r < 16; ++r) { const float ff_ = wsf[crow(r, hi)]; o0[r] *= ff_; o1[r] *= ff_; } } } while (0)
#define ATT_PHASE_A(C0, C1, P0, P1, vslot) do { \
        float sacc_ = 0.f; \
        _Pragma("unroll") for (int g_ = 0; g_ < NG; ++g_) { \
            if (g_ == 0) C0 = __builtin_amdgcn_mfma_f32_32x32x16_bf16(kf[0], ATT_Q(0), f32x16{}, 0, 0, 0); \
            else if (g_ == 1) C1 = __builtin_amdgcn_mfma_f32_32x32x16_bf16(kf[1], ATT_Q(0), f32x16{}, 0, 0, 0); \
            else if (g_ & 1) C1 = __builtin_amdgcn_mfma_f32_32x32x16_bf16(kf[g_], ATT_Q(g_ >> 1), C1, 0, 0, 0); else C0 = __builtin_amdgcn_mfma_f32_32x32x16_bf16(kf[g_], ATT_Q(g_ >> 1), C0, 0, 0, 0); \
            _Pragma("unroll") for (int e_ = (g_ * 32) / NG; e_ < ((g_ + 1) * 32) / NG; ++e_) { \
                sacc_ += (e_ < 16) ? P0[e_] : P1[e_ - 16]; \
                if (e_ & 1) { const int j_ = e_ >> 1; pw[j_ >> 2][j_ & 3] = (j_ < 8) ? pk2(P0[2 * j_], P0[2 * j_ + 1]) : pk2(P1[2 * j_ - 16], P1[2 * j_ - 15]); } } \
            ATT_SB(); } \
        lrun += sacc_; \
        { const LAS unsigned char* vp_ = L + LV + (vslot) * 8192 + vb0; ATT_VFRAG(vf[0], vp_, 0); ATT_VFRAG(vf[1], vp_, 1); ATT_VFRAG(vf[2], vp_, 2); ATT_VFRAG(vf[3], vp_, 3); } } while (0)
#define ATT_PHASE_B(C0, C1, kslot, vslot) do { \
        const LAS unsigned char* vp_ = L + LV + (vslot) * 8192 + vb0; \
        _Pragma("unroll") for (int i_ = 0; i_ < 8; ++i_) { \
            _Pragma("unroll") for (int g_ = (i_ * NG) / 8; g_ < ((i_ + 1) * NG) / 8; ++g_) kf[g_] = ATT_KFRAG(g_, kslot); \
            if (i_ & 1) o1 = __builtin_amdgcn_mfma_f32_32x32x16_bf16(__builtin_bit_cast(bf16x8, pw[i_ >> 1]), vf[i_ & 3], o1, 0, 0, 0); \
            else        o0 = __builtin_amdgcn_mfma_f32_32x32x16_bf16(__builtin_bit_cast(bf16x8, pw[i_ >> 1]), vf[i_ & 3], o0, 0, 0, 0); \
            if (i_ + 4 < 8) ATT_VFRAG(vf[i_ & 3], vp_, i_ + 4);        \
            _Pragma("unroll") for (int e_ = 4 * i_; e_ < 4 * i_ + 4; ++e_) { if (e_ < 16) C0[e_] = __builtin_amdgcn_exp2f(C0[e_] - mrun); else C1[e_ - 16] = __builtin_amdgcn_exp2f(C1[e_ - 16] - mrun); } \
            if (i_ < 4) asm volatile("" : "+v"(C0)); else asm volatile("" : "+v"(C1));        \
            ATT_SB(); } } while (0)
#define ATT_NDMA(t) ((((t) + 4 < NT || hn) ? kcnt : 0) + (((t) + 2 < NT || hn) ? 1 : 0))
#define ATT_END(t) do { const int nw_ = ATT_NDMA(t) + (((t) > 0) ? ATT_NDMA((t) - 1) : 0); \
        if (nw_ == 0) asm volatile("s_waitcnt vmcnt(0) lgkmcnt(0)" ::: "memory"); else if (nw_ == 1) asm volatile("s_waitcnt vmcnt(1) lgkmcnt(0)" ::: "memory"); \
        else if (nw_ == 2) asm volatile("s_waitcnt vmcnt(2) lgkmcnt(0)" ::: "memory"); else if (nw_ == 3) asm volatile("s_waitcnt vmcnt(3) lgkmcnt(0)" ::: "memory"); \
        else if (nw_ == 4) asm volatile("s_waitcnt vmcnt(4) lgkmcnt(0)" ::: "memory"); else if (nw_ == 5) asm volatile("s_waitcnt vmcnt(5) lgkmcnt(0)" ::: "memory"); \
        else asm volatile("s_waitcnt vmcnt(6) lgkmcnt(0)" ::: "memory"); \
        __builtin_amdgcn_s_barrier(); asm volatile("" ::: "memory"); } while (0)
    u32x4 pw[4]; bf16x8 vf[4];
    { asm volatile("s_waitcnt lgkmcnt(0)" ::: "memory"); __builtin_amdgcn_s_barrier(); asm volatile("" ::: "memory");
      if (4 < NT) ATT_DMA_K(4, 0); else if (hn) ATT_DMA_KN(0, 0);
      ATT_DMA_V(2, 2);
      sA0 = f32x16{}; sA1 = f32x16{};
#pragma unroll
      for (int g = 0; g < NG; ++g) { if (g & 1) sA1 = __builtin_amdgcn_mfma_f32_32x32x16_bf16(kf[g], ATT_Q(g >> 1), sA1, 0, 0, 0); else sA0 = __builtin_amdgcn_mfma_f32_32x32x16_bf16(kf[g], ATT_Q(g >> 1), sA0, 0, 0, 0); }
      if (CAUSAL && NT == 4) ATT_DECIDE(sA0, sA1, 0, 1); else ATT_DECIDE(sA0, sA1, 0, 0);
#pragma unroll
      for (int g = 0; g < NG; ++g) kf[g] = ATT_KFRAG(g, 1);
#pragma unroll
      for (int r = 0; r < 16; ++r) { sA0[r] = __builtin_amdgcn_exp2f(sA0[r] - mrun); sA1[r] = __builtin_amdgcn_exp2f(sA1[r] - mrun); }
      ATT_END(0); }
#define ATT_STEPM(C0, C1, P0, P1, t) do {         \
        ATT_DMA_K((t) + 4, (t) & 3); ATT_DMA_V((t) + 2, ((t) + 2) & 3); \
        ATT_PHASE_A(C0, C1, P0, P1, ((t) - 1) & 3); \
        ATT_DECIDE(C0, C1, t, 0); ATT_SB(); \
        ATT_PHASE_B(C0, C1, ((t) + 1) & 3, ((t) - 1) & 3); \
        if (kcnt == 2) asm volatile("s_waitcnt vmcnt(6) lgkmcnt(0)" ::: "memory"); else asm volatile("s_waitcnt vmcnt(4) lgkmcnt(0)" ::: "memory"); \
        __builtin_amdgcn_s_barrier(); asm volatile("" ::: "memory"); \
        ATT_RESC(); } while (0)
#define ATT_SDMA(t) do { if ((t) + 4 < NT) ATT_DMA_K((t) + 4, (t) & 3); else if (hn) ATT_DMA_KN((t) + 4 - NT, (t) & 3); \
        if ((t) + 2 < NT) ATT_DMA_V((t) + 2, ((t) + 2) & 3); else if (hn) ATT_DMA_VN((t) + 2 - NT, ((t) + 2) & 3); } while (0)
#define ATT_ENDT() do { if (hn) { if (kcnt == 2) asm volatile("s_waitcnt vmcnt(6) lgkmcnt(0)" ::: "memory"); else asm volatile("s_waitcnt vmcnt(4) lgkmcnt(0)" ::: "memory"); } \
        else asm volatile("s_waitcnt vmcnt(0) lgkmcnt(0)" ::: "memory");        \
        __builtin_amdgcn_s_barrier(); asm volatile("" ::: "memory"); } while (0)
#define ATT_STEPT(C0, C1, P0, P1, t) do {         \
        ATT_SDMA(t); \
        ATT_PHASE_A(C0, C1, P0, P1, ((t) - 1) & 3); \
        ATT_DECIDE(C0, C1, t, CAUSAL); ATT_SB(); \
        ATT_PHASE_B(C0, C1, ((t) + 1) & 3, ((t) - 1) & 3); \
        ATT_ENDT(); \
        ATT_RESC(); } while (0)
#define ATT_DRAIN(P0, P1, vslot) do { \
        float sacc_ = 0.f; \
        _Pragma("unroll") for (int r = 0; r < 16; ++r) sacc_ += P0[r] + P1[r]; \
        lrun += sacc_; \
        _Pragma("unroll") for (int k = 0; k < 2; ++k) { pw[k] = (u32x4){pk2(P0[8 * k], P0[8 * k + 1]), pk2(P0[8 * k + 2], P0[8 * k + 3]), pk2(P0[8 * k + 4], P0[8 * k + 5]), pk2(P0[8 * k + 6], P0[8 * k + 7])}; \
                                                  pw[2 + k] = (u32x4){pk2(P1[8 * k], P1[8 * k + 1]), pk2(P1[8 * k + 2], P1[8 * k + 3]), pk2(P1[8 * k + 4], P1[8 * k + 5]), pk2(P1[8 * k + 6], P1[8 * k + 7])}; } \
        const LAS unsigned char* vp_ = L + LV + (vslot) * 8192 + vb0; \
        _Pragma("unroll") for (int i_ = 0; i_ < 8; ++i_) { bf16x8 vv_; ATT_VFRAG(vv_, vp_, i_); \
            if (i_ & 1) o1 = __builtin_amdgcn_mfma_f32_32x32x16_bf16(__builtin_bit_cast(bf16x8, pw[i_ >> 1]), vv_, o1, 0, 0, 0); \
            else        o0 = __builtin_amdgcn_mfma_f32_32x32x16_bf16(__builtin_bit_cast(bf16x8, pw[i_ >> 1]), vv_, o0, 0, 0, 0); } } while (0)
    const int tail0 = (NT - 5 > 1) ? NT - 5 : 1;
#pragma unroll 1
    for (int t = 1; t < tail0; t += 2) {
        ATT_STEPM(sB0, sB1, sA0, sA1, t);
        ATT_STEPM(sA0, sA1, sB0, sB1, t + 1);
    }
    int t = tail0;
#pragma unroll 1
    for (; t + 1 < NTw; t += 2) {
        ATT_STEPT(sB0, sB1, sA0, sA1, t);
        ATT_STEPT(sA0, sA1, sB0, sB1, t + 1);
    }
    if (t < NTw) { ATT_STEPT(sB0, sB1, sA0, sA1, t); ++t; }
    if (CAUSAL && NTw < NT) {
        ATT_SDMA(t);
        if ((NTw - 1) & 1) ATT_DRAIN(sB0, sB1, (t - 1) & 3); else ATT_DRAIN(sA0, sA1, (t - 1) & 3);
        ATT_ENDT();
#pragma unroll 1
        for (++t; t < NT; ++t) { ATT_SDMA(t); ATT_ENDT(); }
    }
    f32x4 nc0 = {}, nc1 = {}, ns0 = {}, ns1 = {};
    if (hn) ATT_QLOAD(N, nc0, nc1, ns0, ns1);
    if (NTw == NT) ATT_DRAIN(sB0, sB1, (NT - 1) & 3);
    { int le = hw_lane(); asm volatile("" : "+v"(le)); const int r32e = le & 31, hie = le >> 5;
      LAS float* wse = (LAS float*)(L + LWS) + wid * 64;
      lrun += __shfl_xor(lrun, 32);
      if (hie == 0) wse[32 + r32e] = lrun;
      LDS_WAIT();
      bf16_t LAS* stg = (bf16_t LAS*)(L + LOST) + wid * 2048;
#pragma unroll
      for (int r = 0; r < 16; ++r) { const int orow = crow(r, hie); const float rl = __builtin_amdgcn_rcpf(wse[32 + orow]);
          stg[orow * 64 + r32e] = (bf16_t)(pk2(o0[r] * rl, 0.f) & 0xffffu); stg[orow * 64 + 32 + r32e] = (bf16_t)(pk2(o1[r] * rl, 0.f) & 0xffffu); }
      LDS_WAIT();
#pragma unroll
      for (int i = 0; i < 4; ++i) { const int row = i * 8 + (le >> 3), ch = le & 7; const u32x4 v = *(const LAS u32x4*)(stg + row * 64 + ch * 8); *(u32x4*)(Ow + (size_t)(wid * 32 + row) * ldo + ch * 8) = v; }
      asm volatile("s_waitcnt lgkmcnt(0)" ::: "memory"); __builtin_amdgcn_s_barrier(); asm volatile("" ::: "memory"); }
    if (hn) ATT_QROPE(nc0, nc1, ns0, ns1);
#undef ATT_DMA_KX
#undef ATT_DMA_KN
#undef ATT_DMA_VX
#undef ATT_DMA_VN
#undef ATT_QLOAD
#undef ATT_Q
#undef ATT_QROPE
#undef ATT_DMA_K
#undef ATT_DMA_V
#undef ATT_SB
#undef ATT_KFRAG
#undef ATT_VFRAG
#undef ATT_DECIDE
#undef ATT_RESC
#undef ATT_PHASE_A
#undef ATT_PHASE_B
#undef ATT_END
#undef ATT_NDMA
#undef ATT_STEPM
#undef ATT_SDMA
#undef ATT_ENDT
#undef ATT_STEPT
#undef ATT_DRAIN
}
}

struct Args { const float* in[24]; float* out; unsigned char* ws; };
struct Frame { LAS unsigned char* lds; unsigned* ctl; int tid, lane, wave, vcu, G; };
__device__ __forceinline__ Frame phase_frame(const Frame& F0) { Frame F = F0; int t = (F0.wave << 6) | hw_lane(); asm volatile("" : "+v"(t)); F.tid = t; F.lane = t & 63; F.wave = __builtin_amdgcn_readfirstlane(t >> 6);
    asm volatile("" : "+s"(F.vcu), "+s"(F.G));
    return F; }

struct TrD { const float* W; const float* gain; bf16_t* WT; int ldw, ldt, dcol0, rmk, rmo, k0, n0; };
__device__ __forceinline__ int tr_row(const TrD& d, int n) {
    if (d.rmk == 0) return n + d.rmo;
    if (d.rmk == 1) return n < 256 ? n : (n < 416 ? n + 256 : n - 160);
    return (n >> 2) * 8 + (n & 3) + 4 * d.rmo; }
__device__ __forceinline__ void tr_load(const TrD& d, f32x4 (&v)[8], float (&g)[8], int lane) {
    const int c4 = lane & 7, r0 = lane >> 3;
#pragma unroll
    for (int j = 0; j < 8; ++j) { const int kk = r0 + 8 * j; v[j] = *(const f32x4*)(d.W + (size_t)(d.k0 + kk) * d.ldw + d.n0 + 4 * c4); g[j] = d.gain ? d.gain[d.k0 + kk] : 1.0f; } }
__device__ __forceinline__ void tr_store(const TrD& d, const f32x4 (&v)[8], const float (&g)[8], LAS float* scr, int lane) {
    const int c4 = lane & 7, r0 = lane >> 3;
#pragma unroll
    for (int j = 0; j < 8; ++j) { const int kk = r0 + 8 * j; LAS float* p = scr + kk * 33 + 4 * c4; p[0] = v[j][0] * g[j]; p[1] = v[j][1] * g[j]; p[2] = v[j][2] * g[j]; p[3] = v[j][3] * g[j]; }
    LDS_WAIT(); asm volatile("" ::: "memory");
    const int c = lane & 7;
#pragma unroll
    for (int j = 0; j < 4; ++j) { const int n = (lane >> 3) + 8 * j; const LAS float* q = scr + (8 * c) * 33 + n;
        u32x4 o; o.x = pk2(q[0 * 33], q[1 * 33]); o.y = pk2(q[2 * 33], q[3 * 33]); o.z = pk2(q[4 * 33], q[5 * 33]); o.w = pk2(q[6 * 33], q[7 * 33]);
        *(u32x4*)(d.WT + (size_t)tr_row(d, d.n0 + n) * d.ldt + d.dcol0 + d.k0 + 8 * c) = o; }
    LDS_WAIT(); asm volatile("" ::: "memory");
}
__device__ __forceinline__ void zero16(bf16_t* p) { *(u32x4*)p = (u32x4){0u, 0u, 0u, 0u}; }

__device__ __forceinline__ TrD moe_item(const Args& a, unsigned char* ws, int r, int layer) {
    bf16_t* Wgu = (bf16_t*)(ws + WS_WGU); bf16_t* Wd = (bf16_t*)(ws + WS_WD);
    TrD d; d.gain = nullptr; d.dcol0 = 0; d.rmk = 0; d.rmo = 0;
    const int kind = r >> 12, rr = r & 4095, le = layer * 32 + (rr >> 7), q = rr & 127;
    if (kind < 2) { d.W = (kind ? a.in[21] : a.in[20]) + (size_t)le * 262144; d.ldw = 256; d.gain = a.in[15] + layer * 1024; d.WT = Wgu + (size_t)le * 524288; d.ldt = 1024; d.rmk = 2; d.rmo = kind; d.k0 = 64 * (q / 8); d.n0 = 32 * (q % 8); }
    else { const int e = le & 31;
        d.W = a.in[22] + (size_t)le * 262144; d.ldw = 1024; d.WT = Wd + ((size_t)layer * 4 + (e >> 3)) * (1024 * 2048); d.ldt = 2048; d.dcol0 = (e & 7) * 256; d.k0 = 64 * (q / 32); d.n0 = 32 * (q % 32); }
    return d; }
template <class Dec>
__device__ __forceinline__ void tr_run(int first, int count, int stride, Dec decode, LAS float* scr, int lane) {
    if (first < count) { f32x4 va[8], vb[8]; float ga[8], gb[8]; int it = first; TrD d0 = decode(it), d1 = d0; tr_load(d0, va, ga, lane);
#pragma unroll 1
        for (;;) { const int it1 = it + stride; const bool h1 = it1 < count; if (h1) { d1 = decode(it1); tr_load(d1, vb, gb, lane); }
            tr_store(d0, va, ga, scr, lane); if (!h1) break;
            it = it1 + stride; const bool h2 = it < count; if (h2) { d0 = decode(it); tr_load(d0, va, ga, lane); }
            tr_store(d1, vb, gb, scr, lane); if (!h2) break; } } }
__device__ __forceinline__ void p1_fill(const Frame& F0, const Args& a) {
    const Frame F = phase_frame(F0);
    int fb = (int)blockIdx.x, fn = F.G;
    if (F.G > 64) { if (fb < 64) return; fb -= 64; fn -= 64; }
    unsigned char* ws = a.ws;
    tr_run(fb * 8 + F.wave, 4 * 4096, fn * 8, [&](int it) -> TrD { return it < 4096 ? moe_item(a, ws, it + 2 * 4096, 0) : moe_item(a, ws, it - 4096, 1); }, (LAS float*)(F.lds + F.wave * 16384), F.lane);
    __syncthreads();
}

__device__ __forceinline__ void p0_prologue(const Frame& F0, const Args& a) {
    const Frame F = phase_frame(F0);
    unsigned char* ws = a.ws;
    LAS float* scr = (LAS float*)(F.lds + F.wave * 16384);
    const int gw = F.vcu * 8 + F.wave, NGW = F.G * 8, lane = F.lane;
    bf16_t* WinA = (bf16_t*)(ws + WS_WINA); bf16_t* Wqkv = (bf16_t*)(ws + WS_WQKV); bf16_t* WinP = (bf16_t*)(ws + WS_WINP);
    bf16_t* Wmem = (bf16_t*)(ws + WS_WMEM); bf16_t* Wo = (bf16_t*)(ws + WS_WO); bf16_t* Wgu = (bf16_t*)(ws + WS_WGU); bf16_t* Wd = (bf16_t*)(ws + WS_WD);
    constexpr int I_INA = 16 * 21, I_UQ = 4 * 36, I_UKV = 2 * 48, I_INP = 16 * 32, I_MEM = 16 * 16, I_WO = 512 + 128, I_MOE = 2 * 4096;
    constexpr int NITEMS = I_INA + I_UQ + I_UKV + I_INP + I_MEM + I_WO + I_MOE;
    auto decode = [&](int it) -> TrD { int r = it; TrD d; d.gain = nullptr; d.dcol0 = 0; d.rmk = 0; d.rmo = 0;
        if (r < I_INA) { d.W = a.in[4]; d.ldw = 672; d.gain = a.in[3]; d.WT = WinA; d.ldt = 1024; d.rmk = 1; d.k0 = 64 * (r / 21); d.n0 = 32 * (r % 21); return d; } r -= I_INA;
        if (r < I_UQ) { d.W = a.in[6]; d.ldw = 1152; d.gain = a.in[5]; d.WT = Wqkv; d.ldt = 256; d.k0 = 64 * (r / 36); d.n0 = 32 * (r % 36); return d; } r -= I_UQ;
        if (r < I_UKV) { d.W = a.in[8]; d.ldw = 1536; d.gain = a.in[7]; d.WT = Wqkv; d.ldt = 256; d.rmo = 1280; d.k0 = 64 * (r / 48); d.n0 = 32 * (r % 48); return d; } r -= I_UKV;
        if (r < I_INP) { d.W = a.in[9]; d.ldw = 1024; d.gain = a.in[3] + 1024; d.WT = WinP; d.ldt = 1024; d.k0 = 64 * (r / 32); d.n0 = 32 * (r % 32); return d; } r -= I_INP;
        if (r < I_MEM) { d.W = a.in[13]; d.ldw = 512; d.gain = a.in[12]; d.WT = Wmem; d.ldt = 1024; d.k0 = 64 * (r / 16); d.n0 = 32 * (r % 16); return d; } r -= I_MEM;
        if (r < I_WO) { const int l = r < 512 ? 0 : 1, q = r < 512 ? r : r - 512 + 12 * 32;
            d.W = a.in[14] + (size_t)l * 1048576; d.ldw = 1024; d.WT = Wo + (size_t)l * 1048576; d.ldt = 1024; d.k0 = 64 * (q / 32); d.n0 = 32 * (q % 32); return d; } r -= I_WO;
        return moe_item(a, ws, r, 0); };
    tr_run(gw, NITEMS, NGW, decode, scr, lane);
    const int gt = (F.vcu * 8 + F.wave) * 64 + lane, NGT = NGW * 64;
    for (int c = gt; c < 96 * 128; c += NGT) zero16(WinA + (size_t)672 * 1024 + (size_t)c * 8);
    for (int c = gt; c < 128 * 32; c += NGT) zero16(Wqkv + (size_t)1152 * 256 + (size_t)c * 8);
    for (int c = gt; c < 1536 * 16; c += NGT) zero16(Wqkv + (size_t)(1280 + c / 16) * 256 + 128 + (c % 16) * 8);
    for (int it = gw; it < 4 * 24 * 16; it += NGW) { const int g = it / 384, q = it % 384, c0 = 8 * (q / 16), n = 64 * (q % 16) + lane;
        const float* wg = a.in[10] + ((size_t)g * 192 + c0) * 192; const float* sc = a.in[11] + g * 192; const float* wo = a.in[14] + 1048576 + (size_t)g * 192 * 1024 + n;
        for (int e = lane; e < 384; e += 64) *(LAS f32x4*)(scr + 4 * e) = *(const f32x4*)(wg + 4 * e);
        if (lane < 48) *(LAS f32x4*)(scr + 1536 + 4 * lane) = *(const f32x4*)(sc + 4 * lane);
        LDS_WAIT(); asm volatile("" ::: "memory");
        float acc[8] = {0.f, 0.f, 0.f, 0.f, 0.f, 0.f, 0.f, 0.f};
#pragma unroll 4
        for (int d = 0; d < 192; d += 4) { const f32x4 s4 = *(const LAS f32x4*)(scr + 1536 + d);
            const f32x4 w4 = (f32x4){wo[(size_t)d * 1024] * s4[0], wo[(size_t)(d + 1) * 1024] * s4[1], wo[(size_t)(d + 2) * 1024] * s4[2], wo[(size_t)(d + 3) * 1024] * s4[3]};
#pragma unroll
            for (int i = 0; i < 8; ++i) { const f32x4 m4 = *(const LAS f32x4*)(scr + i * 192 + d); acc[i] += (m4[0] * w4[0] + m4[1] * w4[1]) + (m4[2] * w4[2] + m4[3] * w4[3]); } }
        *(u32x4*)(Wo + 1048576 + (size_t)n * 1024 + g * 192 + c0) = (u32x4){pk2(acc[0], acc[1]), pk2(acc[2], acc[3]), pk2(acc[4], acc[5]), pk2(acc[6], acc[7])};
        LDS_WAIT(); asm volatile("" ::: "memory"); }
    { bf16_t* Wr = (bf16_t*)(ws + WS_WR);
      for (int c = gt; c < 2 * 256 * 1024; c += NGT) { const int l = c >> 18, q = c & 262143, row = q >> 10, k = q & 1023; unsigned o = 0u;
          if (row < 96) { const int L = 4 * (row >> 3) + (row & 3); float w = 0.f;
              if (L < 4) w = a.in[16][((size_t)l * 1024 + k) * 4 + L]; else if (L >= 16) w = a.in[18][((size_t)l * 1024 + k) * 32 + (L - 16)];
              w *= a.in[15][l * 1024 + k]; const unsigned hi = pk2(w, 0.f) & 0xffffu; const float rem = w - __uint_as_float(hi << 16);
              o = (row & 4) ? (pk2(rem, 0.f) & 0xffffu) : hi; }
          Wr[c] = (bf16_t)o; } }
    { float* cs = (float*)(ws + WS_CS); float* sn = (float*)(ws + WS_SN); const int* pos = (const int*)a.in[2];
      for (int c = gt; c < T * 16; c += NGT) { const int t = c >> 4, i = c & 15; const float inv = powf(10000.0f, -(float)(2 * i) / 32.0f); const float ang = (float)pos[t] * inv; cs[c] = cosf(ang); sn[c] = sinf(ang); } }
    { bf16_t* XS = (bf16_t*)(ws + WS_XS); float* rstd0 = (float*)(ws + WS_RSTD0); bf16_t* MB = (bf16_t*)(ws + WS_MEMB); float* rstdm = (float*)(ws + WS_RSTDM);
      auto xload = [&](int m, f32x4 (&v)[4]) { if (m < T + TMEM) { const bool ism = m >= T; const int row = ism ? m - T : m; const f32x4* xr = (const f32x4*)((ism ? a.in[1] : a.in[0]) + (size_t)row * DM) + lane;
#pragma unroll
              for (int j = 0; j < 4; ++j) v[j] = xr[64 * j]; } };
      auto xdone = [&](int m, const f32x4 (&v)[4]) { if (m < T + TMEM) { const bool ism = m >= T; const int row = ism ? m - T : m; float s2 = 0.f;
#pragma unroll
              for (int j = 0; j < 4; ++j) s2 += (v[j][0] * v[j][0] + v[j][1] * v[j][1]) + (v[j][2] * v[j][2] + v[j][3] * v[j][3]);
              s2 = wave_sum(s2); const float rs = 1.0f / sqrtf(s2 * (1.f / DM) + EPS);
              u32x2* o8 = (u32x2*)((ism ? MB : XS) + (size_t)row * DM) + lane;
#pragma unroll
              for (int j = 0; j < 4; ++j) o8[64 * j] = (u32x2){pk2(v[j][0], v[j][1]), pk2(v[j][2], v[j][3])};
              if (lane == 0) (ism ? rstdm : rstd0)[row] = rs; } };
      f32x4 v0[4], v1[4], v2[4], v3[4];
      xload(gw, v0); xload(gw + NGW, v1); xload(gw + 2 * NGW, v2);
#pragma unroll 1
      for (int m = gw; m < T + TMEM; m += 4 * NGW) {
          xload(m + 3 * NGW, v3); xdone(m, v0);
          xload(m + 4 * NGW, v0); xdone(m + NGW, v1);
          xload(m + 5 * NGW, v1); xdone(m + 2 * NGW, v2);
          xload(m + 6 * NGW, v2); xdone(m + 3 * NGW, v3); } }
}

__device__ __forceinline__ void attn_phase(const Frame& F0, unsigned char* ws, bool mla, const bf16_t* QC, int ldqc) {
    const Frame F = phase_frame(F0);
    const bf16_t* Q = (const bf16_t*)(ws + WS_Q); const bf16_t* KN = (const bf16_t*)(ws + WS_KN); const bf16_t* KR = (const bf16_t*)(ws + WS_KROPE); const bf16_t* V = (const bf16_t*)(ws + WS_V);
    const bf16_t* MKV = (const bf16_t*)(ws + WS_MEMKV); bf16_t* CC = (bf16_t*)(ws + WS_CONCAT);
    if (mla) {
        const float* CS = (const float*)(ws + WS_CS); const float* SN = (const float*)(ws + WS_SN);
        auto mk = [&](int j) -> att::AttU { const int pidx = F.vcu + (j >> 1) * F.G, bh = pidx >> 2, pr = pidx & 3, b = bh / NHEAD, h = bh % NHEAD, qb = (j & 1) ? pr : 7 - pr;
            const size_t row0 = (size_t)b * SEQ, q0 = row0 + (size_t)qb * 256;
            return att::AttU{Q + q0 * QW + h * DQK, KN + row0 * KVW + h * 64, KR + row0 * 32, V + row0 * KVW + h * 64, CC + q0 * DM + h * 64, CS + q0 * 16, SN + q0 * 16, 4 * (qb + 1)}; };
        const int nu = 2 * ((NB * NHEAD * 4 - F.vcu + F.G - 1) / F.G);
        u32x4 qr[6]; att::AttU cur = mk(0); int j = 0;
#pragma unroll 1
        do { const bool hn = j + 1 < nu; const att::AttU nxt = hn ? mk(j + 1) : cur;
            att::attn_unit<96, true>(F.lds, cur, nxt, j == 0, hn, QW, KVW, 32, KVW, DM, F.wave, qr);
            cur = nxt; ++j; } while (j < nu);
    }
    {   auto mx = [&](int j) -> att::AttU { const int uidx = F.vcu + j * F.G, qb = uidx & 7, h = (uidx >> 3) & 3, b = uidx >> 5; const size_t q0 = (size_t)b * SEQ + (size_t)qb * 256;
            return att::AttU{QC + q0 * ldqc + h * 64, MKV + (size_t)b * MEML * 512 + h * 64, nullptr, MKV + (size_t)b * MEML * 512 + 256 + h * 64, CC + q0 * DM + 768 + h * 64, nullptr, nullptr, 4}; };
        const int nx = (NB * 4 * 8 - F.vcu + F.G - 1) / F.G;
        u32x4 qx[4]; att::AttU cur = mx(0); int j = 0;
#pragma unroll 1
        do { const bool hn = j + 1 < nx; const att::AttU nxt = hn ? mx(j + 1) : cur;
            att::attn_unit<64, false>(F.lds, cur, nxt, j == 0, hn, ldqc, 512, 0, 512, DM, F.wave, qx);
            cur = nxt; ++j; } while (j < nx); }
}

__device__ __forceinline__ void router_phase(const Frame& F, const Args& a, int layer, LAS unsigned char* listbuf) {
    unsigned char* ws = a.ws;
    for (int blk = F.vcu; blk < T / 256; blk += F.G) {
        SchedOne S{(const char*)(ws + WS_XS), (const char*)(ws + WS_WR) + (size_t)layer * (256 * 2048), blk};
        EpiRouter E{(const float*)(ws + WS_SSQX), a.in[17] + layer * 4, a.in[19] + layer * 32, (float*)(ws + WS_TOKW), (float*)(ws + WS_TOKR), (int*)(ws + WS_LIST), F.ctl + CW_CNT + layer * 128};
        pg8::gemm_run<EpiRouter, SchedOne, false>(F.lds, listbuf, S, E, 16, 1 << 30, 2048u, 2048u, F.wave);
        __syncthreads();
    }
}
__device__ __forceinline__ void moe_table(const Frame& F0, int layer) {
    const Frame F = phase_frame(F0);
    LAS int* tab = (LAS int*)(F.lds + L_TAB); const unsigned* cnt = F.ctl + CW_CNT + layer * 128;
    LAS unsigned short* items = (LAS unsigned short*)(tab + 240);
    int c = 0, v = 0, f = 0, x = 0, xf = 0;
    if (F.tid < 128) { if (F.tid < NBUCKET) { c = (int)__hip_atomic_load(cnt + F.tid, __ATOMIC_RELAXED, __HIP_MEMORY_SCOPE_AGENT); tab[128 + F.tid] = c; v = (c + 255) >> 8; f = (c >> 8) + ((c & 255) > 128 ? 1 : 0); }
        x = v; xf = f;
#pragma unroll
        for (int o = 1; o < 64; o <<= 1) { const int y = __shfl_up(x, o), yf = __shfl_up(xf, o); if (F.lane >= o) { x += y; xf += yf; } }
        if (F.tid == 63) { tab[127] = x; tab[126] = xf; } }
    __syncthreads();
    int tile0 = 0, fpos = 0;
    if (F.tid <= NBUCKET) { tile0 = x - v + (F.tid >= 64 ? tab[127] : 0); fpos = xf - f + (F.tid >= 64 ? tab[126] : 0); tab[F.tid] = tile0;
        if (F.tid == NBUCKET) { tab[121] = fpos; } }
    __syncthreads();
    { const int ntile = tab[NBUCKET], NF = tab[121], NH = ntile - NF;
      int sp = NF - 256; if (sp < 0) sp = 0; { int room = (64 - NH) / 2; if (room < 0) room = 0; if (sp > room) sp = room; }
      const int NFk = NF - sp;
      if (F.tid == 0) tab[120] = NFk + NH + 2 * sp;
      if (F.tid < NBUCKET) {
          for (int k = 0; k < f; ++k) { const int p = fpos + k, tile = tile0 + k;
              if (p < NFk) items[p] = (unsigned short)tile;
              else { const int q = NFk + NH + 2 * (p - NFk); items[q] = (unsigned short)(tile | (1 << 12)); items[q + 1] = (unsigned short)(tile | (2 << 12)); } }
          if (v > f) items[NFk + (tile0 - fpos)] = (unsigned short)((tile0 + f) | (1 << 12)); } }
    __syncthreads();
}

__device__ __forceinline__ void pool_diff_phase(const Frame& F0, unsigned char* ws) {
    const Frame F = phase_frame(F0);
    const bf16_t* Z = (const bf16_t*)(ws + WS_Z); bf16_t* CC = (bf16_t*)(ws + WS_CONCAT);
    constexpr int SR = 32, RR = 96, PITCH = 1536, NS = 256 / SR;
    const unsigned lds0 = (unsigned)(uintptr_t)F.lds;
    const int lane = F.lane, wave = F.wave;
    for (int blk = F.vcu; blk < T / 256; blk += F.G) {
        const int t0 = blk * 256, s0 = t0 & (SEQ - 1);
#define POOL_DMA(trow0, ringrow0, npc) do { _Pragma("unroll") for (int i_ = 0; i_ < (npc); ++i_) { const int p_ = wave * (npc) + i_, k_ = p_ * 64 + lane, r_ = k_ / 96, ch_ = k_ - r_ * 96; \
            att::glds16(Z + (size_t)((trow0) + r_) * DM + ch_ * 8, (unsigned)__builtin_amdgcn_readfirstlane(lds0 + (ringrow0) * PITCH + p_ * 1024)); } } while (0)
        __syncthreads();
        if (s0 != 0) POOL_DMA(t0 - 16, RR - 16, 3);
        POOL_DMA(t0, 0, 6);
#pragma unroll 1
        for (int s = 0; s < NS; ++s) {
            if (s == 0 || wave >= 6) asm volatile("s_waitcnt vmcnt(0)" ::: "memory"); else asm volatile("s_waitcnt vmcnt(8)" ::: "memory");
            __builtin_amdgcn_s_barrier(); asm volatile("" ::: "memory");
            if (s + 1 < NS) POOL_DMA(t0 + (s + 1) * SR, ((s + 1) % 3) * SR, 6);
            if (wave < 6) {
                const int run = F.tid / 96, q = F.tid - run * 96, g = q / 24, w = 2 << g, r0 = s * SR + run * 8;
                int pos = s0 + r0;
                const LAS unsigned char* col = F.lds + q * 16;
#define POOL_ROW(dst, r) do { const int rr_ = ((r) + RR) % RR; const u32x4 w_ = *(const LAS u32x4*)(col + rr_ * PITCH); \
                    dst[0] = bflo(w_.x); dst[1] = bfhi(w_.x); dst[2] = bflo(w_.y); dst[3] = bfhi(w_.y); dst[4] = bflo(w_.z); dst[5] = bfhi(w_.z); dst[6] = bflo(w_.w); dst[7] = bfhi(w_.w); } while (0)
                float S[8] = {0.f, 0.f, 0.f, 0.f, 0.f, 0.f, 0.f, 0.f};
                const int m = min(pos, w - 1);
                for (int j = 1; j <= m; ++j) { float y[8]; POOL_ROW(y, r0 - j);
#pragma unroll
                    for (int k = 0; k < 8; ++k) S[k] += y[k]; }
#pragma unroll 2
                for (int i = 0; i < 8; ++i) { float x[8]; POOL_ROW(x, r0 + i);
#pragma unroll
                    for (int k = 0; k < 8; ++k) S[k] += x[k];
                    const float inv = 1.0f / (float)min(pos + 1, w);
                    *(u32x4*)(CC + (size_t)(t0 + r0 + i) * DM + q * 8) = (u32x4){pk2(S[0] * inv - x[0], S[1] * inv - x[1]), pk2(S[2] * inv - x[2], S[3] * inv - x[3]), pk2(S[4] * inv - x[4], S[5] * inv - x[5]), pk2(S[6] * inv - x[6], S[7] * inv - x[7])};
                    if (pos + 1 >= w) { float y[8]; POOL_ROW(y, r0 + i - (w - 1));
#pragma unroll
                        for (int k = 0; k < 8; ++k) S[k] -= y[k]; }
                    ++pos; }
#undef POOL_ROW
            }
        }
#undef POOL_DMA
    }
    __syncthreads();
}
__device__ __forceinline__ void final_phase(const Frame& F0, const Args& a) {
    const Frame F = phase_frame(F0);
    const bf16_t* XS = (const bf16_t*)(a.ws + WS_XS); const float* gf = a.in[23];
    const int gw = F.vcu * 8 + F.wave, NGW = F.G * 8, lane = F.lane;
    f32x4 gv[4];
#pragma unroll
    for (int j = 0; j < 4; ++j) gv[j] = *((const f32x4*)gf + lane + 64 * j);
    auto fload = [&](int m, u32x2 (&w)[4]) { if (m < T) { const u32x2* xr = (const u32x2*)(XS + (size_t)m * DM) + lane;
#pragma unroll
            for (int j = 0; j < 4; ++j) w[j] = xr[64 * j]; } };
    auto fdone = [&](int m, const u32x2 (&w)[4]) { if (m < T) { f32x4 v[4]; float s2 = 0.f;
#pragma unroll
            for (int j = 0; j < 4; ++j) { v[j] = (f32x4){bflo(w[j].x), bfhi(w[j].x), bflo(w[j].y), bfhi(w[j].y)}; s2 += (v[j][0] * v[j][0] + v[j][1] * v[j][1]) + (v[j][2] * v[j][2] + v[j][3] * v[j][3]); }
            s2 = wave_sum(s2); const float rs = 1.0f / sqrtf(s2 * (1.f / DM) + EPS);
            f32x4* o = (f32x4*)(a.out + (size_t)m * DM) + lane;
#pragma unroll
            for (int j = 0; j < 4; ++j) o[64 * j] = v[j] * rs * gv[j]; } };
    u32x2 w0[4], w1[4], w2[4], w3[4];
    fload(gw, w0); fload(gw + NGW, w1); fload(gw + 2 * NGW, w2);
#pragma unroll 1
    for (int m = gw; m < T; m += 4 * NGW) {
        fload(m + 3 * NGW, w3); fdone(m, w0);
        fload(m + 4 * NGW, w0); fdone(m + NGW, w1);
        fload(m + 5 * NGW, w1); fdone(m + 2 * NGW, w2);
        fload(m + 6 * NGW, w2); fdone(m + 3 * NGW, w3); }
}

#ifndef PHASE_MASK
#define PHASE_MASK 0xFFFFFFFFu
#endif
#define PH(n) ((PHASE_MASK >> (n)) & 1u)
__global__ void __launch_bounds__(512, 2) fwd_kernel(Args args) {
    extern __shared__ __attribute__((aligned(16))) unsigned char lds_raw[];
    Frame F; F.lds = (LAS unsigned char*)lds_raw; F.tid = threadIdx.x; F.lane = F.tid & 63; F.wave = __builtin_amdgcn_readfirstlane(F.tid >> 6);
    __builtin_assume(gridDim.x <= 256u); __builtin_assume(blockIdx.x < gridDim.x);
    F.G = gridDim.x; { const int bx = blockIdx.x; F.vcu = (F.G % 8 == 0) ? (bx % 8) * (F.G / 8) + bx / 8 : bx; }
    unsigned char* ws = args.ws; F.ctl = (unsigned*)(ws + WS_CTL);
    for (int u = F.tid; u < (LDS_BYTES - RING_BYTES) / 4; u += 512) ((LAS unsigned*)(F.lds + RING_BYTES))[u] = 0u;
    __syncthreads();
    XcdBarrier bar = xcd_barrier_post(F.ctl + CW_BAR, (volatile LAS unsigned*)(F.lds + L_MISC) + 8, F.wave);
    LAS unsigned char* listbuf = F.lds + L_LIST;
    const float qcscale = 0.125f * LOG2E;
    const float qscale = 0.10206207261596577f * LOG2E;

    if (PH(0)) p0_prologue(F, args);
    xcd_barrier(bar);
    if (PH(1)) p1_fill(F, args);
    if (PH(1)) {   SchedPlainPart S; S.o.init(TMEM / 256, 2, F.G, (int)blockIdx.x); S.A = (const char*)(ws + WS_MEMB); S.B = (const char*)(ws + WS_WMEM); S.a_tile = 256 * 2048; S.b_tile = 256 * 2048;
        EpiRowScale E{(bf16_t*)(ws + WS_MEMKV), 512, (const float*)(ws + WS_RSTDM)};
        pg8::gemm_run<EpiRowScale, SchedPlainPart, false>(F.lds, listbuf, S, E, 16, 1 << 30, 2048u, 2048u, F.wave); }
    if (PH(2)) {   SchedPlain S; S.o.init(T / 256, 3, F.G, (int)blockIdx.x); S.A = (const char*)(ws + WS_XS); S.B = (const char*)(ws + WS_WINA); S.a_tile = 256 * 2048; S.b_tile = 256 * 2048;
        EpiInA E{(const float*)(ws + WS_RSTD0), (bf16_t*)(ws + WS_QLAT), (bf16_t*)(ws + WS_QC), (bf16_t*)(ws + WS_KVLAT), (bf16_t*)(ws + WS_KROPE), (float*)(ws + WS_SSQQ), (float*)(ws + WS_SSQKV),
                 (const float*)(ws + WS_CS), (const float*)(ws + WS_SN), qcscale};
        pg8::gemm_run<EpiInA, SchedPlain, false>(F.lds, listbuf, S, E, 16, 1 << 30, 2048u, 2048u, F.wave); }
    xcd_barrier(bar);
    if (PH(3)) {   SchedQKV S; S.o.init(T / 256, 11, F.G, (int)blockIdx.x); S.Aq = (const char*)(ws + WS_QLAT); S.Akv = (const char*)(ws + WS_KVLAT); S.B = (const char*)(ws + WS_WQKV);
        EpiQKV E{(const float*)(ws + WS_SSQQ), (const float*)(ws + WS_SSQKV), (bf16_t*)(ws + WS_Q), (bf16_t*)(ws + WS_KN), (bf16_t*)(ws + WS_V), qscale};
        pg8::gemm_run<EpiQKV, SchedQKV, false>(F.lds, listbuf, S, E, 4, 1 << 30, 512u, 512u, F.wave); }
    xcd_barrier(bar);
#pragma unroll 1
    for (int layer = 0; layer < 2; ++layer) {
        int gG = F.G, gB = (int)blockIdx.x, gV = F.vcu; asm volatile("" : "+s"(gG), "+s"(gB), "+s"(gV));
        { size_t zoff = 0; asm volatile("" : "+s"(zoff)); ws = args.ws + zoff; }
        if (layer == 0) {
            if (PH(4)) attn_phase(F, ws, true, (const bf16_t*)(ws + WS_QC), 256);
            xcd_barrier(bar);
        } else {
            if (PH(5)) {   SchedPlain S; S.o.init(T / 256, 4, gG, gB); S.A = (const char*)(ws + WS_XS); S.B = (const char*)(ws + WS_WINP); S.a_tile = 256 * 2048; S.b_tile = 256 * 2048;
                EpiInP E{(const float*)(ws + WS_SSQX), (bf16_t*)(ws + WS_Z), qcscale};
                pg8::gemm_run<EpiInP, SchedPlain, false>(F.lds, listbuf, S, E, 16, 1 << 30, 2048u, 2048u, F.wave); }
            xcd_barrier(bar);
            if (PH(6)) pool_diff_phase(F, ws);
            if (PH(7)) attn_phase(F, ws, false, (const bf16_t*)(ws + WS_Z) + 768, 1024);
            xcd_barrier(bar);
        }
        if (PH(9)) {   SchedPlain S; S.o.init(T / 256, 4, gG, gB); S.A = (const char*)(ws + WS_CONCAT); S.B = (const char*)(ws + WS_WO) + (size_t)layer * 2097152; S.a_tile = 256 * 2048; S.b_tile = 256 * 2048;
            EpiWo E{(bf16_t*)(ws + WS_XS), (float*)(ws + WS_SSQX)};
            pg8::gemm_run<EpiWo, SchedPlain, false>(F.lds, listbuf, S, E, 16, 1 << 30, 2048u, 2048u, F.wave); }
        xcd_barrier(bar);
        if (PH(10)) router_phase(F, args, layer, listbuf);
        xcd_barrier(bar);
        moe_table(F, layer);
        if (PH(11)) {   SchedMoe<false> S{(const LAS int*)(F.lds + L_TAB), gG, gV, (const char*)(ws + WS_XS), (const char*)(ws + WS_WGU) + (size_t)layer * (32u * 512u * 2048u), (const int*)(ws + WS_LIST)};
            EpiMoeUp E{(const float*)(ws + WS_TOKR), (const float*)(ws + WS_TOKW), (bf16_t*)(ws + WS_ACT)};
            pg8::gemm_run<EpiMoeUp, SchedMoe<false>, true>(F.lds, listbuf, S, E, 16, 1 << 30, 2048u, 2048u, F.wave); }
        xcd_barrier(bar);
        if (PH(12)) {   SchedMoe<true> S{(const LAS int*)(F.lds + L_TAB), gG, gV, (const char*)(ws + WS_ACT), (const char*)(ws + WS_WD) + (size_t)layer * (4u * 1024u * 4096u), (const int*)(ws + WS_LIST)};
            EpiMoeDown E{(bf16_t*)(ws + WS_XS), (float*)(ws + WS_SSQX)};
            pg8::gemm_run<EpiMoeDown, SchedMoe<true>, false>(F.lds, listbuf, S, E, 8, 4, 1024u, 4096u, F.wave); }
        xcd_barrier(bar);
    }
    if (PH(13)) final_phase(F, args);
}

extern "C" void kernel_launch(void* const* d_in, const int* in_sizes, int n_in, void* d_out, int out_size, void* d_ws, size_t ws_size, hipStream_t stream) {
    static int grid = 0;
    if (grid == 0) {
        if (n_in != 24 || in_sizes[0] != T * DM || out_size != T * DM || ws_size < WS_END) { fprintf(stderr, "kernel_launch: unexpected shapes (n_in %d, in0 %d, out %d, ws %zu); nothing launched\n", n_in, n_in > 0 ? in_sizes[0] : -1, out_size, ws_size); grid = -1; return; }
        int dev = 0, cus = 0, per_cu = 0;
        if (hipGetDevice(&dev) != hipSuccess || hipDeviceGetAttribute(&cus, hipDeviceAttributeMultiprocessorCount, dev) != hipSuccess) { grid = -1; return; }
        if (hipFuncSetAttribute((const void*)fwd_kernel, hipFuncAttributeMaxDynamicSharedMemorySize, LDS_BYTES) != hipSuccess) { fprintf(stderr, "kernel_launch: hipFuncSetAttribute failed\n"); grid = -1; return; }
        if (hipOccupancyMaxActiveBlocksPerMultiprocessor(&per_cu, (const void*)fwd_kernel, 512, LDS_BYTES) != hipSuccess || per_cu < 1) fprintf(stderr, "kernel_launch: occupancy query reports %d\n", per_cu);
        (void)hipGetLastError();
        grid = cus < 256 ? cus : 256;
    }
    if (grid < 0) return;
    if (hipMemsetAsync((char*)d_ws + WS_CTL, 0, CTL_ZERO_BYTES, stream) != hipSuccess) return;
    Args a{};
    for (int i = 0; i < 24; ++i) a.in[i] = (const float*)d_in[i];
    a.out = (float*)d_out; a.ws = (unsigned char*)d_ws;
    hipLaunchKernelGGL(fwd_kernel, dim3(grid), dim3(512), LDS_BYTES, stream, a);
}
```
